# Optimizing an MI355X kernel written in HIP

```python
import math
import jax
import jax.numpy as jnp
from jax import lax
import numpy as np

D_MODEL = 1024
BATCH = 8
SEQ = 2048
DEPTH = 2

GRID_W = 64
CTX_LEN = 256
ROT_DIM = 64
ROPE_BASE = 10000.0
Q_BLOCK = 128
CHUNK = 32

DA_HEADS = 4
DA_DH = ROT_DIM
DA_DV = 2 * DA_DH
GLA_HEADS = 4
GLA_DK = 64
GLA_DV = 128
GLA_LR = 16
GLA_NORMALIZER = 16.0
MLA_HEADS = 4
MLA_Q_RANK = 256
MLA_KV_RANK = 128
MLA_NOPE = 128
MLA_ROPE = ROT_DIM
MLA_DV = 128
MLA_SCALE = (MLA_NOPE + MLA_ROPE) ** -0.5
HG_HEADS = 4
HG_DK = 128
HG_DV = 128
D_FF = 3584
N_EXPERTS = 8
TOP_K = 2

LN_EPS = 1e-5
RMS_EPS = 1e-6
DN_ALPHA = (2 * DEPTH) ** 0.25
DN_BETA = (8 * DEPTH) ** -0.25
N_EVEN = (DEPTH + 1) // 2
N_ODD = DEPTH // 2

A_QK = DA_HEADS * 2 * DA_DH
A_V = DA_HEADS * DA_DV
B_QK = GLA_HEADS * GLA_DK
B_V = GLA_HEADS * GLA_DV
EV_SIZES = (A_QK, A_QK, A_V, B_QK, B_QK, B_V, B_V, GLA_LR, GLA_LR)
EV_IN = sum(EV_SIZES)
EV_MIX = A_V + B_V
HG_K = HG_HEADS * HG_DK
HG_W = HG_HEADS * HG_DV
OD_SIZES = (MLA_Q_RANK, MLA_KV_RANK, MLA_ROPE, HG_K, HG_K, HG_K, HG_W, HG_W)
OD_IN = sum(OD_SIZES)
OD_MIX = MLA_HEADS * MLA_DV + HG_W

kernel_name = "hybrid_diffusion_backbone"


def _layernorm(x, g, b):
    xf = x.astype(jnp.float32)
    mu = jnp.mean(xf, axis=-1, keepdims=True)
    var = jnp.mean(jnp.square(xf - mu), axis=-1, keepdims=True)
    return ((xf - mu) * lax.rsqrt(var + LN_EPS) * g + b).astype(x.dtype)


def _rmsnorm(x, g):
    xf = x.astype(jnp.float32)
    return (xf * lax.rsqrt(jnp.mean(xf * xf, axis=-1, keepdims=True) + RMS_EPS) * g).astype(x.dtype)


def _split_cols(t, sizes):
    return jnp.split(t, np.cumsum(sizes)[:-1].tolist(), axis=-1)


def _heads(t, n):
    b, s, _ = t.shape
    return t.reshape(b, s, n, -1).transpose(0, 2, 1, 3)


def _unheads(t):
    b, n, s, d = t.shape
    return t.transpose(0, 2, 1, 3).reshape(b, s, n * d)


def _axial_rope_table(rows, rot_dim):
    n_freq = rot_dim // 4
    inv = ROPE_BASE ** (-jnp.arange(n_freq, dtype=jnp.float32) / n_freq)
    row = jnp.repeat(jnp.arange(rows, dtype=jnp.float32), GRID_W)
    col = jnp.tile(jnp.arange(GRID_W, dtype=jnp.float32), rows)
    ang = jnp.concatenate([row[:, None] * inv, col[:, None] * inv], axis=-1)
    return jnp.cos(ang), jnp.sin(ang)


def _rope(t, cos, sin):
    tf = t.astype(jnp.float32).reshape(t.shape[:-1] + (-1, 2))
    t0, t1 = tf[..., 0], tf[..., 1]
    out = jnp.stack([t0 * cos - t1 * sin, t0 * sin + t1 * cos], axis=-1)
    return out.reshape(t.shape).astype(t.dtype)


def _split_q_blocks(t):
    b, h, s, d = t.shape
    return t.reshape(b, h, s // Q_BLOCK, Q_BLOCK, d).transpose(2, 0, 1, 3, 4)


def _merge_q_blocks(t):
    nb, b, h, q, d = t.shape
    return t.transpose(1, 2, 0, 3, 4).reshape(b, h, nb * q, d)


def _softmax32(s):
    return jax.nn.softmax(s.astype(jnp.float32), axis=-1)


def _diff_attend(q1, q2, k1, k2, v, lam):
    scale = DA_DH ** -0.5
    p1 = _softmax32(jnp.einsum('bhqd,bhkd->bhqk', q1, k1) * scale)
    p2 = _softmax32(jnp.einsum('bhqd,bhkd->bhqk', q2, k2) * scale)
    return jnp.einsum('bhqk,bhkd->bhqd', (p1 - lam * p2).astype(v.dtype), v)


def _mla_attend(q, k, v):
    p = _softmax32(jnp.einsum('bhqd,bhkd->bhqk', q, k) * MLA_SCALE).astype(v.dtype)
    return jnp.einsum('bhqk,bhkd->bhqd', p, v)


def _chunk_scan(q, k, v, g, s0, need_out):
    dtype = v.dtype
    b_, h_, s_, dk = q.shape
    dv = v.shape[-1]
    n = s_ // CHUNK
    q, k, v, g = (t.astype(jnp.float32).reshape(b_, h_, n, CHUNK, t.shape[-1]) for t in (q, k, v, g))
    bcum = jnp.cumsum(g, axis=3)
    b_last = bcum[:, :, :, -1:, :]
    d_state = jnp.einsum('bhnck,bhncv->bhnkv', k * jnp.exp(b_last - bcum), v)
    chunk_decay = jnp.exp(b_last[:, :, :, 0, :])

    def step(state, inp):
        ds_n, dec_n = inp
        return state * dec_n[..., None] + ds_n, state

    s_fin, s_start = lax.scan(step, s0, (jnp.moveaxis(d_state, 2, 0), jnp.moveaxis(chunk_decay, 2, 0)))
    if not need_out:
        return None, s_fin
    s_start = jnp.moveaxis(s_start, 0, 2)
    b_ref = bcum[:, :, :, CHUNK // 2 - 1:CHUNK // 2, :]
    att = jnp.einsum('bhnik,bhnjk->bhnij', q * jnp.exp(bcum - b_ref), k * jnp.exp(b_ref - bcum))
    att = jnp.where(jnp.tril(jnp.ones((CHUNK, CHUNK), dtype=bool)), att, 0.0)
    o = jnp.einsum('bhnij,bhnjv->bhniv', att, v) + jnp.einsum('bhnik,bhnkv->bhniv', q * jnp.exp(bcum), s_start)
    return o.reshape(b_, h_, s_, dv).astype(dtype), s_fin


def _bidir_scan(q_c, k_c, v_c, g_c, q_l, k_l, v_l, g_l, need_ctx):
    b_, h_, _, dk = q_l.shape
    dv = v_l.shape[-1]
    o_c_sum, o_l_sum = None, None
    for d in range(2):
        fl = (lambda t: jnp.flip(t, axis=2)) if d == 1 else (lambda t: t)
        s0 = jnp.zeros((b_, h_, dk, dv), jnp.float32)
        o_c, s_c = _chunk_scan(fl(q_c), fl(k_c[d]), fl(v_c), fl(g_c[d]), s0, need_ctx)
        o_l, _ = _chunk_scan(fl(q_l), fl(k_l[d]), fl(v_l), fl(g_l[d]), s_c, True)
        o_l_sum = fl(o_l) if d == 0 else o_l_sum + fl(o_l)
        if need_ctx:
            o_c_sum = fl(o_c) if d == 0 else o_c_sum + fl(o_c)
    return o_c_sum, o_l_sum


def _even_mixer(h_c, h_l, cos, sin, w_in, lam_vecs, lam_init, subln_g, gk_w2, gk_b, gla_g, w_out, need_ctx):
    def project(h, rotate):
        qa, ka, va, qb, kb, vb, gb, lr_f, lr_b = _split_cols(h @ w_in, EV_SIZES)
        qa, ka = _heads(qa, DA_HEADS), _heads(ka, DA_HEADS)
        q1, q2, k1, k2 = qa[..., :DA_DH], qa[..., DA_DH:], ka[..., :DA_DH], ka[..., DA_DH:]
        if rotate:
            q1, q2, k1, k2 = (_rope(t, cos, sin) for t in (q1, q2, k1, k2))
        gk = tuple(_heads(jax.nn.log_sigmoid((lr @ gk_w2[d] + gk_b[d]).astype(jnp.float32)) / GLA_NORMALIZER, GLA_HEADS)
                   for d, lr in enumerate((lr_f, lr_b)))
        gla_k = _heads(kb, GLA_HEADS)
        return (q1, q2, k1, k2, _heads(va, DA_HEADS), _heads(qb, GLA_HEADS) * GLA_DK ** -0.5,
                (gla_k, gla_k), _heads(vb, GLA_HEADS), gk, _heads(gb, GLA_HEADS))

    q1c, q2c, k1c, k2c, vac, qbc, kbc, vbc, gkc, gbc = project(h_c, False)
    q1l, q2l, k1l, k2l, val, qbl, kbl, vbl, gkl, gbl = project(h_l, True)
    lv = lam_vecs.astype(jnp.float32)
    lam = jnp.exp(jnp.sum(lv[0] * lv[1])) - jnp.exp(jnp.sum(lv[2] * lv[3])) + lam_init
    k1_all = jnp.concatenate([k1c, k1l], axis=2)
    k2_all = jnp.concatenate([k2c, k2l], axis=2)
    v_all = jnp.concatenate([vac, val], axis=2)
    o_a_l = _merge_q_blocks(lax.map(lambda qs: _diff_attend(qs[0], qs[1], k1_all, k2_all, v_all, lam),
                                    (_split_q_blocks(q1l), _split_q_blocks(q2l))))
    o_b_c, o_b_l = _bidir_scan(qbc, kbc, vbc, gkc, qbl, kbl, vbl, gkl, need_ctx)

    def merge(o_a, o_b, gate):
        o_a = _rmsnorm(o_a, subln_g) * (1.0 - lam_init)
        o_b = _rmsnorm(o_b, gla_g) * jax.nn.silu(gate)
        return jnp.concatenate([_unheads(o_a), _unheads(o_b)], axis=-1) @ w_out

    y_l = merge(o_a_l, o_b_l, gbl)
    y_c = merge(_diff_attend(q1c, q2c, k1c, k2c, vac, lam), o_b_c, gbc) if need_ctx else None
    return y_c, y_l


def _odd_mixer(h_c, h_l, cos, sin, w_in, q_norm_g, kv_norm_g, w_uq, w_ukv, lb, hg_g, w_out, need_ctx):
    def project(h, rotate):
        cq, ckv, kr, hq, hf_f, hf_b, hi, hgate = _split_cols(h @ w_in, OD_SIZES)
        q = _heads(_rmsnorm(cq, q_norm_g) @ w_uq, MLA_HEADS)
        kv = _heads(_rmsnorm(ckv, kv_norm_g) @ w_ukv, MLA_HEADS)
        q_nope, q_rope = q[..., :MLA_NOPE], q[..., MLA_NOPE:]
        k_nope, v = kv[..., :MLA_NOPE], kv[..., MLA_NOPE:]
        k_rope = kr[:, None]
        if rotate:
            q_rope, k_rope = _rope(q_rope, cos, sin), _rope(k_rope, cos, sin)
        q = jnp.concatenate([q_nope, q_rope], axis=-1)
        k = jnp.concatenate([k_nope, jnp.broadcast_to(k_rope, k_nope.shape[:-1] + (MLA_ROPE,))], axis=-1)
        f = [lb + (1.0 - lb) * jax.nn.sigmoid(t.astype(jnp.float32)) for t in (hf_f, hf_b)]
        hk = tuple(_heads(1.0 - t, HG_HEADS) for t in f)
        hlog = tuple(_heads(jnp.log(t), HG_HEADS) for t in f)
        return q, k, v, _heads(hq, HG_HEADS), hk, _heads(hi, HG_HEADS), hlog, _heads(hgate, HG_HEADS)

    qc, kc, vc, hqc, hkc, hic, hgc, gtc = project(h_c, False)
    ql, kl, vl, hql, hkl, hil, hgl, gtl = project(h_l, True)
    k_all = jnp.concatenate([kc, kl], axis=2)
    v_all = jnp.concatenate([vc, vl], axis=2)
    o_m_l = _merge_q_blocks(lax.map(lambda qb: _mla_attend(qb, k_all, v_all), _split_q_blocks(ql)))
    o_h_c, o_h_l = _bidir_scan(hqc, hkc, hic, hgc, hql, hkl, hil, hgl, need_ctx)

    def merge(o_m, o_h, gate):
        o_h = _rmsnorm(o_h, hg_g) * jax.nn.silu(gate)
        return jnp.concatenate([_unheads(o_m), _unheads(o_h)], axis=-1) @ w_out

    y_l = merge(o_m_l, o_h_l, gtl)
    y_c = merge(_mla_attend(qc, kc, vc), o_h_c, gtc) if need_ctx else None
    return y_c, y_l


def _swiglu(h, w1, w2):
    hg, hu = jnp.split(h @ w1, 2, axis=-1)
    return (jax.nn.silu(hg) * hu) @ w2


def _moe(h, w_router, w1, w2):
    shape = h.shape
    hf = h.reshape(-1, shape[-1])
    logits = (hf @ w_router).astype(jnp.float32)
    top_v, top_i = lax.top_k(logits, TOP_K)
    gates = jax.nn.softmax(top_v, axis=-1)
    comb = jnp.sum(jax.nn.one_hot(top_i, N_EXPERTS, dtype=jnp.float32) * gates[..., None], axis=1)
    out = jnp.zeros_like(hf)
    for e in range(N_EXPERTS):
        out = out + comb[:, e:e + 1].astype(hf.dtype) * _swiglu(hf, w1[e], w2[e])
    return out.reshape(shape)


def _ada(cond, w, b):
    return jnp.split(jax.nn.silu(cond) @ w + b, 6, axis=-1)


def _diff_lambda_init(layer):
    return 0.8 - 0.6 * math.exp(-0.3 * layer)


def setup_inputs(seed: int = 0) -> dict:
    key = jax.random.key(seed)
    ks = iter(jax.random.split(key, 32))

    def nrm(shape, scale):
        return jax.random.normal(next(ks), shape, jnp.float32) * scale

    D = D_MODEL
    return {
        "x": nrm((BATCH, SEQ, D), 1.0),
        "c": nrm((BATCH, D), 1.0),
        "ctx": nrm((BATCH, CTX_LEN, D), 1.0),
        "c_ctx": nrm((D,), 1.0),
        "ada_w": nrm((DEPTH, D, 6 * D), 0.5 * D ** -0.5),
        "ada_b": nrm((DEPTH, 6 * D), 0.02),
        "post_ln_g": 1.0 + nrm((DEPTH, 2, D), 0.02),
        "post_ln_b": nrm((DEPTH, 2, D), 0.02),
        "lb_table": nrm((DEPTH, HG_K), 1.0),
        "ev_w_in": nrm((N_EVEN, D, EV_IN), D ** -0.5),
        "ev_lam": nrm((N_EVEN, 4, DA_DH), 0.1),
        "ev_subln_g": 1.0 + nrm((N_EVEN, DA_DV), 0.02),
        "ev_gk_w2": nrm((N_EVEN, 2, GLA_LR, B_QK), GLA_LR ** -0.5),
        "ev_gk_b": nrm((N_EVEN, 2, B_QK), 0.02),
        "ev_gla_norm_g": 1.0 + nrm((N_EVEN, GLA_DV), 0.02),
        "ev_w_out": nrm((N_EVEN, EV_MIX, D), DN_BETA * EV_MIX ** -0.5),
        "ev_ffn_w1": nrm((N_EVEN, D, 2 * D_FF), D ** -0.5),
        "ev_ffn_w2": nrm((N_EVEN, D_FF, D), DN_BETA * D_FF ** -0.5),
        "od_w_in": nrm((N_ODD, D, OD_IN), D ** -0.5),
        "od_q_norm_g": 1.0 + nrm((N_ODD, MLA_Q_RANK), 0.02),
        "od_kv_norm_g": 1.0 + nrm((N_ODD, MLA_KV_RANK), 0.02),
        "od_w_uq": nrm((N_ODD, MLA_Q_RANK, MLA_HEADS * (MLA_NOPE + MLA_ROPE)), MLA_Q_RANK ** -0.5),
        "od_w_ukv": nrm((N_ODD, MLA_KV_RANK, MLA_HEADS * (MLA_NOPE + MLA_DV)), MLA_KV_RANK ** -0.5),
        "od_hg_norm_g": 1.0 + nrm((N_ODD, HG_DV), 0.02),
        "od_w_out": nrm((N_ODD, OD_MIX, D), DN_BETA * OD_MIX ** -0.5),
        "od_router": nrm((N_ODD, D, N_EXPERTS), D ** -0.5),
        "od_exp_w1": nrm((N_ODD, N_EXPERTS, D, 2 * D_FF), D ** -0.5),
        "od_exp_w2": nrm((N_ODD, N_EXPERTS, D_FF, D), DN_BETA * D_FF ** -0.5),
    }


def reference(x, c, ctx, c_ctx, ada_w, ada_b, post_ln_g, post_ln_b, lb_table,
              ev_w_in, ev_lam, ev_subln_g, ev_gk_w2, ev_gk_b, ev_gla_norm_g, ev_w_out, ev_ffn_w1, ev_ffn_w2,
              od_w_in, od_q_norm_g, od_kv_norm_g, od_w_uq, od_w_ukv, od_hg_norm_g, od_w_out,
              od_router, od_exp_w1, od_exp_w2):
    rows = x.shape[1] // GRID_W
    cos, sin = _axial_rope_table(rows, ROT_DIM)
    lb_soft = jax.nn.softmax(lb_table.astype(jnp.float32), axis=0)
    lower_bounds = jnp.cumsum(lb_soft, axis=0) - lb_soft[0]
    for layer in range(DEPTH):
        last = layer == DEPTH - 1
        j = layer // 2
        m_l = [t[:, None, :] for t in _ada(c, ada_w[layer], ada_b[layer])]
        m_c = _ada(c_ctx, ada_w[layer], ada_b[layer])
        h_l = x * (1.0 + m_l[1]) + m_l[0]
        h_c = ctx * (1.0 + m_c[1]) + m_c[0]
        if layer % 2 == 0:
            y_c, y_l = _even_mixer(h_c, h_l, cos, sin, ev_w_in[j], ev_lam[j], _diff_lambda_init(layer),
                                   ev_subln_g[j], ev_gk_w2[j], ev_gk_b[j], ev_gla_norm_g[j], ev_w_out[j], not last)
        else:
            y_c, y_l = _odd_mixer(h_c, h_l, cos, sin, od_w_in[j], od_q_norm_g[j], od_kv_norm_g[j], od_w_uq[j],
                                  od_w_ukv[j], lower_bounds[layer], od_hg_norm_g[j], od_w_out[j], not last)
        x = _layernorm(DN_ALPHA * x + m_l[2] * y_l, post_ln_g[layer, 0], post_ln_b[layer, 0])
        h_l = x * (1.0 + m_l[4]) + m_l[3]
        if layer % 2 == 0:
            f_l = _swiglu(h_l, ev_ffn_w1[j], ev_ffn_w2[j])
        else:
            f_l = _moe(h_l, od_router[j], od_exp_w1[j], od_exp_w2[j])
        x = _layernorm(DN_ALPHA * x + m_l[5] * f_l, post_ln_g[layer, 1], post_ln_b[layer, 1])
        if not last:
            ctx = _layernorm(DN_ALPHA * ctx + m_c[2] * y_c, post_ln_g[layer, 0], post_ln_b[layer, 0])
            h_c = ctx * (1.0 + m_c[4]) + m_c[3]
            if layer % 2 == 0:
                f_c = _swiglu(h_c, ev_ffn_w1[j], ev_ffn_w2[j])
            else:
                f_c = _moe(h_c, od_router[j], od_exp_w1[j], od_exp_w2[j])
            ctx = _layernorm(DN_ALPHA * ctx + m_c[5] * f_c, post_ln_g[layer, 1], post_ln_b[layer, 1])
    return x
```

```cpp
#include <hip/hip_runtime.h>
#include <cstdio>
#include <cstdint>
namespace pg8 {
#define PG8_LAS __attribute__((address_space(3)))
typedef unsigned short bf16_t;
typedef short bf16x8 __attribute__((ext_vector_type(8)));
typedef float f32x4 __attribute__((ext_vector_type(4)));
typedef unsigned u32x4 __attribute__((ext_vector_type(4)));
constexpr int BM = 256, BK = 64, HALF = 128, HTB = HALF * BK * 2  , STAGE_BYTES = 8 * HTB, NXCD = 8, WGM = 8;

__host__ __device__ __forceinline__ int lds_byte(int r, int c) { const int st = (r >> 4) * 2 + (c >> 5), rr = r & 15, cc = c & 31, ob = rr * 64 + cc * 2; return st * 1024 + (ob ^ (((ob >> 9) & 1) << 5)); }
__host__ __device__ __forceinline__ void stage_rc(int b, int& R, int& C) { const int st = b / 1024, sb = b % 1024, swz = sb ^ (((sb >> 9) & 1) << 5); R = (st >> 1) * 16 + swz / 64; C = (st & 1) * 32 + (swz % 64) / 2; }
__host__ __device__ __forceinline__ int perm32(int rho) { const int n = rho >> 4, i = rho & 15; return 8 * (i >> 2) + 4 * n + (i & 3); }

struct Unit { int pm, pn; };
struct Gemm { const bf16_t* A; const bf16_t* Bt; int M, N, K; };

struct StaticOrder {
    int nM, nN, nwg, G, c;
    __host__ __device__ void init(int M, int N, int G_, int c_) { nM = M / BM; nN = N / BM; nwg = nM * nN; G = G_; c = c_; }
    __host__ __device__ bool next(int i, Unit& u) const {
        const long L = (long)i * G + c; if (L >= nwg) return false;
        int wgid = (int)L; { const int q = nwg / NXCD, r = nwg % NXCD, xcd = wgid % NXCD, off = wgid / NXCD; wgid = (xcd < r ? xcd * (q + 1) : r * (q + 1) + (xcd - r) * q) + off; }
        const int nig = WGM * nN, gid = wgid / nig, fm = gid * WGM, gsz = (nM - fm) < WGM ? (nM - fm) : WGM;
        u.pm = fm + ((wgid % nig) % gsz); u.pn = (wgid % nig) / gsz; return true;
    }
    __device__ __forceinline__ void a_ready(const Unit&) const {}
    __device__ __forceinline__ void done(const Unit&) const {}
};

__device__ __forceinline__ unsigned cvt_pk_bf16(float lo, float hi) { unsigned r; asm volatile("v_cvt_pk_bf16_f32 %0, %1, %2" : "=v"(r) : "v"(lo), "v"(hi)); return r; }
typedef float f32x2 __attribute__((ext_vector_type(2)));
__device__ __forceinline__ f32x2 gelu_pk(f32x2 v) {
    const f32x2 av = __builtin_elementwise_abs(v), d = av * 0.2316418882f + 1.0f;
    f32x2 t; t.x = __builtin_amdgcn_rcpf(d.x); t.y = __builtin_amdgcn_rcpf(d.y);
    f32x2 q = t * 0.5307027145f + (-0.7265760135f); q = q * t + 0.7107068705f; q = q * t + (-0.142248368f); q = q * t + 0.127414796f; q = q * t;
    const f32x2 s = (v * v) * (-0.72134752044f);
    f32x2 e; e.x = __builtin_amdgcn_exp2f(s.x); e.y = __builtin_amdgcn_exp2f(s.y);
    const f32x2 m = v * (q * e), r = v - m;
    f32x2 o; o.x = v.x < 0.f ? m.x : r.x; o.y = v.y < 0.f ? m.y : r.y; return o;
}

template <int ACT  > struct EpiBf16 {
    static constexpr bool PERM = true, AFTER_DRAIN = false; static_assert(ACT == 0 || ACT == 1, "EpiBf16: ACT is 0 (none) or 1 (gelu_pk)");
    bf16_t* O; int ldc; const float* bias; int split_cols; size_t split_stride; float scale0;
    __device__ __forceinline__ void operator()(const f32x4 (&acc)[2][2][4][2], const Unit& u, int wr, int wc, int fr, int fq) const {
        const int row0 = u.pm * BM + wr * 64 + fr; int colt = u.pn * BM; bf16_t* base = O;
        float sc = 1.f; if (split_cols) { const int t = colt / split_cols; base += (size_t)t * split_stride; colt -= t * split_cols; if (t == 0) sc = scale0; }
        const int col0 = colt + wc * 32 + 8 * fq, bcol0 = u.pn * BM + wc * 32 + 8 * fq;
        f32x4 bv[2][2];
#pragma unroll
        for (int bj = 0; bj < 2; ++bj)
#pragma unroll
            for (int n = 0; n < 2; ++n) bv[bj][n] = bias ? *(const f32x4*)(bias + bcol0 + bj * HALF + 4 * n) : (f32x4){0.f, 0.f, 0.f, 0.f};
#pragma unroll
        for (int ai = 0; ai < 2; ++ai)
#pragma unroll
            for (int m = 0; m < 4; ++m) { bf16_t* rowp = base + (size_t)(row0 + ai * HALF + m * 16) * ldc + col0;
#pragma unroll
                for (int bj = 0; bj < 2; ++bj) { f32x4 v0 = acc[ai][bj][m][0] + bv[bj][0], v1 = acc[ai][bj][m][1] + bv[bj][1];
                    if (ACT == 1) { f32x2 a = gelu_pk((f32x2){v0[0], v0[1]}), b = gelu_pk((f32x2){v0[2], v0[3]}), c = gelu_pk((f32x2){v1[0], v1[1]}), d = gelu_pk((f32x2){v1[2], v1[3]});
                        v0 = (f32x4){a.x, a.y, b.x, b.y}; v1 = (f32x4){c.x, c.y, d.x, d.y}; }
                    v0 = v0 * sc; v1 = v1 * sc; u32x4 w; w.x = cvt_pk_bf16(v0[0], v0[1]); w.y = cvt_pk_bf16(v0[2], v0[3]); w.z = cvt_pk_bf16(v1[0], v1[1]); w.w = cvt_pk_bf16(v1[2], v1[3]);
                    *(u32x4*)(rowp + bj * HALF) = w; } }
    }
};
struct EpiF32 {
    static constexpr bool PERM = false, AFTER_DRAIN = false;
    float* C; int ldc; const float* bias;
    __device__ __forceinline__ void operator()(const f32x4 (&acc)[2][2][4][2], const Unit& u, int wr, int wc, int fr, int fq) const {
        const int row0 = u.pm * BM + wr * 64 + fr, col0 = u.pn * BM + wc * 32 + 4 * fq;
        f32x4 bv[2][2];
#pragma unroll
        for (int bj = 0; bj < 2; ++bj)
#pragma unroll
            for (int n = 0; n < 2; ++n) bv[bj][n] = bias ? *(const f32x4*)(bias + col0 + bj * HALF + n * 16) : (f32x4){0.f, 0.f, 0.f, 0.f};
#pragma unroll
        for (int ai = 0; ai < 2; ++ai)
#pragma unroll
            for (int m = 0; m < 4; ++m) { float* rowp = C + (size_t)(row0 + ai * HALF + m * 16) * ldc + col0;
#pragma unroll
                for (int bj = 0; bj < 2; ++bj)
#pragma unroll
                    for (int n = 0; n < 2; ++n) *(f32x4*)(rowp + bj * HALF + n * 16) = acc[ai][bj][m][n] + bv[bj][n]; }
    }
};
template <class Epi, class Sched, bool ALIGN_EPI = false, bool SP2 = false>
__device__ __forceinline__ void gemm_phase(PG8_LAS unsigned char* lds, const Gemm g, const Sched& S, const Epi& E) {
    int tid_ = threadIdx.x; asm volatile("" : "+v"(tid_));
    const int tid = tid_, wid = __builtin_amdgcn_readfirstlane(tid >> 6), lane = tid & 63, wr = wid >> 2, wc = wid & 3, fr = lane & 15, fq = lane >> 4;
    const int K = g.K, nt = K / BK;
    unsigned voffA[2], voffB[2];
#pragma unroll
    for (int i = 0; i < 2; ++i) { int R, C; stage_rc(tid * 16 + i * 8192, R, C); const int Rb = Epi::PERM ? ((R & ~31) + perm32(R & 31)) : R;
        voffA[i] = (unsigned)(R * K + C) * 2u; voffB[i] = (unsigned)(Rb * K + C) * 2u; }
    const size_t kstep = (size_t)(BK * 2);
    const size_t hstep = (size_t)HALF * K * 2;
    const size_t tstep = 2 * hstep;
    const unsigned ldsw = (unsigned)wid * 1024u;
    const int aoff = lds_byte(wr * 64 + fr, fq * 8), boff = lds_byte(wc * 32 + fr, fq * 8);
#define PG8_SA(b, h) (((b) * 2 + (h)) * HTB)
#define PG8_SB(b, h) ((4 + (b) * 2 + (h)) * HTB)
#define PG8_STAGE(bufoff, gbase, voff) do { _Pragma("unroll") for (int _i = 0; _i < 2; ++_i) \
        __builtin_amdgcn_global_load_lds((const unsigned*)((const char*)(gbase) + (voff)[_i]), (PG8_LAS unsigned*)(lds + (bufoff) + ldsw + _i * 8192), 16, 0, 0); } while (0)
#define PG8_LDA(dst, b, h) do { _Pragma("unroll") for (int m = 0; m < 4; ++m) _Pragma("unroll") for (int k = 0; k < 2; ++k) dst[m][k] = *(const PG8_LAS bf16x8*)(lds + PG8_SA(b, h) + aoff + m * 2048 + k * 1024); } while (0)
#define PG8_LDB(dst, b, h) do { _Pragma("unroll") for (int n = 0; n < 2; ++n) _Pragma("unroll") for (int k = 0; k < 2; ++k) dst[n][k] = *(const PG8_LAS bf16x8*)(lds + PG8_SB(b, h) + boff + n * 2048 + k * 1024); } while (0)
#define PG8_MMA(ai, bj, At, Bt) do { __builtin_amdgcn_s_setprio(1); _Pragma("unroll") for (int m = 0; m < 4; ++m) _Pragma("unroll") for (int n = 0; n < 2; ++n) _Pragma("unroll") for (int k = 0; k < 2; ++k) \
        acc[ai][bj][m][n] = __builtin_amdgcn_mfma_f32_16x16x32_bf16(Bt[n][k], At[m][k], acc[ai][bj][m][n], 0, 0, 0); __builtin_amdgcn_s_setprio(0); } while (0)
#define PG8_WAIT_V(n) asm volatile("s_waitcnt vmcnt(" #n ")" ::: "memory")
#define PG8_WAIT_L(n) asm volatile("s_waitcnt lgkmcnt(" #n ")" ::: "memory")
#define PG8_BAR __builtin_amdgcn_s_barrier()
#define PG8_SCHED __builtin_amdgcn_sched_barrier(0)
    Unit cur, nxt; int ui = 0;
    if (!S.next(0, cur)) return;
    f32x4 acc[2][2][4][2];
#pragma unroll
    for (int a = 0; a < 2; ++a)
#pragma unroll
        for (int b = 0; b < 2; ++b)
#pragma unroll
            for (int m = 0; m < 4; ++m)
#pragma unroll
                for (int n = 0; n < 2; ++n) acc[a][b][m][n] = (f32x4){0.f, 0.f, 0.f, 0.f};
    bf16x8 At[4][2], B0[2][2], B1[2][2];
    const char* cA = (const char*)g.A + (size_t)cur.pm * tstep; const char* cB = (const char*)g.Bt + (size_t)cur.pn * tstep;
    S.a_ready(cur);
    if constexpr (SP2) {
        PG8_STAGE(PG8_SB(0, 0), cB, voffB); PG8_STAGE(PG8_SB(0, 1), cB + hstep, voffB); PG8_STAGE(PG8_SA(0, 0), cA, voffA); PG8_STAGE(PG8_SA(0, 1), cA + hstep, voffA);
        if (wr == 1) PG8_BAR;
        PG8_WAIT_V(2); PG8_BAR;
        PG8_STAGE(PG8_SB(1, 0), cB + kstep, voffB); PG8_STAGE(PG8_SA(1, 0), cA + kstep, voffA); PG8_STAGE(PG8_SB(1, 1), cB + hstep + kstep, voffB);
        PG8_WAIT_V(6); PG8_BAR;
    } else {
        PG8_STAGE(PG8_SB(0, 0), cB, voffB); PG8_STAGE(PG8_SA(0, 0), cA, voffA); PG8_STAGE(PG8_SB(0, 1), cB + hstep, voffB); PG8_STAGE(PG8_SA(0, 1), cA + hstep, voffA);
        if (wr == 1) PG8_BAR;
        PG8_WAIT_V(4); PG8_BAR;
        PG8_STAGE(PG8_SB(1, 0), cB + kstep, voffB); PG8_STAGE(PG8_SA(1, 0), cA + kstep, voffA); PG8_STAGE(PG8_SB(1, 1), cB + hstep + kstep, voffB);
        PG8_WAIT_V(6); PG8_BAR;
    }
    for (;;) {
        const bool has_next = S.next(ui + 1, nxt);
        const char* nA = has_next ? (const char*)g.A + (size_t)nxt.pm * tstep : cA; const char* nB = has_next ? (const char*)g.Bt + (size_t)nxt.pn * tstep : cB;
        for (int t = 0; t < nt; t += 2) {
            const bool last = (t == nt - 2);
            const char* a1 = cA + (size_t)(t + 1) * kstep;
            const char* a2 = last ? nA : cA + (size_t)(t + 2) * kstep; const char* b2 = last ? nB : cB + (size_t)(t + 2) * kstep;
            const char* a3 = a2 + kstep; const char* b3 = b2 + kstep;
            if (last && has_next) S.a_ready(nxt);
            if constexpr (SP2) {
            PG8_LDB(B0, 0, 0); PG8_LDB(B1, 0, 1); PG8_SCHED; PG8_LDA(At, 0, 0); PG8_STAGE(PG8_SA(1, 1), a1 + hstep, voffA);
            PG8_WAIT_V(8); PG8_WAIT_L(0); PG8_BAR; PG8_MMA(0, 0, At, B0); PG8_MMA(0, 1, At, B1); PG8_BAR; PG8_SCHED;
            PG8_LDA(At, 0, 1); PG8_STAGE(PG8_SB(0, 0), b2, voffB); PG8_STAGE(PG8_SB(0, 1), b2 + hstep, voffB); PG8_STAGE(PG8_SA(0, 0), a2, voffA);
            PG8_WAIT_V(8); PG8_WAIT_L(0); PG8_BAR; PG8_MMA(1, 0, At, B0); PG8_MMA(1, 1, At, B1); PG8_BAR; PG8_SCHED;
            PG8_LDB(B0, 1, 0); PG8_LDB(B1, 1, 1); PG8_SCHED; PG8_LDA(At, 1, 0); PG8_STAGE(PG8_SA(0, 1), a2 + hstep, voffA);
            PG8_WAIT_V(8); PG8_WAIT_L(0); PG8_BAR; PG8_MMA(0, 0, At, B0); PG8_MMA(0, 1, At, B1); PG8_BAR; PG8_SCHED;
            PG8_LDA(At, 1, 1); PG8_STAGE(PG8_SB(1, 0), b3, voffB); PG8_STAGE(PG8_SB(1, 1), b3 + hstep, voffB); PG8_STAGE(PG8_SA(1, 0), a3, voffA);
            PG8_WAIT_V(8); PG8_WAIT_L(0); PG8_BAR; PG8_MMA(1, 0, At, B0); PG8_MMA(1, 1, At, B1); PG8_BAR; PG8_SCHED;
            } else {
            PG8_LDB(B0, 0, 0); PG8_SCHED; PG8_LDA(At, 0, 0); PG8_STAGE(PG8_SA(1, 1), a1 + hstep, voffA);
            PG8_WAIT_L(8); PG8_BAR; PG8_WAIT_L(0); PG8_MMA(0, 0, At, B0); PG8_BAR; PG8_SCHED;
            PG8_LDB(B1, 0, 1); PG8_STAGE(PG8_SB(0, 0), b2, voffB);
            PG8_BAR; PG8_WAIT_L(0); PG8_MMA(0, 1, At, B1); PG8_BAR;
            PG8_LDA(At, 0, 1); PG8_STAGE(PG8_SA(0, 0), a2, voffA);
            PG8_BAR; PG8_WAIT_L(0); PG8_MMA(1, 0, At, B0); PG8_BAR; PG8_SCHED;
            PG8_STAGE(PG8_SB(0, 1), b2 + hstep, voffB);
            PG8_WAIT_V(6); PG8_BAR; PG8_MMA(1, 1, At, B1); PG8_BAR;
            PG8_LDB(B0, 1, 0); PG8_SCHED; PG8_LDA(At, 1, 0); PG8_STAGE(PG8_SA(0, 1), a2 + hstep, voffA);
            PG8_WAIT_L(8); PG8_BAR; PG8_WAIT_L(0); PG8_MMA(0, 0, At, B0); PG8_BAR; PG8_SCHED;
            PG8_LDB(B1, 1, 1); PG8_STAGE(PG8_SB(1, 0), b3, voffB);
            PG8_BAR; PG8_WAIT_L(0); PG8_MMA(0, 1, At, B1); PG8_BAR;
            PG8_LDA(At, 1, 1); PG8_STAGE(PG8_SA(1, 0), a3, voffA);
            PG8_BAR; PG8_WAIT_L(0); PG8_MMA(1, 0, At, B0); PG8_BAR; PG8_SCHED;
            PG8_STAGE(PG8_SB(1, 1), b3 + hstep, voffB);
            PG8_WAIT_V(6); PG8_BAR; PG8_MMA(1, 1, At, B1); PG8_BAR;
            }
        }
        if constexpr (ALIGN_EPI) { if (wr == 0) PG8_BAR; }
        if constexpr (!Epi::AFTER_DRAIN) { E(acc, cur, wr, wc, fr, fq); S.done(cur); }
        if (!has_next) break;
#pragma unroll
        for (int a = 0; a < 2; ++a)
#pragma unroll
            for (int b = 0; b < 2; ++b)
#pragma unroll
                for (int m = 0; m < 4; ++m)
#pragma unroll
                    for (int n = 0; n < 2; ++n) acc[a][b][m][n] = (f32x4){0.f, 0.f, 0.f, 0.f};
        cur = nxt; cA = nA; cB = nB; ++ui;
        if constexpr (ALIGN_EPI) { if (wr == 1) PG8_BAR; }
    }
    PG8_WAIT_V(0);
    if constexpr (!ALIGN_EPI) { if (wr == 0) PG8_BAR; }
    PG8_BAR;
    if constexpr (Epi::AFTER_DRAIN) { E.fused(acc, cur, wr, wc, fr, fq, lds, wid, lane); S.done(cur); }
#undef PG8_SA
#undef PG8_SB
#undef PG8_STAGE
#undef PG8_LDA
#undef PG8_LDB
#undef PG8_MMA
#undef PG8_WAIT_V
#undef PG8_WAIT_L
#undef PG8_BAR
#undef PG8_SCHED
}
}
#define GAS __attribute__((address_space(1)))
#define LAS __attribute__((address_space(3)))
typedef unsigned short bf16;
typedef unsigned v4u __attribute__((ext_vector_type(4)));
typedef float f32x4 __attribute__((ext_vector_type(4)));
typedef short bf16x8 __attribute__((ext_vector_type(8)));
typedef GAS unsigned gu32;
typedef GAS unsigned long long gu64;
#define RLX_AGENT __ATOMIC_RELAXED, __HIP_MEMORY_SCOPE_AGENT
#define LDS_WAIT() asm volatile("s_waitcnt lgkmcnt(0)" ::: "memory")
#define VM_WAIT() asm volatile("s_waitcnt vmcnt(0)" ::: "memory")
__device__ __forceinline__ unsigned long long rt() { return __builtin_amdgcn_s_memrealtime(); }
__device__ __forceinline__ unsigned f2bf(float f) { unsigned u = __builtin_bit_cast(unsigned, f); return (u + 0x7fffu + ((u >> 16) & 1u)) >> 16; }
__device__ __forceinline__ unsigned pk2(float lo, float hi) { return f2bf(lo) | (f2bf(hi) << 16); }

#define XB_TMO      128
#define XB_XCNT(j)  (256  + 64 * (j))
#define XB_XSUB(j)  (1280 + 64 * (j))
#define XB_XGEN(j)  (2304 + 64 * (j))
#define XB_TOP      3328
#define XB_TOPGEN   3392
#define XCD_BAR_WORDS 3456
#define XB_SPIN_CAP (1u << 22)

__device__ __forceinline__ unsigned xb_ld(unsigned* p)              { return __hip_atomic_load(p, __ATOMIC_RELAXED, __HIP_MEMORY_SCOPE_AGENT); }
__device__ __forceinline__ unsigned xb_add(unsigned* p, unsigned v) { return __hip_atomic_fetch_add(p, v, __ATOMIC_RELAXED, __HIP_MEMORY_SCOPE_AGENT); }
__device__ __forceinline__ unsigned xb_xcc_id() { return (unsigned)__builtin_amdgcn_s_getreg((3 << 11) | 20) & 0xFu; }
#define XB_SPIN(cond, bar) do { unsigned _sp = 0; while (cond) { __builtin_amdgcn_s_sleep(1); \
    if ((++_sp & 255u) == 0u) { if (xb_ld(&(bar)[XB_TMO])) break; if (_sp > XB_SPIN_CAP) { atomicAdd(&(bar)[XB_TMO], 1u); break; } } } } while (0)

struct XcdBarrier {
    unsigned* bar; unsigned x;
    volatile LAS unsigned* st;
};

__device__ __forceinline__ XcdBarrier xcd_barrier_post(unsigned* bar, volatile LAS unsigned* st) {
    XcdBarrier b; b.bar = bar; b.x = xb_xcc_id(); b.st = st;
    if (threadIdx.x == 0) (void)xb_add(&bar[XB_XCNT(b.x)], 1u);
    return b;
}
__device__ __forceinline__ void xcd_barrier_complete(unsigned* bar, unsigned x, unsigned& nloc, unsigned& nx) {
    const unsigned G = gridDim.x * gridDim.y * gridDim.z;
    unsigned sum, cnt, mine, sp = 0u;
    for (;;) {
        sum = 0u; cnt = 0u; mine = 0u;
#pragma unroll
        for (unsigned j = 0; j < 16; ++j) { const unsigned c = xb_ld(&bar[XB_XCNT(j)]); sum += c; cnt += (c > 0u) ? 1u : 0u; mine = (j == x) ? c : mine; }
        if (sum == G) break;
        __builtin_amdgcn_s_sleep(1);
        if ((++sp & 255u) == 0u) { if (xb_ld(&bar[XB_TMO])) break; if (sp > XB_SPIN_CAP) { atomicAdd(&bar[XB_TMO], 1u); break; } }
    }
    nloc = mine > 0u ? mine : 1u; nx = cnt > 0u ? cnt : 1u;
}

__device__ __forceinline__ void xcd_barrier(const XcdBarrier& b) {
    asm volatile("s_waitcnt vmcnt(0)" ::: "memory");
    __syncthreads();
    if (threadIdx.x == 0) {
        unsigned* bar = b.bar;
        __builtin_amdgcn_s_waitcnt(0);
        unsigned nloc = b.st[0], nx = b.st[1];
        if (nloc == 0u) { xcd_barrier_complete(bar, b.x, nloc, nx); b.st[0] = nloc; b.st[1] = nx; }
        const unsigned old = xb_add(&bar[XB_XSUB(b.x)], 1u);
        const unsigned gen = old / nloc;
        if (old + 1u == (gen + 1u) * nloc) {
            __builtin_amdgcn_fence(__ATOMIC_RELEASE, "agent");
            asm volatile("s_waitcnt vmcnt(0)" ::: "memory");
            const unsigned og = xb_add(&bar[XB_TOP], 1u);
            const unsigned tg = og / nx;
            if (og + 1u == (tg + 1u) * nx) xb_add(&bar[XB_TOPGEN], 1u);
            else XB_SPIN(xb_ld(&bar[XB_TOPGEN]) == tg, bar);
            __builtin_amdgcn_fence(__ATOMIC_ACQUIRE, "agent");
            xb_add(&bar[XB_XGEN(b.x)], 1u);
            asm volatile("s_waitcnt vmcnt(0)" ::: "memory");
        } else {
            XB_SPIN(xb_ld(&bar[XB_XGEN(b.x)]) == gen, bar);
            __builtin_amdgcn_fence(__ATOMIC_ACQUIRE, "agent");
            asm volatile("s_waitcnt vmcnt(0)" ::: "memory");
        }
    }
    __syncthreads();
}

constexpr int NWAVES = 8, NTHR = 512;
constexpr int NB = 8, SEQ = 2048, DM = 1024, CTXL = 256;
constexpr int ML = NB * SEQ, MC = NB * CTXL, MT = ML + MC;
constexpr int EV_IN = 3104, EV_INP = 3328, OD_IN = 3008, OD_INP = 3072, DFF = 3584, NEXP = 8;
constexpr int EV_QA = 0, EV_KA = 512, EV_VA = 1024, EV_QB = 1536, EV_KB = 1792, EV_VB = 2048, EV_GB = 2560, EV_LRF = 3072, EV_LRB = 3088;
constexpr int OD_CQ = 0, OD_CKV = 256, OD_KR = 384, OD_HQ = 448, OD_HFF = 960, OD_HFB = 1472, OD_HI = 1984, OD_HG = 2496;
constexpr float LN_EPS = 1e-5f, RMS_EPS = 1e-6f, DN_ALPHA = 1.41421356237f, LAM_INIT0 = 0.2f;
constexpr float DA_SCALE = 0.125f, GLA_QSCALE = 0.125f, MLA_SCALE = 0.07216878364870322f;

constexpr size_t MiB = 1u << 20;
constexpr size_t WS_CTL = 0, CTL_ZERO_BYTES = 1 * MiB;
constexpr size_t WS_MOD = 1 * MiB;
constexpr size_t WS_COS = 2 * MiB, WS_SIN = 2 * MiB + 262144;
constexpr size_t WS_SCAL = 2 * MiB + 524288;
constexpr size_t WS_ROUTE = 3 * MiB;
constexpr size_t WS_W_IN0 = 8 * MiB, WS_W_OUT0 = 15 * MiB, WS_W_FF1 = 17 * MiB, WS_W_FF2 = 31 * MiB, WS_W_IN1 = 38 * MiB, WS_W_UQ = 44 * MiB, WS_W_UKV = 45 * MiB, WS_W_OUT1 = 46 * MiB;
constexpr size_t WS_EXP_W1 = 48 * MiB, WS_EXP_W2 = 160 * MiB;
constexpr size_t WS_H = 216 * MiB, WS_X1 = 252 * MiB, WS_X2 = 324 * MiB, WS_BIG = 396 * MiB, WS_ACT = 648 * MiB, WS_YF = 774 * MiB, WS_SPARE = 846 * MiB, WS_END = 864 * MiB;
constexpr size_t WS_P = WS_BIG, WS_U = WS_BIG;
constexpr size_t WS_GK = WS_ACT, WS_OA = WS_ACT + 36 * MiB, WS_OBF = WS_ACT + 72 * MiB, WS_OBB = WS_YF;
constexpr size_t WS_Q = WS_ACT, WS_KV = WS_ACT + 24 * MiB, WS_OM = WS_ACT + 60 * MiB, WS_OHF = WS_ACT + 92 * MiB, WS_OHB = WS_YF, WS_NQ = WS_SPARE, WS_NKV = WS_SPARE + 8 * MiB;
constexpr size_t WS_FSUM = WS_X2;
static_assert(WS_OHF + 32 * MiB <= WS_YF && WS_NKV + 9 * MiB <= WS_END, "ws map");
constexpr int CW_BAR = 4096;
constexpr int MAX_LAUNCHES = 64;
static_assert((CW_BAR + MAX_LAUNCHES * XCD_BAR_WORDS) * 4 <= (int)CTL_ZERO_BYTES, "CTL words inside the memset region");

constexpr int SCR_BYTES = 151552;
constexpr int MISC_OFF = SCR_BYTES;
constexpr int LDS_BYTES = 155648;

struct Frame {
    LAS unsigned char* lds;
    volatile LAS unsigned* MISC;
    gu32* ctl;
    int tid, lane, wave, G, gw, NGW;
    unsigned char* ws;
    const float* in[28];
    float* out;
};
enum InIdx { I_X = 0, I_C, I_CTX, I_CCTX, I_ADAW, I_ADAB, I_LNG, I_LNB, I_LBT, I_EV_WIN, I_EV_LAM, I_EV_SUBLN, I_EV_GKW2, I_EV_GKB, I_EV_GLAG, I_EV_WOUT, I_EV_W1, I_EV_W2,
             I_OD_WIN, I_OD_QNG, I_OD_KVNG, I_OD_WUQ, I_OD_WUKV, I_OD_HGG, I_OD_WOUT, I_OD_ROUTER, I_OD_EW1, I_OD_EW2 };

__device__ __forceinline__ float bf2f(unsigned short b) { return __uint_as_float(((unsigned)b) << 16); }
__device__ __forceinline__ float bflo(unsigned w) { return __uint_as_float(w << 16); }
__device__ __forceinline__ float bfhi(unsigned w) { return __uint_as_float(w & 0xffff0000u); }
__device__ __forceinline__ float wave_sum(float v) {
#pragma unroll
    for (int o = 1; o < 64; o <<= 1) v += __shfl_xor(v, o);
    return v;
}
__device__ __forceinline__ float wave_max(float v) {
#pragma unroll
    for (int o = 1; o < 64; o <<= 1) v = fmaxf(v, __shfl_xor(v, o));
    return v;
}
__device__ __forceinline__ float sigmoidf_(float x) { return 1.0f / (1.0f + __expf(-x)); }
__device__ __forceinline__ float siluf_(float x) { return x / (1.0f + __expf(-x)); }
__device__ __forceinline__ float logsigmoidf_(float x) { return fminf(x, 0.0f) - log1pf(__expf(-fabsf(x))); }
__device__ __forceinline__ int mod_row(int m) { return m < ML ? (m >> 11) : NB; }
__device__ __forceinline__ void frame_refresh(Frame& F) {
    int t = threadIdx.x; asm volatile("" : "+v"(t));
    F.tid = t; F.lane = t & 63; F.wave = __builtin_amdgcn_readfirstlane(t >> 6); F.gw = blockIdx.x * NWAVES + F.wave;
}
__device__ __forceinline__ const float* src_row(const Frame& F, int m) { return m < ML ? F.in[I_X] + (size_t)m * DM : F.in[I_CTX] + (size_t)(m - ML) * DM; }

__device__ __forceinline__ void transpose_tile(const float* W, int N, bf16* WT, int ldt, LAS float* scr, int k0, int n0, int lane) {
#pragma unroll 8
    for (int i = 0; i < 32; ++i) { const int kk = 2 * i + (lane >> 5); scr[kk * 33 + (lane & 31)] = W[(size_t)(k0 + kk) * N + n0 + (lane & 31)]; }
    LDS_WAIT(); asm volatile("" ::: "memory");
    const int c = lane & 7;
#pragma unroll
    for (int j = 0; j < 4; ++j) { const int n = (lane >> 3) + 8 * j; const LAS float* s = scr + (8 * c) * 33 + n;
        v4u o; o.x = pk2(s[0 * 33], s[1 * 33]); o.y = pk2(s[2 * 33], s[3 * 33]); o.z = pk2(s[4 * 33], s[5 * 33]); o.w = pk2(s[6 * 33], s[7 * 33]);
        *(GAS v4u*)(WT + (size_t)(n0 + n) * ldt + k0 + 8 * c) = o; }
    LDS_WAIT(); asm volatile("" ::: "memory");
}
__device__ __forceinline__ void transpose_weight(Frame& F, const float* W, int K, int N, bf16* WT, int ldt, LAS float* scr) {
    const int nblk = N / 32, items = (K / 64) * nblk;
    for (int it = F.gw; it < items; it += F.NGW) transpose_tile(W, N, WT, ldt, scr, 64 * (it / nblk), 32 * (it % nblk), F.lane);
}
__device__ __forceinline__ void zero_bytes16(Frame& F, unsigned char* p, size_t nbytes) {
    const v4u z = {0u, 0u, 0u, 0u};
    for (size_t i = (size_t)blockIdx.x * NTHR + F.tid; i < nbytes / 16; i += (size_t)F.G * NTHR) ((GAS v4u*)p)[i] = z;
}

__device__ __forceinline__ void p0_prologue(Frame& F) {
    {
        LAS float* sS = (LAS float*)F.lds;
        LAS float* part = (LAS float*)(F.lds + 40960);
        float* MOD = (float*)(F.ws + WS_MOD);
        if ((int)blockIdx.x < 192) {
            for (int i = F.tid; i < 9 * 1024; i += NTHR) { const int r = i >> 10, k = i & 1023; const float v = r < 8 ? F.in[I_C][r * 1024 + k] : F.in[I_CCTX][k]; sS[i] = siluf_(v); }
            __syncthreads();
            for (int it = blockIdx.x; it < 192; it += F.G) {
                const int l = it / 96, n0 = (it % 96) * 64;
                const float* Wp = F.in[I_ADAW] + ((size_t)l * 1024 + 128 * F.wave) * 6144 + n0 + F.lane;
                float acc[9];
#pragma unroll
                for (int r = 0; r < 9; ++r) acc[r] = 0.f;
                for (int kk = 0; kk < 128; kk += 8) {
                    float wv[8];
#pragma unroll
                    for (int j = 0; j < 8; ++j) wv[j] = Wp[(size_t)(kk + j) * 6144];
#pragma unroll
                    for (int j = 0; j < 8; ++j)
#pragma unroll
                        for (int r = 0; r < 9; ++r) acc[r] += sS[r * 1024 + 128 * F.wave + kk + j] * wv[j];
                }
#pragma unroll
                for (int r = 0; r < 9; ++r) part[(F.wave * 9 + r) * 64 + F.lane] = acc[r];
                __syncthreads();
                for (int i = F.tid; i < 576; i += NTHR) { const int r = i >> 6, c = i & 63; float s = 0.f;
#pragma unroll
                    for (int w = 0; w < 8; ++w) s += part[(w * 9 + r) * 64 + c];
                    MOD[((size_t)l * 9 + r) * 6144 + n0 + c] = s + F.in[I_ADAB][l * 6144 + n0 + c]; }
                __syncthreads();
            }
        }
        __syncthreads();
    }
    {
        float* COS = (float*)(F.ws + WS_COS); float* SIN = (float*)(F.ws + WS_SIN);
        for (int i = blockIdx.x * NTHR + F.tid; i < 2048 * 32; i += F.G * NTHR) {
            const int pos = i >> 5, pi = i & 31; const int j = pi & 15;
            const float inv = (float)pow(10000.0, -(double)j / 16.0);
            const float p = (float)(pi < 16 ? (pos >> 6) : (pos & 63));
            const float ang = p * inv;
            COS[i] = (float)cos((double)ang); SIN[i] = (float)sin((double)ang);
        }
        if (blockIdx.x == 0) {
            float* SC = (float*)(F.ws + WS_SCAL);
            if (F.wave == 0) { const float* lv = F.in[I_EV_LAM]; const float a = wave_sum(lv[F.lane] * lv[64 + F.lane]), b = wave_sum(lv[128 + F.lane] * lv[192 + F.lane]);
                if (F.lane == 0) SC[0] = expf(a) - expf(b) + LAM_INIT0; }
            { const float t0 = F.in[I_LBT][F.tid], t1 = F.in[I_LBT][512 + F.tid]; SC[256 + F.tid] = 1.0f / (1.0f + expf(t0 - t1)); }
        }
    }
    {
        LAS float* scr = (LAS float*)(F.lds + F.wave * 16384);
        transpose_weight(F, F.in[I_EV_WIN], 1024, EV_IN, (bf16*)(F.ws + WS_W_IN0), 1024, scr);
        transpose_weight(F, F.in[I_EV_WOUT], 1024, 1024, (bf16*)(F.ws + WS_W_OUT0), 1024, scr);
        transpose_weight(F, F.in[I_EV_W1], 1024, 2 * DFF, (bf16*)(F.ws + WS_W_FF1), 1024, scr);
        transpose_weight(F, F.in[I_EV_W2], DFF, 1024, (bf16*)(F.ws + WS_W_FF2), DFF, scr);
        transpose_weight(F, F.in[I_OD_WIN], 1024, OD_IN, (bf16*)(F.ws + WS_W_IN1), 1024, scr);
        transpose_weight(F, F.in[I_OD_WUQ], 256, 768, (bf16*)(F.ws + WS_W_UQ), 256, scr);
        transpose_weight(F, F.in[I_OD_WUKV], 128, 1024, (bf16*)(F.ws + WS_W_UKV), 256, scr);
        transpose_weight(F, F.in[I_OD_WOUT], 1024, 1024, (bf16*)(F.ws + WS_W_OUT1), 1024, scr);
        for (int e = 0; e < NEXP; ++e) {
            transpose_weight(F, F.in[I_OD_EW1] + (size_t)e * 1024 * 2 * DFF, 1024, 2 * DFF, (bf16*)(F.ws + WS_EXP_W1) + (size_t)e * 2 * DFF * 1024, 1024, scr);
            transpose_weight(F, F.in[I_OD_EW2] + (size_t)e * DFF * 1024, DFF, 1024, (bf16*)(F.ws + WS_EXP_W2) + (size_t)e * 1024 * DFF, DFF, scr);
        }
        zero_bytes16(F, F.ws + WS_W_IN0 + (size_t)EV_IN * 1024 * 2, (size_t)(EV_INP - EV_IN) * 1024 * 2);
        zero_bytes16(F, F.ws + WS_W_IN1 + (size_t)OD_IN * 1024 * 2, (size_t)(OD_INP - OD_IN) * 1024 * 2);
        { const v4u z = {0u, 0u, 0u, 0u};
          for (int i = blockIdx.x * NTHR + F.tid; i < 1024 * 16; i += F.G * NTHR) *(GAS v4u*)(F.ws + WS_W_UKV + (size_t)(i >> 4) * 512 + 256 + (i & 15) * 16) = z; }
    }
}

__device__ __forceinline__ void store_bf16x4(bf16* p, f32x4 v) { *(GAS unsigned long long*)p = (unsigned long long)pk2(v.x, v.y) | ((unsigned long long)pk2(v.z, v.w) << 32); }
__device__ __forceinline__ void p_modulate0(Frame& F) {
    const float* MOD = (const float*)(F.ws + WS_MOD); bf16* H = (bf16*)(F.ws + WS_H);
    for (int m = F.gw; m < MT; m += F.NGW) {
        const float* xr = src_row(F, m); const float* mr = MOD + (size_t)(0 * 9 + mod_row(m)) * 6144;
#pragma unroll
        for (int j = 0; j < 4; ++j) { const int c = 4 * F.lane + 256 * j; const f32x4 v = *(const f32x4*)(xr + c), sh = *(const f32x4*)(mr + c), sc = *(const f32x4*)(mr + 1024 + c);
            store_bf16x4(H + (size_t)m * DM + c, v * (1.0f + sc) + sh); }
    }
}

__device__ __forceinline__ void p_post0(Frame& F) {
    bf16* P = (bf16*)(F.ws + WS_P); float* GK = (float*)(F.ws + WS_GK);
    const float* COS = (const float*)(F.ws + WS_COS); const float* SIN = (const float*)(F.ws + WS_SIN);
    for (int m = blockIdx.x; m < MT; m += F.G) {
        bf16* pr = P + (size_t)m * EV_INP;
        if (m < ML) { const int t = m & (SEQ - 1), i = F.tid & 31; const float cs = COS[t * 32 + i], sn = SIN[t * 32 + i];
            const unsigned w = *(const unsigned*)(pr + 2 * F.tid); const float t0 = bflo(w), t1 = bfhi(w);
            *(unsigned*)(pr + 2 * F.tid) = pk2(t0 * cs - t1 * sn, t0 * sn + t1 * cs); }
        { const int d = F.tid >> 8, k = F.tid & 255; float acc = F.in[I_EV_GKB][d * 256 + k];
#pragma unroll
          for (int r = 0; r < 16; ++r) acc += bf2f(pr[EV_LRF + d * 16 + r]) * F.in[I_EV_GKW2][(d * 16 + r) * 256 + k];
          GK[((size_t)d * MT + m) * 256 + k] = logsigmoidf_(acc) * (1.0f / 16.0f); }
    }
}

__device__ __forceinline__ int key_row(int b, int j) { return j < CTXL ? ML + b * CTXL + j : b * SEQ + (j - CTXL); }
__device__ __forceinline__ float dot64_lds(const bf16* kp, const LAS float* q) {
    float s = 0.f;
#pragma unroll
    for (int c = 0; c < 8; ++c) { const v4u kv = *(const GAS v4u*)(kp + 8 * c); const LAS float* qq = q + 8 * c;
        s += bflo(kv.x) * qq[0] + bfhi(kv.x) * qq[1] + bflo(kv.y) * qq[2] + bfhi(kv.y) * qq[3] + bflo(kv.z) * qq[4] + bfhi(kv.z) * qq[5] + bflo(kv.w) * qq[6] + bfhi(kv.w) * qq[7]; }
    return s;
}
constexpr int ATT_WAVE_BYTES = 18944;
static_assert(8 * ATT_WAVE_BYTES <= SCR_BYTES, "attention scratch");

__device__ __forceinline__ void p_attn0(Frame& F) {
    const bf16* P = (const bf16*)(F.ws + WS_P); float* OA = (float*)(F.ws + WS_OA);
    const float lam = *(const float*)(F.ws + WS_SCAL);
    LAS float* w1 = (LAS float*)(F.lds + F.wave * ATT_WAVE_BYTES); LAS float* w2 = w1 + 2304; LAS float* q = w2 + 2304;
    for (int it = F.gw; it < MT * 4; it += F.NGW) {
        const int m = it >> 2, h = it & 3;
        const int b = m < ML ? (m >> 11) : ((m - ML) >> 8), NK = m < ML ? (CTXL + SEQ) : CTXL;
        const bf16* qp = P + (size_t)m * EV_INP + EV_QA + h * 128;
        q[F.lane] = bf2f(qp[F.lane]); q[64 + F.lane] = bf2f(qp[64 + F.lane]);
        LDS_WAIT(); asm volatile("" ::: "memory");
        float mx1 = -3.0e38f, mx2 = -3.0e38f;
        for (int j = F.lane; j < NK; j += 64) { const bf16* kp = P + (size_t)key_row(b, j) * EV_INP + EV_KA + h * 128;
            const float s1 = dot64_lds(kp, q) * DA_SCALE, s2 = dot64_lds(kp + 64, q + 64) * DA_SCALE; w1[j] = s1; w2[j] = s2; mx1 = fmaxf(mx1, s1); mx2 = fmaxf(mx2, s2); }
        mx1 = wave_max(mx1); mx2 = wave_max(mx2);
        float sum1 = 0.f, sum2 = 0.f;
        for (int j = F.lane; j < NK; j += 64) { const float e1 = __expf(w1[j] - mx1), e2 = __expf(w2[j] - mx2); w1[j] = e1; w2[j] = e2; sum1 += e1; sum2 += e2; }
        const float inv1 = 1.0f / wave_sum(sum1), c2 = lam / wave_sum(sum2);
        for (int j = F.lane; j < NK; j += 64) w1[j] = w1[j] * inv1 - c2 * w2[j];
        LDS_WAIT(); asm volatile("" ::: "memory");
        float a0 = 0.f, a1 = 0.f;
        const bf16* vbase = P + EV_VA + h * 128 + 2 * F.lane;
        for (int j = 0; j < NK; j += 4) {
            unsigned vv[4]; float ww[4];
#pragma unroll
            for (int u = 0; u < 4; ++u) { vv[u] = *(const GAS unsigned*)(vbase + (size_t)key_row(b, j + u) * EV_INP); ww[u] = w1[j + u]; }
#pragma unroll
            for (int u = 0; u < 4; ++u) { a0 += ww[u] * bflo(vv[u]); a1 += ww[u] * bfhi(vv[u]); }
        }
        *(float2*)(OA + (size_t)m * 512 + h * 128 + 2 * F.lane) = make_float2(a0, a1);
        LDS_WAIT(); asm volatile("" ::: "memory");
    }
}

__device__ __forceinline__ void p_attn1(Frame& F) {
    const bf16* P = (const bf16*)(F.ws + WS_P); const bf16* Q = (const bf16*)(F.ws + WS_Q); const bf16* KV = (const bf16*)(F.ws + WS_KV); float* OM = (float*)(F.ws + WS_OM);
    const float* COS = (const float*)(F.ws + WS_COS); const float* SIN = (const float*)(F.ws + WS_SIN);
    LAS float* w1 = (LAS float*)(F.lds + F.wave * ATT_WAVE_BYTES); LAS float* q = w1 + 2304;
    for (int it = F.gw; it < ML * 4; it += F.NGW) {
        const int m = it >> 2, h = it & 3, b = m >> 11, NK = CTXL + SEQ, t = m & (SEQ - 1);
        const bf16* qp = Q + (size_t)m * 768 + h * 192;
        q[F.lane] = bf2f(qp[F.lane]); q[64 + F.lane] = bf2f(qp[64 + F.lane]);
        if (F.lane < 32) { const float t0 = bf2f(qp[128 + 2 * F.lane]), t1 = bf2f(qp[129 + 2 * F.lane]), cs = COS[t * 32 + F.lane], sn = SIN[t * 32 + F.lane];
            q[128 + 2 * F.lane] = t0 * cs - t1 * sn; q[129 + 2 * F.lane] = t0 * sn + t1 * cs; }
        LDS_WAIT(); asm volatile("" ::: "memory");
        float mx = -3.0e38f;
        for (int j = F.lane; j < NK; j += 64) { const int kr = key_row(b, j); const bf16* kn = KV + (size_t)kr * 1024 + h * 256; const bf16* kp = P + (size_t)kr * OD_INP + OD_KR;
            const float s = (dot64_lds(kn, q) + dot64_lds(kn + 64, q + 64) + dot64_lds(kp, q + 128)) * MLA_SCALE; w1[j] = s; mx = fmaxf(mx, s); }
        mx = wave_max(mx);
        float sum = 0.f;
        for (int j = F.lane; j < NK; j += 64) { const float e = __expf(w1[j] - mx); w1[j] = e; sum += e; }
        const float inv = 1.0f / wave_sum(sum);
        LDS_WAIT(); asm volatile("" ::: "memory");
        float a0 = 0.f, a1 = 0.f;
        const bf16* vbase = KV + h * 256 + 128 + 2 * F.lane;
        for (int j = 0; j < NK; j += 4) {
            unsigned vv[4]; float ww[4];
#pragma unroll
            for (int u = 0; u < 4; ++u) { vv[u] = *(const GAS unsigned*)(vbase + (size_t)key_row(b, j + u) * 1024); ww[u] = w1[j + u]; }
#pragma unroll
            for (int u = 0; u < 4; ++u) { a0 += ww[u] * bflo(vv[u]); a1 += ww[u] * bfhi(vv[u]); }
        }
        *(float2*)(OM + (size_t)m * 512 + h * 128 + 2 * F.lane) = make_float2(a0 * inv, a1 * inv);
        LDS_WAIT(); asm volatile("" ::: "memory");
    }
}

__device__ __forceinline__ int scan_row(int b, int d, int s) {
    if (s < CTXL) return ML + b * CTXL + (d ? (CTXL - 1 - s) : s);
    const int t = s - CTXL; return b * SEQ + (d ? (SEQ - 1 - t) : t);
}
__device__ __forceinline__ void p_scan0(Frame& F) {
    const bf16* P = (const bf16*)(F.ws + WS_P); const float* GK = (const float*)(F.ws + WS_GK);
    LAS float* qL = (LAS float*)F.lds; LAS float* kL = qL + 2048; LAS float* eL = kL + 2048; LAS float* vL = eL + 2048; LAS float* part = vL + 4096;
    const int v = F.tid & 127, kg = F.tid >> 7;
    for (int ch = blockIdx.x; ch < 64; ch += F.G) {
        const int b = ch >> 3, h = (ch >> 1) & 3, d = ch & 1;
        float* OB = (float*)(F.ws + (d ? WS_OBB : WS_OBF));
        float S[16];
#pragma unroll
        for (int i = 0; i < 16; ++i) S[i] = 0.f;
        for (int c = 0; c < (CTXL + SEQ) / 32; ++c) {
            for (int i = F.tid; i < 32 * 64; i += NTHR) { const int r = i >> 6, k = i & 63; const size_t row = (size_t)scan_row(b, d, c * 32 + r);
                qL[i] = bf2f(P[row * EV_INP + EV_QB + h * 64 + k]) * GLA_QSCALE; kL[i] = bf2f(P[row * EV_INP + EV_KB + h * 64 + k]); eL[i] = __expf(GK[((size_t)d * MT + row) * 256 + h * 64 + k]); }
            for (int i = F.tid; i < 32 * 128; i += NTHR) { const int r = i >> 7, vv = i & 127; const size_t row = (size_t)scan_row(b, d, c * 32 + r); vL[i] = bf2f(P[row * EV_INP + EV_VB + h * 128 + vv]); }
            __syncthreads();
            for (int r = 0; r < 32; ++r) { const float vv = vL[r * 128 + v]; float po = 0.f;
#pragma unroll
                for (int kk = 0; kk < 16; ++kk) { const int k = kg * 16 + kk; S[kk] = S[kk] * eL[r * 64 + k] + kL[r * 64 + k] * vv; po += S[kk] * qL[r * 64 + k]; }
                part[(r * 4 + kg) * 128 + v] = po; }
            __syncthreads();
            for (int i = F.tid; i < 32 * 128; i += NTHR) { const int r = i >> 7, vv = i & 127; const size_t row = (size_t)scan_row(b, d, c * 32 + r);
                OB[row * 512 + h * 128 + vv] = (part[(r * 4 + 0) * 128 + vv] + part[(r * 4 + 1) * 128 + vv]) + (part[(r * 4 + 2) * 128 + vv] + part[(r * 4 + 3) * 128 + vv]); }
            __syncthreads();
        }
    }
}
__device__ __forceinline__ void p_scan1(Frame& F) {
    const bf16* P = (const bf16*)(F.ws + WS_P); const float* LB = (const float*)(F.ws + WS_SCAL) + 256;
    LAS float* qL = (LAS float*)F.lds; LAS float* fL = qL + 4096; LAS float* vL = fL + 4096; LAS float* part = vL + 4096;
    const int v = F.tid & 127, kg = F.tid >> 7;
    for (int ch = blockIdx.x; ch < 64; ch += F.G) {
        const int b = ch >> 3, h = (ch >> 1) & 3, d = ch & 1;
        float* OH = (float*)(F.ws + (d ? WS_OHB : WS_OHF));
        const int fcol = (d ? OD_HFB : OD_HFF) + h * 128;
        float S[32];
#pragma unroll
        for (int i = 0; i < 32; ++i) S[i] = 0.f;
        for (int c = 0; c < (CTXL + SEQ) / 32; ++c) {
            for (int i = F.tid; i < 32 * 128; i += NTHR) { const int r = i >> 7, k = i & 127; const size_t row = (size_t)scan_row(b, d, c * 32 + r); const bf16* pr = P + row * OD_INP;
                const float lb = LB[h * 128 + k];
                qL[i] = bf2f(pr[OD_HQ + h * 128 + k]); fL[i] = lb + (1.0f - lb) * sigmoidf_(bf2f(pr[fcol + k])); vL[i] = bf2f(pr[OD_HI + h * 128 + k]); }
            __syncthreads();
            for (int r = 0; r < 32; ++r) { const float vv = vL[r * 128 + v]; float po = 0.f;
#pragma unroll
                for (int kk = 0; kk < 32; ++kk) { const int k = kg * 32 + kk; const float f = fL[r * 128 + k]; S[kk] = S[kk] * f + (1.0f - f) * vv; po += S[kk] * qL[r * 128 + k]; }
                part[(r * 4 + kg) * 128 + v] = po; }
            __syncthreads();
            if (c >= CTXL / 32) {
                for (int i = F.tid; i < 32 * 128; i += NTHR) { const int r = i >> 7, vv = i & 127; const size_t row = (size_t)scan_row(b, d, c * 32 + r);
                    OH[row * 512 + h * 128 + vv] = (part[(r * 4 + 0) * 128 + vv] + part[(r * 4 + 1) * 128 + vv]) + (part[(r * 4 + 2) * 128 + vv] + part[(r * 4 + 3) * 128 + vv]); }
            }
            __syncthreads();
        }
    }
}

__device__ __forceinline__ void p_merge0(Frame& F) {
    const bf16* P = (const bf16*)(F.ws + WS_P); const float* OA = (const float*)(F.ws + WS_OA); const float* OBF = (const float*)(F.ws + WS_OBF); const float* OBB = (const float*)(F.ws + WS_OBB);
    bf16* A = (bf16*)(F.ws + WS_H);
    const int c = 2 * F.lane;
    for (int it = F.gw; it < MT * 8; it += F.NGW) {
        const int m = it >> 3, seg = it & 7; float o0, o1;
        if (seg < 4) { const float2 v = *(const float2*)(OA + (size_t)m * 512 + seg * 128 + c);
            const float r = rsqrtf(wave_sum(v.x * v.x + v.y * v.y) * (1.0f / 128.0f) + RMS_EPS) * (1.0f - LAM_INIT0);
            o0 = v.x * r * F.in[I_EV_SUBLN][c]; o1 = v.y * r * F.in[I_EV_SUBLN][c + 1]; }
        else { const int h = seg - 4; const float2 a = *(const float2*)(OBF + (size_t)m * 512 + h * 128 + c), bq = *(const float2*)(OBB + (size_t)m * 512 + h * 128 + c);
            const float v0 = a.x + bq.x, v1 = a.y + bq.y; const float r = rsqrtf(wave_sum(v0 * v0 + v1 * v1) * (1.0f / 128.0f) + RMS_EPS);
            const unsigned gw_ = *(const GAS unsigned*)(P + (size_t)m * EV_INP + EV_GB + h * 128 + c);
            o0 = v0 * r * F.in[I_EV_GLAG][c] * siluf_(bflo(gw_)); o1 = v1 * r * F.in[I_EV_GLAG][c + 1] * siluf_(bfhi(gw_)); }
        *(GAS unsigned*)(A + (size_t)m * DM + seg * 128 + c) = pk2(o0, o1);
    }
}
__device__ __forceinline__ void p_merge1(Frame& F) {
    const bf16* P = (const bf16*)(F.ws + WS_P); const float* OM = (const float*)(F.ws + WS_OM); const float* OHF = (const float*)(F.ws + WS_OHF); const float* OHB = (const float*)(F.ws + WS_OHB);
    bf16* A = (bf16*)(F.ws + WS_H);
    const int c = 2 * F.lane;
    for (int it = F.gw; it < ML * 8; it += F.NGW) {
        const int m = it >> 3, seg = it & 7; float o0, o1;
        if (seg < 4) { const float2 v = *(const float2*)(OM + (size_t)m * 512 + seg * 128 + c); o0 = v.x; o1 = v.y; }
        else { const int h = seg - 4; const float2 a = *(const float2*)(OHF + (size_t)m * 512 + h * 128 + c), bq = *(const float2*)(OHB + (size_t)m * 512 + h * 128 + c);
            const float v0 = a.x + bq.x, v1 = a.y + bq.y; const float r = rsqrtf(wave_sum(v0 * v0 + v1 * v1) * (1.0f / 128.0f) + RMS_EPS);
            const unsigned gw_ = *(const GAS unsigned*)(P + (size_t)m * OD_INP + OD_HG + h * 128 + c);
            o0 = v0 * r * F.in[I_OD_HGG][c] * siluf_(bflo(gw_)); o1 = v1 * r * F.in[I_OD_HGG][c + 1] * siluf_(bfhi(gw_)); }
        *(GAS unsigned*)(A + (size_t)m * DM + seg * 128 + c) = pk2(o0, o1);
    }
}

template <bool BASE_SRC, bool DO_H, bool ROUTER>
__device__ __forceinline__ void p_ln(Frame& F, int nrows, const float* base, const float* y, int l, int gate_chunk, int ln_slot, float* xout, int hl, int hsc, int hsh) {
    const float* MOD = (const float*)(F.ws + WS_MOD); bf16* H = (bf16*)(F.ws + WS_H);
    const float* G = F.in[I_LNG] + (size_t)(l * 2 + ln_slot) * DM; const float* Bb = F.in[I_LNB] + (size_t)(l * 2 + ln_slot) * DM;
    for (int m = F.gw; m < nrows; m += F.NGW) {
        const float* br = BASE_SRC ? src_row(F, m) : base + (size_t)m * DM; const float* yr = y + (size_t)m * DM;
        const float* mr = MOD + (size_t)(l * 9 + mod_row(m)) * 6144 + gate_chunk * 1024;
        f32x4 t[4]; float s = 0.f;
#pragma unroll
        for (int j = 0; j < 4; ++j) { const int c = 4 * F.lane + 256 * j; t[j] = *(const f32x4*)(br + c) * DN_ALPHA + *(const f32x4*)(mr + c) * *(const f32x4*)(yr + c); s += (t[j].x + t[j].y) + (t[j].z + t[j].w); }
        const float mean = wave_sum(s) * (1.0f / DM); float s2 = 0.f;
#pragma unroll
        for (int j = 0; j < 4; ++j) { t[j] = t[j] - mean; s2 += (t[j].x * t[j].x + t[j].y * t[j].y) + (t[j].z * t[j].z + t[j].w * t[j].w); }
        const float rstd = rsqrtf(wave_sum(s2) * (1.0f / DM) + LN_EPS);
        float lg[8];
#pragma unroll
        for (int e = 0; e < 8; ++e) lg[e] = 0.f;
#pragma unroll
        for (int j = 0; j < 4; ++j) { const int c = 4 * F.lane + 256 * j; const f32x4 xo = t[j] * rstd * *(const f32x4*)(G + c) + *(const f32x4*)(Bb + c);
            if (xout) *(f32x4*)(xout + (size_t)m * DM + c) = xo;
            if (DO_H) { const float* hr = MOD + (size_t)(hl * 9 + mod_row(m)) * 6144; const f32x4 hv = xo * (1.0f + *(const f32x4*)(hr + hsc * 1024 + c)) + *(const f32x4*)(hr + hsh * 1024 + c);
                store_bf16x4(H + (size_t)m * DM + c, hv);
                if (ROUTER) { const float* wr = F.in[I_OD_ROUTER] + (size_t)c * 8;
#pragma unroll
                    for (int q = 0; q < 4; ++q) { const f32x4 wa = *(const f32x4*)(wr + q * 8), wb = *(const f32x4*)(wr + q * 8 + 4); const float hq = hv[q];
                        lg[0] += hq * wa.x; lg[1] += hq * wa.y; lg[2] += hq * wa.z; lg[3] += hq * wa.w; lg[4] += hq * wb.x; lg[5] += hq * wb.y; lg[6] += hq * wb.z; lg[7] += hq * wb.w; } } }
        }
        if (ROUTER) {
#pragma unroll
            for (int e = 0; e < 8; ++e) lg[e] = wave_sum(lg[e]);
            int i0 = 0; float v0 = lg[0];
#pragma unroll
            for (int e = 1; e < 8; ++e) if (lg[e] > v0) { v0 = lg[e]; i0 = e; }
            int i1 = -1; float v1 = -3.0e38f;
#pragma unroll
            for (int e = 0; e < 8; ++e) if (e != i0 && lg[e] > v1) { v1 = lg[e]; i1 = e; }
            const float g0 = 1.0f / (1.0f + __expf(v1 - v0)), g1 = 1.0f - g0;
            if (F.lane == 0) { v4u o; o.x = (unsigned)i0; o.y = (unsigned)i1; o.z = __float_as_uint(g0); o.w = __float_as_uint(g1); *(GAS v4u*)(F.ws + WS_ROUTE + (size_t)m * 16) = o; }
        }
    }
}

__device__ __forceinline__ void p_post1(Frame& F) {
    bf16* P = (bf16*)(F.ws + WS_P); bf16* NQ = (bf16*)(F.ws + WS_NQ); bf16* NKV = (bf16*)(F.ws + WS_NKV);
    const float* COS = (const float*)(F.ws + WS_COS); const float* SIN = (const float*)(F.ws + WS_SIN);
    for (int m = F.gw; m < MT; m += F.NGW) {
        bf16* pr = P + (size_t)m * OD_INP;
        if (m < ML) {
            const int c = 4 * F.lane; const unsigned long long w = *(const GAS unsigned long long*)(pr + OD_CQ + c);
            const float v0 = bflo((unsigned)w), v1 = bfhi((unsigned)w), v2 = bflo((unsigned)(w >> 32)), v3 = bfhi((unsigned)(w >> 32));
            const float r = rsqrtf(wave_sum((v0 * v0 + v1 * v1) + (v2 * v2 + v3 * v3)) * (1.0f / 256.0f) + RMS_EPS);
            const f32x4 g = *(const f32x4*)(F.in[I_OD_QNG] + c);
            store_bf16x4(NQ + (size_t)m * 256 + c, (f32x4){v0 * r * g.x, v1 * r * g.y, v2 * r * g.z, v3 * r * g.w});
        }
        { const int c = 2 * F.lane; const unsigned w = *(const GAS unsigned*)(pr + OD_CKV + c); const float v0 = bflo(w), v1 = bfhi(w);
          const float r = rsqrtf(wave_sum(v0 * v0 + v1 * v1) * (1.0f / 128.0f) + RMS_EPS);
          *(GAS unsigned*)(NKV + (size_t)m * 256 + c) = pk2(v0 * r * F.in[I_OD_KVNG][c], v1 * r * F.in[I_OD_KVNG][c + 1]);
          *(GAS unsigned*)(NKV + (size_t)m * 256 + 128 + c) = 0u; }
        if (m < ML && F.lane < 32) { const int t = m & (SEQ - 1); const float cs = COS[t * 32 + F.lane], sn = SIN[t * 32 + F.lane];
            const unsigned w = *(const GAS unsigned*)(pr + OD_KR + 2 * F.lane); const float t0 = bflo(w), t1 = bfhi(w);
            *(GAS unsigned*)(pr + OD_KR + 2 * F.lane) = pk2(t0 * cs - t1 * sn, t0 * sn + t1 * cs); }
    }
}

__device__ __forceinline__ void p_act(Frame& F, int nrows) {
    const bf16* U = (const bf16*)(F.ws + WS_U); bf16* ACT = (bf16*)(F.ws + WS_ACT);
    const size_t n8 = (size_t)nrows * (DFF / 8);
    for (size_t i = (size_t)blockIdx.x * NTHR + F.tid; i < n8; i += (size_t)F.G * NTHR) {
        const size_t m = i / (DFF / 8); const int j = (int)(i % (DFF / 8)) * 8;
        const v4u g = *(const GAS v4u*)(U + m * (2 * DFF) + j), u = *(const GAS v4u*)(U + m * (2 * DFF) + DFF + j);
        v4u o; o.x = pk2(siluf_(bflo(g.x)) * bflo(u.x), siluf_(bfhi(g.x)) * bfhi(u.x)); o.y = pk2(siluf_(bflo(g.y)) * bflo(u.y), siluf_(bfhi(g.y)) * bfhi(u.y));
        o.z = pk2(siluf_(bflo(g.z)) * bflo(u.z), siluf_(bfhi(g.z)) * bfhi(u.z)); o.w = pk2(siluf_(bflo(g.w)) * bflo(u.w), siluf_(bfhi(g.w)) * bfhi(u.w));
        *(GAS v4u*)(ACT + m * DFF + j) = o;
    }
}
__device__ __forceinline__ void p_moe_acc(Frame& F, int e) {
    const float* Fe = (const float*)(F.ws + WS_YF); float* FS = (float*)(F.ws + WS_FSUM);
    for (size_t i = (size_t)blockIdx.x * NTHR + F.tid; i < (size_t)ML * 256; i += (size_t)F.G * NTHR) {
        const size_t m = i >> 8; const v4u r = *(const GAS v4u*)(F.ws + WS_ROUTE + m * 16);
        const float comb = ((int)r.x == e ? __uint_as_float(r.z) : 0.f) + ((int)r.y == e ? __uint_as_float(r.w) : 0.f);
        f32x4 acc = *(const f32x4*)(Fe + i * 4) * comb;
        if (e > 0) acc = acc + *(const f32x4*)(FS + i * 4);
        *(f32x4*)(FS + i * 4) = acc;
    }
}

template <class Epi> __device__ __forceinline__ void run_gemm(Frame& F, const bf16* A, const bf16* Bt, int M, int N, int K, const Epi& E) {
    pg8::Gemm g{A, Bt, M, N, K}; pg8::StaticOrder S; S.init(M, N, F.G, (int)blockIdx.x);
    pg8::gemm_phase<Epi, pg8::StaticOrder, true, true>(F.lds, g, S, E);
}

constexpr int NPHASE = 55;
struct Args { const float* in[28]; float* out; unsigned char* ws; int ph_lo, ph_hi, li, pad; };
__global__ void __launch_bounds__(NTHR, 2) fwd(Args args) {
    extern __shared__ __attribute__((aligned(16))) unsigned char lds[];
    Frame F;
    F.lds = (LAS unsigned char*)lds; F.MISC = (volatile LAS unsigned*)(F.lds + MISC_OFF);
    F.tid = threadIdx.x; F.lane = F.tid & 63; F.wave = __builtin_amdgcn_readfirstlane(F.tid >> 6);
    F.G = gridDim.x; F.gw = blockIdx.x * NWAVES + F.wave; F.NGW = F.G * NWAVES;
    F.ws = args.ws; F.ctl = (gu32*)(args.ws + WS_CTL); F.out = args.out;
#pragma unroll
    for (int i = 0; i < 28; ++i) F.in[i] = args.in[i];
    for (int u = F.tid; u < (LDS_BYTES - MISC_OFF) / 4; u += NTHR) ((LAS unsigned*)(F.lds + MISC_OFF))[u] = 0u;
    __syncthreads();
    XcdBarrier bar = xcd_barrier_post((unsigned*)(F.ctl + CW_BAR) + args.li * XCD_BAR_WORDS, F.MISC + 8);
    const int lo = args.ph_lo, hi = args.ph_hi;
#define IN(k) (lo <= (k) && (k) < hi && (frame_refresh(F), true))
#define SEAM(k) do { if (IN(k) && IN((k) + 1)) xcd_barrier(bar); } while (0)
    bf16* const Hb = (bf16*)(F.ws + WS_H); bf16* const Pb = (bf16*)(F.ws + WS_P); bf16* const Ub = (bf16*)(F.ws + WS_U); bf16* const ACTb = (bf16*)(F.ws + WS_ACT);
    float* const YF = (float*)(F.ws + WS_YF); float* const X1 = (float*)(F.ws + WS_X1); float* const X2 = (float*)(F.ws + WS_X2);

    if (IN(0)) { p0_prologue(F); } SEAM(0);
    if (IN(1)) { p_modulate0(F); } SEAM(1);
    if (IN(2)) { pg8::EpiBf16<0> E{Pb, EV_INP, nullptr, 0, 0, 1.f}; run_gemm(F, Hb, (const bf16*)(F.ws + WS_W_IN0), MT, EV_INP, DM, E); } SEAM(2);
    if (IN(3)) { p_post0(F); } SEAM(3);
    if (IN(4)) { p_attn0(F); } SEAM(4);
    if (IN(5)) { p_scan0(F); } SEAM(5);
    if (IN(6)) { p_merge0(F); } SEAM(6);
    if (IN(7)) { pg8::EpiF32 E{YF, DM, nullptr}; run_gemm(F, Hb, (const bf16*)(F.ws + WS_W_OUT0), MT, DM, DM, E); } SEAM(7);
    if (IN(8)) { p_ln<true, true, false>(F, MT, nullptr, YF, 0, 2, 0, X1, 0, 4, 3); } SEAM(8);
    if (IN(9)) { pg8::EpiBf16<0> E{Ub, 2 * DFF, nullptr, 0, 0, 1.f}; run_gemm(F, Hb, (const bf16*)(F.ws + WS_W_FF1), MT, 2 * DFF, DM, E); } SEAM(9);
    if (IN(10)) { p_act(F, MT); } SEAM(10);
    if (IN(11)) { pg8::EpiF32 E{YF, DM, nullptr}; run_gemm(F, ACTb, (const bf16*)(F.ws + WS_W_FF2), MT, DM, DFF, E); } SEAM(11);
    if (IN(12)) { p_ln<false, true, false>(F, MT, X1, YF, 0, 5, 1, X2, 1, 1, 0); } SEAM(12);
    if (IN(13)) { pg8::EpiBf16<0> E{Pb, OD_INP, nullptr, 0, 0, 1.f}; run_gemm(F, Hb, (const bf16*)(F.ws + WS_W_IN1), MT, OD_INP, DM, E); } SEAM(13);
    if (IN(14)) { p_post1(F); } SEAM(14);
    if (IN(15)) { pg8::EpiBf16<0> E{(bf16*)(F.ws + WS_Q), 768, nullptr, 0, 0, 1.f}; run_gemm(F, (const bf16*)(F.ws + WS_NQ), (const bf16*)(F.ws + WS_W_UQ), ML, 768, 256, E); } SEAM(15);
    if (IN(16)) { pg8::EpiBf16<0> E{(bf16*)(F.ws + WS_KV), 1024, nullptr, 0, 0, 1.f}; run_gemm(F, (const bf16*)(F.ws + WS_NKV), (const bf16*)(F.ws + WS_W_UKV), MT, 1024, 256, E); } SEAM(16);
    if (IN(17)) { p_attn1(F); } SEAM(17);
    if (IN(18)) { p_scan1(F); } SEAM(18);
    if (IN(19)) { p_merge1(F); } SEAM(19);
    if (IN(20)) { pg8::EpiF32 E{YF, DM, nullptr}; run_gemm(F, Hb, (const bf16*)(F.ws + WS_W_OUT1), ML, DM, DM, E); } SEAM(20);
    if (IN(21)) { p_ln<false, true, true>(F, ML, X2, YF, 1, 2, 0, X1, 1, 4, 3); } SEAM(21);
    for (int e = 0; e < NEXP; ++e) {
        const int p = 22 + 4 * e;
        if (IN(p)) { pg8::EpiBf16<0> E{Ub, 2 * DFF, nullptr, 0, 0, 1.f}; run_gemm(F, Hb, (const bf16*)(F.ws + WS_EXP_W1) + (size_t)e * 2 * DFF * DM, ML, 2 * DFF, DM, E); } SEAM(p);
        if (IN(p + 1)) { p_act(F, ML); } SEAM(p + 1);
        if (IN(p + 2)) { pg8::EpiF32 E{YF, DM, nullptr}; run_gemm(F, ACTb, (const bf16*)(F.ws + WS_EXP_W2) + (size_t)e * DM * DFF, ML, DM, DFF, E); } SEAM(p + 2);
        if (IN(p + 3)) { p_moe_acc(F, e); } SEAM(p + 3);
    }
    if (IN(54)) { p_ln<false, false, false>(F, ML, X1, (const float*)(F.ws + WS_FSUM), 1, 5, 1, F.out, 0, 0, 0); }
#undef IN
#undef SEAM
}

#ifndef MK_ONE_LAUNCH
#define MK_ONE_LAUNCH 0
#endif
extern "C" void kernel_launch(void* const* d_in, const int* in_sizes, int n_in, void* d_out, int out_size, void* d_ws, size_t ws_size, hipStream_t stream) {
    static int grid = 0;
    if (grid == 0) {
        if (n_in != 28 || in_sizes[0] != ML * DM || out_size != ML * DM || ws_size < WS_END) { fprintf(stderr, "kernel_launch: unexpected shapes (n_in %d, in0 %d, out %d, ws %zu)\n", n_in, n_in > 0 ? in_sizes[0] : -1, out_size, ws_size); grid = -1; return; }
        int dev = 0, cus = 0;
        if (hipGetDevice(&dev) != hipSuccess || hipDeviceGetAttribute(&cus, hipDeviceAttributeMultiprocessorCount, dev) != hipSuccess) { grid = -1; return; }
        if (hipFuncSetAttribute((const void*)fwd, hipFuncAttributeMaxDynamicSharedMemorySize, LDS_BYTES) != hipSuccess) { fprintf(stderr, "kernel_launch: hipFuncSetAttribute failed\n"); grid = -1; return; }
        int per_cu = 0;
        if (hipOccupancyMaxActiveBlocksPerMultiprocessor(&per_cu, (const void*)fwd, NTHR, LDS_BYTES) != hipSuccess || per_cu < 1) fprintf(stderr, "kernel_launch: occupancy query reports %d\n", per_cu);
        (void)hipGetLastError();
        grid = cus;
    }
    if (grid < 0) return;
    if (hipMemsetAsync((char*)d_ws + WS_CTL, 0, CTL_ZERO_BYTES, stream) != hipSuccess) return;
    Args a{};
    for (int i = 0; i < 28; ++i) a.in[i] = (const float*)d_in[i];
    a.out = (float*)d_out; a.ws = (unsigned char*)d_ws; a.pad = 0;
#if MK_ONE_LAUNCH
    a.ph_lo = 0; a.ph_hi = NPHASE; a.li = 0;
    hipLaunchKernelGGL(fwd, dim3(grid), dim3(NTHR), LDS_BYTES, stream, a);
#else
    for (int p = 0; p < NPHASE; ++p) { a.ph_lo = p; a.ph_hi = p + 1; a.li = p; hipLaunchKernelGGL(fwd, dim3(grid), dim3(NTHR), LDS_BYTES, stream, a); }
#endif
    const hipError_t le = hipPeekAtLastError();
    if (le != hipSuccess) fprintf(stderr, "kernel_launch: launch failed: %s\n", hipGetErrorName(le));
}
```

```cpp
#include <hip/hip_runtime.h>
#include <cstdio>
#include <cstdint>
#define DUPK -1
namespace pg8 {
#define PG8_LAS __attribute__((address_space(3)))
typedef unsigned short bf16_t;
typedef short bf16x8 __attribute__((ext_vector_type(8)));
typedef float f32x4 __attribute__((ext_vector_type(4)));
typedef unsigned u32x4 __attribute__((ext_vector_type(4)));
constexpr int BM = 256, BK = 64, HALF = 128, HTB = HALF * BK * 2  , STAGE_BYTES = 8 * HTB, NXCD = 8, WGM = 4;

__host__ __device__ __forceinline__ int lds_byte(int r, int c) { const int st = (r >> 4) * 2 + (c >> 5), rr = r & 15, cc = c & 31, ob = rr * 64 + cc * 2; return st * 1024 + (ob ^ (((ob >> 9) & 1) << 5)); }
__host__ __device__ __forceinline__ void stage_rc(int b, int& R, int& C) { const int st = b / 1024, sb = b % 1024, swz = sb ^ (((sb >> 9) & 1) << 5); R = (st >> 1) * 16 + swz / 64; C = (st & 1) * 32 + (swz % 64) / 2; }
__host__ __device__ __forceinline__ int perm32(int rho) { const int n = rho >> 4, i = rho & 15; return 8 * (i >> 2) + 4 * n + (i & 3); }

struct Unit { int pm, pn; };
struct Gemm { const bf16_t* A; const bf16_t* Bt; int M, N, K; int kt; };

struct StaticOrder {
    int nM, nN, nwg, G, c;
    __host__ __device__ void init(int M, int N, int G_, int c_) { nM = M / BM; nN = N / BM; nwg = nM * nN; G = G_; c = c_; }
    __host__ __device__ bool next(int i, Unit& u) const {
        const long L = (long)i * G + c; if (L >= nwg) return false;
        int wgid = (int)L; { const int q = nwg / NXCD, r = nwg % NXCD, xcd = wgid % NXCD, off = wgid / NXCD; wgid = (xcd < r ? xcd * (q + 1) : r * (q + 1) + (xcd - r) * q) + off; }
        const int nig = WGM * nN, gid = wgid / nig, fm = gid * WGM, gsz = (nM - fm) < WGM ? (nM - fm) : WGM;
        u.pm = fm + ((wgid % nig) % gsz); u.pn = (wgid % nig) / gsz; return true;
    }
    __device__ __forceinline__ void a_ready(const Unit&) const {}
    __device__ __forceinline__ void done(const Unit&) const {}
    __device__ __forceinline__ const char* bptr(const char* Bt, const Unit& u, size_t tstep) const { return Bt + (size_t)u.pn * tstep; }
    __device__ __forceinline__ const char* aptr(const char* A, const Unit& u, size_t tstep) const { return A + (size_t)u.pm * tstep; }
};
struct SplitOrder : StaticOrder {
    int mt; size_t kbytes;
    __device__ __forceinline__ const char* aptr(const char* A, const Unit& u, size_t tstep) const { return A + (size_t)(u.pm % mt) * tstep + (size_t)(u.pm / mt) * kbytes; }
    __device__ __forceinline__ const char* bptr(const char* Bt, const Unit& u, size_t tstep) const { return Bt + (size_t)u.pn * tstep + (size_t)(u.pm / mt) * kbytes; }
};
struct GroupedOrder : StaticOrder {
    int t1, t2, t3, t4, t5, t6, t7; size_t estride;
    int mt; size_t kbytes;
    __device__ __forceinline__ const char* aptr(const char* A, const Unit& u, size_t tstep) const { return mt ? A + (size_t)(u.pm % mt) * tstep + (size_t)(u.pm / mt) * kbytes : A + (size_t)u.pm * tstep; }
    __device__ __forceinline__ const char* bptr(const char* Bt, const Unit& u, size_t tstep) const {
        const int pm = mt ? u.pm % mt : u.pm; const size_t ko = mt ? (size_t)(u.pm / mt) * kbytes : 0;
        const int e = (pm >= t1) + (pm >= t2) + (pm >= t3) + (pm >= t4) + (pm >= t5) + (pm >= t6) + (pm >= t7);
        return Bt + (size_t)e * estride + (size_t)u.pn * tstep + ko; }
};


__device__ __forceinline__ unsigned cvt_pk_bf16(float lo, float hi) { unsigned r; asm volatile("v_cvt_pk_bf16_f32 %0, %1, %2" : "=v"(r) : "v"(lo), "v"(hi)); return r; }
typedef float f32x2 __attribute__((ext_vector_type(2)));
__device__ __forceinline__ f32x2 gelu_pk(f32x2 v) {
    const f32x2 av = __builtin_elementwise_abs(v), d = av * 0.2316418882f + 1.0f;
    f32x2 t; t.x = __builtin_amdgcn_rcpf(d.x); t.y = __builtin_amdgcn_rcpf(d.y);
    f32x2 q = t * 0.5307027145f + (-0.7265760135f); q = q * t + 0.7107068705f; q = q * t + (-0.142248368f); q = q * t + 0.127414796f; q = q * t;
    const f32x2 s = (v * v) * (-0.72134752044f);
    f32x2 e; e.x = __builtin_amdgcn_exp2f(s.x); e.y = __builtin_amdgcn_exp2f(s.y);
    const f32x2 m = v * (q * e), r = v - m;
    f32x2 o; o.x = v.x < 0.f ? m.x : r.x; o.y = v.y < 0.f ? m.y : r.y; return o;
}

template <int ACT  > struct EpiBf16 {
    static constexpr bool PERM = true, AFTER_DRAIN = false; static_assert(ACT == 0 || ACT == 1, "EpiBf16: ACT is 0 (none) or 1 (gelu_pk)");
    bf16_t* O; int ldc; const float* bias; int split_cols; size_t split_stride; float scale0;
    __device__ __forceinline__ void operator()(const f32x4 (&acc)[2][2][4][2], const Unit& u, int wr, int wc, int fr, int fq) const {
        const int row0 = u.pm * BM + wr * 64 + fr; int colt = u.pn * BM; bf16_t* base = O;
        float sc = 1.f; if (split_cols) { const int t = colt / split_cols; base += (size_t)t * split_stride; colt -= t * split_cols; if (t == 0) sc = scale0; }
        const int col0 = colt + wc * 32 + 8 * fq, bcol0 = u.pn * BM + wc * 32 + 8 * fq;
        f32x4 bv[2][2];
#pragma unroll
        for (int bj = 0; bj < 2; ++bj)
#pragma unroll
            for (int n = 0; n < 2; ++n) bv[bj][n] = bias ? *(const f32x4*)(bias + bcol0 + bj * HALF + 4 * n) : (f32x4){0.f, 0.f, 0.f, 0.f};
#pragma unroll
        for (int ai = 0; ai < 2; ++ai)
#pragma unroll
            for (int m = 0; m < 4; ++m) { bf16_t* rowp = base + (size_t)(row0 + ai * HALF + m * 16) * ldc + col0;
#pragma unroll
                for (int bj = 0; bj < 2; ++bj) { f32x4 v0 = acc[ai][bj][m][0] + bv[bj][0], v1 = acc[ai][bj][m][1] + bv[bj][1];
                    if (ACT == 1) { f32x2 a = gelu_pk((f32x2){v0[0], v0[1]}), b = gelu_pk((f32x2){v0[2], v0[3]}), c = gelu_pk((f32x2){v1[0], v1[1]}), d = gelu_pk((f32x2){v1[2], v1[3]});
                        v0 = (f32x4){a.x, a.y, b.x, b.y}; v1 = (f32x4){c.x, c.y, d.x, d.y}; }
                    v0 = v0 * sc; v1 = v1 * sc; u32x4 w; w.x = cvt_pk_bf16(v0[0], v0[1]); w.y = cvt_pk_bf16(v0[2], v0[3]); w.z = cvt_pk_bf16(v1[0], v1[1]); w.w = cvt_pk_bf16(v1[2], v1[3]);
                    *(u32x4*)(rowp + bj * HALF) = w; } }
    }
};
struct EpiF32 {
    static constexpr bool PERM = false, AFTER_DRAIN = false;
    float* C; int ldc; const float* bias;
    __device__ __forceinline__ void operator()(const f32x4 (&acc)[2][2][4][2], const Unit& u, int wr, int wc, int fr, int fq) const {
        const int row0 = u.pm * BM + wr * 64 + fr, col0 = u.pn * BM + wc * 32 + 4 * fq;
        f32x4 bv[2][2];
#pragma unroll
        for (int bj = 0; bj < 2; ++bj)
#pragma unroll
            for (int n = 0; n < 2; ++n) bv[bj][n] = bias ? *(const f32x4*)(bias + col0 + bj * HALF + n * 16) : (f32x4){0.f, 0.f, 0.f, 0.f};
#pragma unroll
        for (int ai = 0; ai < 2; ++ai)
#pragma unroll
            for (int m = 0; m < 4; ++m) { float* rowp = C + (size_t)(row0 + ai * HALF + m * 16) * ldc + col0;
#pragma unroll
                for (int bj = 0; bj < 2; ++bj)
#pragma unroll
                    for (int n = 0; n < 2; ++n) *(f32x4*)(rowp + bj * HALF + n * 16) = acc[ai][bj][m][n] + bv[bj][n]; }
    }
};
struct EpiSwiGLU {
    static constexpr bool PERM = true, AFTER_DRAIN = false;
    bf16_t* O; int ldc;
    __device__ __forceinline__ void operator()(const f32x4 (&acc)[2][2][4][2], const Unit& u, int wr, int wc, int fr, int fq) const {
        const int row0 = u.pm * BM + wr * 64 + fr, col0 = u.pn * HALF + wc * 32 + 8 * fq;
#pragma unroll
        for (int ai = 0; ai < 2; ++ai)
#pragma unroll
            for (int m = 0; m < 4; ++m) { bf16_t* rowp = O + (size_t)(row0 + ai * HALF + m * 16) * ldc + col0;
                f32x4 v0, v1;
#pragma unroll
                for (int i = 0; i < 4; ++i) { const float g0 = acc[ai][0][m][0][i], g1 = acc[ai][0][m][1][i];
                    v0[i] = g0 * __builtin_amdgcn_rcpf(1.0f + __builtin_amdgcn_exp2f(-1.4426950408889634f * g0)) * acc[ai][1][m][0][i]; v1[i] = g1 * __builtin_amdgcn_rcpf(1.0f + __builtin_amdgcn_exp2f(-1.4426950408889634f * g1)) * acc[ai][1][m][1][i]; }
                u32x4 w; w.x = cvt_pk_bf16(v0[0], v0[1]); w.y = cvt_pk_bf16(v0[2], v0[3]); w.z = cvt_pk_bf16(v1[0], v1[1]); w.w = cvt_pk_bf16(v1[2], v1[3]);
                *(u32x4*)rowp = w; }
    }
};

struct EpiRope {
    static constexpr bool PERM = true, AFTER_DRAIN = false;
    bf16_t* O; int ldc; const float* cs; const float* sn; int rope_tiles, rope_rows;
    __device__ __forceinline__ void operator()(const f32x4 (&acc)[2][2][4][2], const Unit& u, int wr, int wc, int fr, int fq) const {
        const int row0 = u.pm * BM + wr * 64 + fr, col0 = u.pn * BM + wc * 32 + 8 * fq;
        const bool rot = u.pn < rope_tiles && u.pm * BM < rope_rows;
        const int i0 = 16 * (wc & 1) + 4 * fq;
#pragma unroll
        for (int ai = 0; ai < 2; ++ai)
#pragma unroll
            for (int m = 0; m < 4; ++m) { const int row = row0 + ai * HALF + m * 16; bf16_t* rowp = O + (size_t)row * ldc + col0;
                f32x4 c4 = {1.f, 1.f, 1.f, 1.f}, s4 = {0.f, 0.f, 0.f, 0.f};
                if (rot) { const int t = row & 2047; c4 = *(const f32x4*)(cs + t * 32 + i0); s4 = *(const f32x4*)(sn + t * 32 + i0); }
#pragma unroll
                for (int bj = 0; bj < 2; ++bj) { const f32x4 v0 = acc[ai][bj][m][0], v1 = acc[ai][bj][m][1];
                    u32x4 w; w.x = cvt_pk_bf16(v0[0] * c4[0] - v0[1] * s4[0], v0[0] * s4[0] + v0[1] * c4[0]); w.y = cvt_pk_bf16(v0[2] * c4[1] - v0[3] * s4[1], v0[2] * s4[1] + v0[3] * c4[1]);
                    w.z = cvt_pk_bf16(v1[0] * c4[2] - v1[1] * s4[2], v1[0] * s4[2] + v1[1] * c4[2]); w.w = cvt_pk_bf16(v1[2] * c4[3] - v1[3] * s4[3], v1[2] * s4[3] + v1[3] * c4[3]);
                    *(u32x4*)(rowp + bj * HALF) = w; } }
    }
};
template <class Epi, class Sched, bool ALIGN_EPI = false, bool SP2 = false>
__device__ __forceinline__ void gemm_phase(PG8_LAS unsigned char* lds, const Gemm g, const Sched& S, const Epi& E) {
    int tid_ = threadIdx.x; asm volatile("" : "+v"(tid_));
    const int tid = tid_, wid = __builtin_amdgcn_readfirstlane(tid >> 6), lane = tid & 63, wr = wid >> 2, wc = wid & 3, fr = lane & 15, fq = lane >> 4;
    const int K = g.K, nt = g.kt ? g.kt : K / BK;
    unsigned voffA[2], voffB[2];
#pragma unroll
    for (int i = 0; i < 2; ++i) { int R, C; stage_rc(tid * 16 + i * 8192, R, C); const int Rb = Epi::PERM ? ((R & ~31) + perm32(R & 31)) : R;
        voffA[i] = (unsigned)(R * K + C) * 2u; voffB[i] = (unsigned)(Rb * K + C) * 2u; }
    const size_t kstep = (size_t)(BK * 2);
    const size_t hstep = (size_t)HALF * K * 2;
    const size_t tstep = 2 * hstep;
    const unsigned ldsw = (unsigned)wid * 1024u;
    const int aoff = lds_byte(wr * 64 + fr, fq * 8), boff = lds_byte(wc * 32 + fr, fq * 8);
#define PG8_SA(b, h) (((b) * 2 + (h)) * HTB)
#define PG8_SB(b, h) ((4 + (b) * 2 + (h)) * HTB)
#define PG8_STAGE(bufoff, gbase, voff) do { _Pragma("unroll") for (int _i = 0; _i < 2; ++_i) \
        __builtin_amdgcn_global_load_lds((const unsigned*)((const char*)(gbase) + (voff)[_i]), (PG8_LAS unsigned*)(lds + (bufoff) + ldsw + _i * 8192), 16, 0, 0); } while (0)
#define PG8_LDA(dst, b, h) do { _Pragma("unroll") for (int m = 0; m < 4; ++m) _Pragma("unroll") for (int k = 0; k < 2; ++k) dst[m][k] = *(const PG8_LAS bf16x8*)(lds + PG8_SA(b, h) + aoff + m * 2048 + k * 1024); } while (0)
#define PG8_LDB(dst, b, h) do { _Pragma("unroll") for (int n = 0; n < 2; ++n) _Pragma("unroll") for (int k = 0; k < 2; ++k) dst[n][k] = *(const PG8_LAS bf16x8*)(lds + PG8_SB(b, h) + boff + n * 2048 + k * 1024); } while (0)
#define PG8_MMA(ai, bj, At, Bt) do { __builtin_amdgcn_s_setprio(1); _Pragma("unroll") for (int m = 0; m < 4; ++m) _Pragma("unroll") for (int n = 0; n < 2; ++n) _Pragma("unroll") for (int k = 0; k < 2; ++k) \
        acc[ai][bj][m][n] = __builtin_amdgcn_mfma_f32_16x16x32_bf16(Bt[n][k], At[m][k], acc[ai][bj][m][n], 0, 0, 0); __builtin_amdgcn_s_setprio(0); } while (0)
#define PG8_WAIT_V(n) asm volatile("s_waitcnt vmcnt(" #n ")" ::: "memory")
#define PG8_WAIT_L(n) asm volatile("s_waitcnt lgkmcnt(" #n ")" ::: "memory")
#define PG8_BAR __builtin_amdgcn_s_barrier()
#define PG8_SCHED __builtin_amdgcn_sched_barrier(0)
    Unit cur, nxt; int ui = 0;
    if (!S.next(0, cur)) return;
    f32x4 acc[2][2][4][2];
#pragma unroll
    for (int a = 0; a < 2; ++a)
#pragma unroll
        for (int b = 0; b < 2; ++b)
#pragma unroll
            for (int m = 0; m < 4; ++m)
#pragma unroll
                for (int n = 0; n < 2; ++n) acc[a][b][m][n] = (f32x4){0.f, 0.f, 0.f, 0.f};
    bf16x8 At[4][2], B0[2][2], B1[2][2];
    const char* cA = S.aptr((const char*)g.A, cur, tstep); const char* cB = S.bptr((const char*)g.Bt, cur, tstep);
    S.a_ready(cur);
    if constexpr (SP2) {
        PG8_STAGE(PG8_SB(0, 0), cB, voffB); PG8_STAGE(PG8_SB(0, 1), cB + hstep, voffB); PG8_STAGE(PG8_SA(0, 0), cA, voffA); PG8_STAGE(PG8_SA(0, 1), cA + hstep, voffA);
        if (wr == 1) PG8_BAR;
        PG8_WAIT_V(2); PG8_BAR;
        PG8_STAGE(PG8_SB(1, 0), cB + kstep, voffB); PG8_STAGE(PG8_SA(1, 0), cA + kstep, voffA); PG8_STAGE(PG8_SB(1, 1), cB + hstep + kstep, voffB);
        PG8_WAIT_V(6); PG8_BAR;
    } else {
        PG8_STAGE(PG8_SB(0, 0), cB, voffB); PG8_STAGE(PG8_SA(0, 0), cA, voffA); PG8_STAGE(PG8_SB(0, 1), cB + hstep, voffB); PG8_STAGE(PG8_SA(0, 1), cA + hstep, voffA);
        if (wr == 1) PG8_BAR;
        PG8_WAIT_V(4); PG8_BAR;
        PG8_STAGE(PG8_SB(1, 0), cB + kstep, voffB); PG8_STAGE(PG8_SA(1, 0), cA + kstep, voffA); PG8_STAGE(PG8_SB(1, 1), cB + hstep + kstep, voffB);
        PG8_WAIT_V(6); PG8_BAR;
    }
    for (;;) {
        const bool has_next = S.next(ui + 1, nxt);
        const char* nA = has_next ? S.aptr((const char*)g.A, nxt, tstep) : cA; const char* nB = has_next ? S.bptr((const char*)g.Bt, nxt, tstep) : cB;
        for (int t = 0; t < nt; t += 2) {
            const bool last = (t == nt - 2);
            const char* a1 = cA + (size_t)(t + 1) * kstep;
            const char* a2 = last ? nA : cA + (size_t)(t + 2) * kstep; const char* b2 = last ? nB : cB + (size_t)(t + 2) * kstep;
            const char* a3 = a2 + kstep; const char* b3 = b2 + kstep;
            if (last && has_next) S.a_ready(nxt);
            if constexpr (SP2) {
            PG8_LDB(B0, 0, 0); PG8_LDB(B1, 0, 1); PG8_SCHED; PG8_LDA(At, 0, 0); PG8_STAGE(PG8_SA(1, 1), a1 + hstep, voffA);
            PG8_WAIT_V(8); PG8_WAIT_L(0); PG8_BAR; PG8_MMA(0, 0, At, B0); PG8_MMA(0, 1, At, B1); PG8_BAR; PG8_SCHED;
            PG8_LDA(At, 0, 1); PG8_STAGE(PG8_SB(0, 0), b2, voffB); PG8_STAGE(PG8_SB(0, 1), b2 + hstep, voffB); PG8_STAGE(PG8_SA(0, 0), a2, voffA);
            PG8_WAIT_V(8); PG8_WAIT_L(0); PG8_BAR; PG8_MMA(1, 0, At, B0); PG8_MMA(1, 1, At, B1); PG8_BAR; PG8_SCHED;
            PG8_LDB(B0, 1, 0); PG8_LDB(B1, 1, 1); PG8_SCHED; PG8_LDA(At, 1, 0); PG8_STAGE(PG8_SA(0, 1), a2 + hstep, voffA);
            PG8_WAIT_V(8); PG8_WAIT_L(0); PG8_BAR; PG8_MMA(0, 0, At, B0); PG8_MMA(0, 1, At, B1); PG8_BAR; PG8_SCHED;
            PG8_LDA(At, 1, 1); PG8_STAGE(PG8_SB(1, 0), b3, voffB); PG8_STAGE(PG8_SB(1, 1), b3 + hstep, voffB); PG8_STAGE(PG8_SA(1, 0), a3, voffA);
            PG8_WAIT_V(8); PG8_WAIT_L(0); PG8_BAR; PG8_MMA(1, 0, At, B0); PG8_MMA(1, 1, At, B1); PG8_BAR; PG8_SCHED;
            } else {
            PG8_LDB(B0, 0, 0); PG8_SCHED; PG8_LDA(At, 0, 0); PG8_STAGE(PG8_SA(1, 1), a1 + hstep, voffA);
            PG8_WAIT_L(8); PG8_BAR; PG8_WAIT_L(0); PG8_MMA(0, 0, At, B0); PG8_BAR; PG8_SCHED;
            PG8_LDB(B1, 0, 1); PG8_STAGE(PG8_SB(0, 0), b2, voffB);
            PG8_BAR; PG8_WAIT_L(0); PG8_MMA(0, 1, At, B1); PG8_BAR;
            PG8_LDA(At, 0, 1); PG8_STAGE(PG8_SA(0, 0), a2, voffA);
            PG8_BAR; PG8_WAIT_L(0); PG8_MMA(1, 0, At, B0); PG8_BAR; PG8_SCHED;
            PG8_STAGE(PG8_SB(0, 1), b2 + hstep, voffB);
            PG8_WAIT_V(6); PG8_BAR; PG8_MMA(1, 1, At, B1); PG8_BAR;
            PG8_LDB(B0, 1, 0); PG8_SCHED; PG8_LDA(At, 1, 0); PG8_STAGE(PG8_SA(0, 1), a2 + hstep, voffA);
            PG8_WAIT_L(8); PG8_BAR; PG8_WAIT_L(0); PG8_MMA(0, 0, At, B0); PG8_BAR; PG8_SCHED;
            PG8_LDB(B1, 1, 1); PG8_STAGE(PG8_SB(1, 0), b3, voffB);
            PG8_BAR; PG8_WAIT_L(0); PG8_MMA(0, 1, At, B1); PG8_BAR;
            PG8_LDA(At, 1, 1); PG8_STAGE(PG8_SA(1, 0), a3, voffA);
            PG8_BAR; PG8_WAIT_L(0); PG8_MMA(1, 0, At, B0); PG8_BAR; PG8_SCHED;
            PG8_STAGE(PG8_SB(1, 1), b3 + hstep, voffB);
            PG8_WAIT_V(6); PG8_BAR; PG8_MMA(1, 1, At, B1); PG8_BAR;
            }
        }
        if constexpr (ALIGN_EPI) { if (wr == 0) PG8_BAR; }
        if constexpr (!Epi::AFTER_DRAIN) { E(acc, cur, wr, wc, fr, fq); S.done(cur); }
        if (!has_next) break;
#pragma unroll
        for (int a = 0; a < 2; ++a)
#pragma unroll
            for (int b = 0; b < 2; ++b)
#pragma unroll
                for (int m = 0; m < 4; ++m)
#pragma unroll
                    for (int n = 0; n < 2; ++n) acc[a][b][m][n] = (f32x4){0.f, 0.f, 0.f, 0.f};
        cur = nxt; cA = nA; cB = nB; ++ui;
        if constexpr (ALIGN_EPI) { if (wr == 1) PG8_BAR; }
    }
    PG8_WAIT_V(0);
    if constexpr (!ALIGN_EPI) { if (wr == 0) PG8_BAR; }
    PG8_BAR;
    if constexpr (Epi::AFTER_DRAIN) { E.fused(acc, cur, wr, wc, fr, fq, lds, wid, lane); S.done(cur); }
#undef PG8_SA
#undef PG8_SB
#undef PG8_STAGE
#undef PG8_LDA
#undef PG8_LDB
#undef PG8_MMA
#undef PG8_WAIT_V
#undef PG8_WAIT_L
#undef PG8_BAR
#undef PG8_SCHED
}
}
#define GAS __attribute__((address_space(1)))
#define LAS __attribute__((address_space(3)))
typedef unsigned short bf16;
typedef unsigned v4u __attribute__((ext_vector_type(4)));
typedef float f32x4 __attribute__((ext_vector_type(4)));
typedef short bf16x8 __attribute__((ext_vector_type(8)));
typedef GAS unsigned gu32;
typedef GAS unsigned long long gu64;
#define RLX_AGENT __ATOMIC_RELAXED, __HIP_MEMORY_SCOPE_AGENT
#define LDS_WAIT() asm volatile("s_waitcnt lgkmcnt(0)" ::: "memory")
#define VM_WAIT() asm volatile("s_waitcnt vmcnt(0)" ::: "memory")
__device__ __forceinline__ unsigned long long rt() { return __builtin_amdgcn_s_memrealtime(); }
__device__ __forceinline__ unsigned f2bf(float f) { unsigned u = __builtin_bit_cast(unsigned, f); return (u + 0x7fffu + ((u >> 16) & 1u)) >> 16; }
__device__ __forceinline__ unsigned pk2(float lo, float hi) { return f2bf(lo) | (f2bf(hi) << 16); }

#define XB_TMO      128
#define XB_XCNT(j)  (256  + 64 * (j))
#define XB_XSUB(j)  (1280 + 64 * (j))
#define XB_XGEN(j)  (2304 + 64 * (j))
#define XB_TOP      3328
#define XB_TOPGEN   3392
#define XCD_BAR_WORDS 3456
#define XB_SPIN_CAP (1u << 22)

__device__ __forceinline__ unsigned xb_ld(unsigned* p)              { return __hip_atomic_load(p, __ATOMIC_RELAXED, __HIP_MEMORY_SCOPE_AGENT); }
__device__ __forceinline__ unsigned xb_add(unsigned* p, unsigned v) { return __hip_atomic_fetch_add(p, v, __ATOMIC_RELAXED, __HIP_MEMORY_SCOPE_AGENT); }
__device__ __forceinline__ unsigned xb_xcc_id() { return (unsigned)__builtin_amdgcn_s_getreg((3 << 11) | 20) & 0xFu; }
#define XB_SPIN(cond, bar) do { unsigned _sp = 0; while (cond) { __builtin_amdgcn_s_sleep(1); \
    if ((++_sp & 255u) == 0u) { if (xb_ld(&(bar)[XB_TMO])) break; if (_sp > XB_SPIN_CAP) { atomicAdd(&(bar)[XB_TMO], 1u); break; } } } } while (0)

struct XcdBarrier {
    unsigned* bar; unsigned x;
    volatile LAS unsigned* st;
};

__device__ __forceinline__ XcdBarrier xcd_barrier_post(unsigned* bar, volatile LAS unsigned* st) {
    XcdBarrier b; b.bar = bar; b.x = xb_xcc_id(); b.st = st;
    if (threadIdx.x == 0) (void)xb_add(&bar[XB_XCNT(b.x)], 1u);
    return b;
}
__device__ __forceinline__ void xcd_barrier_complete(unsigned* bar, unsigned x, unsigned& nloc, unsigned& nx) {
    const unsigned G = gridDim.x * gridDim.y * gridDim.z;
    unsigned sum, cnt, mine, sp = 0u;
    for (;;) {
        sum = 0u; cnt = 0u; mine = 0u;
#pragma unroll
        for (unsigned j = 0; j < 16; ++j) { const unsigned c = xb_ld(&bar[XB_XCNT(j)]); sum += c; cnt += (c > 0u) ? 1u : 0u; mine = (j == x) ? c : mine; }
        if (sum == G) break;
        __builtin_amdgcn_s_sleep(1);
        if ((++sp & 255u) == 0u) { if (xb_ld(&bar[XB_TMO])) break; if (sp > XB_SPIN_CAP) { atomicAdd(&bar[XB_TMO], 1u); break; } }
    }
    nloc = mine > 0u ? mine : 1u; nx = cnt > 0u ? cnt : 1u;
}

__device__ __forceinline__ void xcd_barrier(const XcdBarrier& b) {
    asm volatile("s_waitcnt vmcnt(0)" ::: "memory");
    __syncthreads();
    if (threadIdx.x == 0) {
        unsigned* bar = b.bar;
        __builtin_amdgcn_s_waitcnt(0);
        unsigned nloc = b.st[0], nx = b.st[1];
        if (nloc == 0u) { xcd_barrier_complete(bar, b.x, nloc, nx); b.st[0] = nloc; b.st[1] = nx; }
        const unsigned old = xb_add(&bar[XB_XSUB(b.x)], 1u);
        const unsigned gen = old / nloc;
        if (old + 1u == (gen + 1u) * nloc) {
            __builtin_amdgcn_fence(__ATOMIC_RELEASE, "agent");
            asm volatile("s_waitcnt vmcnt(0)" ::: "memory");
            const unsigned og = xb_add(&bar[XB_TOP], 1u);
            const unsigned tg = og / nx;
            if (og + 1u == (tg + 1u) * nx) xb_add(&bar[XB_TOPGEN], 1u);
            else XB_SPIN(xb_ld(&bar[XB_TOPGEN]) == tg, bar);
            __builtin_amdgcn_fence(__ATOMIC_ACQUIRE, "agent");
            xb_add(&bar[XB_XGEN(b.x)], 1u);
            asm volatile("s_waitcnt vmcnt(0)" ::: "memory");
        } else {
            XB_SPIN(xb_ld(&bar[XB_XGEN(b.x)]) == gen, bar);
            __builtin_amdgcn_fence(__ATOMIC_ACQUIRE, "agent");
            asm volatile("s_waitcnt vmcnt(0)" ::: "memory");
        }
    }
    __syncthreads();
}

constexpr int NWAVES = 8, NTHR = 512;
constexpr int NB = 8, SEQ = 2048, DM = 1024, CTXL = 256;
constexpr int ML = NB * SEQ, MC = NB * CTXL, MT = ML + MC;
constexpr int EV_IN = 3104, EV_INP = 3328, OD_IN = 3008, OD_INP = 3072, DFF = 3584, NEXP = 8;
constexpr int EV_QA = 0, EV_KA = 512, EV_VA = 1024, EV_QB = 1536, EV_KB = 1792, EV_VB = 2048, EV_GB = 2560, EV_LRF = 3072, EV_LRB = 3088;
constexpr int OD_CQ = 0, OD_CKV = 256, OD_KR = 384, OD_HQ = 448, OD_HFF = 960, OD_HFB = 1472, OD_HI = 1984, OD_HG = 2496;
constexpr float LN_EPS = 1e-5f, RMS_EPS = 1e-6f, DN_ALPHA = 1.41421356237f, LAM_INIT0 = 0.2f;
constexpr float DA_SCALE = 0.125f, GLA_QSCALE = 0.125f, MLA_SCALE = 0.07216878364870322f;

constexpr size_t MiB = 1u << 20;
constexpr size_t WS_CTL = 0, CTL_ZERO_BYTES = 1 * MiB;
constexpr size_t WS_MOD = 1 * MiB;
constexpr size_t WS_COS = 2 * MiB, WS_SIN = 2 * MiB + 262144;
constexpr size_t WS_SCAL = 2 * MiB + 524288;
constexpr size_t WS_ROUTE = 3 * MiB;
constexpr size_t WS_W_IN0 = 8 * MiB, WS_W_OUT0 = 15 * MiB, WS_W_FF1 = 17 * MiB, WS_W_FF2 = 31 * MiB, WS_W_IN1 = 38 * MiB, WS_W_UQ = 44 * MiB, WS_W_UKV = 45 * MiB, WS_W_OUT1 = 46 * MiB;
constexpr size_t WS_EXP_W1 = 48 * MiB, WS_EXP_W2 = 160 * MiB;
constexpr size_t WS_H = 216 * MiB, WS_X1 = 252 * MiB, WS_X2 = 324 * MiB, WS_BIG = 396 * MiB, WS_ACT = 648 * MiB, WS_YF = 774 * MiB, WS_SPARE = 846 * MiB, WS_END = 864 * MiB;
constexpr size_t WS_P = WS_BIG, WS_U = WS_BIG;
constexpr size_t WS_GK = WS_ACT, WS_OA = WS_ACT + 36 * MiB, WS_OBF = WS_ACT + 72 * MiB, WS_OBB = WS_YF;
constexpr size_t WS_Q = WS_ACT, WS_KV = WS_ACT + 24 * MiB, WS_OM = WS_ACT + 60 * MiB, WS_OHF = WS_ACT + 92 * MiB, WS_OHB = WS_YF, WS_NQ = WS_SPARE, WS_NKV = WS_SPARE + 8 * MiB;
constexpr size_t WS_FSUM = WS_X2;
constexpr size_t WS_YPART = WS_BIG;
constexpr size_t WS_SCAN_E = WS_YF + 40 * MiB, WS_SCAN_D = WS_YF + 60 * MiB;
constexpr size_t WS_GH = WS_BIG + 112 * MiB;
constexpr size_t WS_POS = WS_ROUTE + 262144;
constexpr int MOE_MAXROWS = 2 * ML + NEXP * 256;
constexpr size_t WS_HG = WS_ACT;
constexpr size_t WS_ACT2 = WS_BIG;
constexpr size_t WS_F2 = WS_ACT;
static_assert(WS_ACT2 + (size_t)MOE_MAXROWS * DFF * 2 <= WS_ACT && WS_F2 + (size_t)MOE_MAXROWS * DM * 4 <= WS_SPARE, "moe ws map");
constexpr int CW_CNT = 1024;
static_assert(WS_OHF + 32 * MiB <= WS_YF && WS_NKV + 9 * MiB <= WS_END, "ws map");
constexpr int CW_BAR = 4096;
constexpr int MAX_LAUNCHES = 64;
static_assert((CW_BAR + MAX_LAUNCHES * XCD_BAR_WORDS) * 4 <= (int)CTL_ZERO_BYTES, "CTL words inside the memset region");

constexpr int SCR_BYTES = 151552;
constexpr int MISC_OFF = SCR_BYTES;
constexpr int LDS_BYTES = 155648;

struct Frame {
    LAS unsigned char* lds;
    volatile LAS unsigned* MISC;
    gu32* ctl;
    int tid, lane, wave, G, gw, NGW;
    unsigned char* ws;
    const float* in[28];
    float* out;
};
enum InIdx { I_X = 0, I_C, I_CTX, I_CCTX, I_ADAW, I_ADAB, I_LNG, I_LNB, I_LBT, I_EV_WIN, I_EV_LAM, I_EV_SUBLN, I_EV_GKW2, I_EV_GKB, I_EV_GLAG, I_EV_WOUT, I_EV_W1, I_EV_W2,
             I_OD_WIN, I_OD_QNG, I_OD_KVNG, I_OD_WUQ, I_OD_WUKV, I_OD_HGG, I_OD_WOUT, I_OD_ROUTER, I_OD_EW1, I_OD_EW2 };

__device__ __forceinline__ float bf2f(unsigned short b) { return __uint_as_float(((unsigned)b) << 16); }
__device__ __forceinline__ float bflo(unsigned w) { return __uint_as_float(w << 16); }
__device__ __forceinline__ float bfhi(unsigned w) { return __uint_as_float(w & 0xffff0000u); }
__device__ __forceinline__ float wave_sum(float v) {
#pragma unroll
    for (int o = 1; o < 64; o <<= 1) v += __shfl_xor(v, o);
    return v;
}
__device__ __forceinline__ float wave_max(float v) {
#pragma unroll
    for (int o = 1; o < 64; o <<= 1) v = fmaxf(v, __shfl_xor(v, o));
    return v;
}
__device__ __forceinline__ float sigmoidf_(float x) { return 1.0f / (1.0f + __expf(-x)); }
__device__ __forceinline__ float siluf_(float x) { return x / (1.0f + __expf(-x)); }
__device__ __forceinline__ float logsigmoidf_(float x) { return fminf(x, 0.0f) - log1pf(__expf(-fabsf(x))); }
__device__ __forceinline__ int mod_row(int m) { return m < ML ? (m >> 11) : NB; }
__device__ __forceinline__ void frame_refresh(Frame& F) {
    int t = threadIdx.x; asm volatile("" : "+v"(t));
    F.tid = t; F.lane = t & 63; F.wave = __builtin_amdgcn_readfirstlane(t >> 6); F.gw = blockIdx.x * NWAVES + F.wave;
}
__device__ __forceinline__ const float* src_row(const Frame& F, int m) { return m < ML ? F.in[I_X] + (size_t)m * DM : F.in[I_CTX] + (size_t)(m - ML) * DM; }

__device__ __forceinline__ void transpose_tile(const float* W, int N, bf16* WT, int ldt, LAS float* scr, int k0, int n0, int lane) {
    float tv[32];
#pragma unroll
    for (int i = 0; i < 32; ++i) { const int kk = 2 * i + (lane >> 5); tv[i] = W[(size_t)(k0 + kk) * N + n0 + (lane & 31)]; }
#pragma unroll
    for (int i = 0; i < 32; ++i) { const int kk = 2 * i + (lane >> 5); scr[kk * 33 + (lane & 31)] = tv[i]; }
    LDS_WAIT(); asm volatile("" ::: "memory");
    const int c = lane & 7;
#pragma unroll
    for (int j = 0; j < 4; ++j) { const int n = (lane >> 3) + 8 * j; const LAS float* s = scr + (8 * c) * 33 + n;
        v4u o; o.x = pk2(s[0 * 33], s[1 * 33]); o.y = pk2(s[2 * 33], s[3 * 33]); o.z = pk2(s[4 * 33], s[5 * 33]); o.w = pk2(s[6 * 33], s[7 * 33]);
        *(GAS v4u*)(WT + (size_t)(n0 + n) * ldt + k0 + 8 * c) = o; }
    LDS_WAIT(); asm volatile("" ::: "memory");
}
template <bool SWI>
__device__ __forceinline__ void transpose_weight(Frame& F, const float* W, int K, int N, bf16* WT, int ldt, LAS float* scr) {
    const int nblk = N / 32, items = (K / 64) * nblk;
    for (int it = F.gw; it < items; it += F.NGW) { const int n0 = 32 * (it % nblk);
        const int r0 = !SWI ? n0 : (n0 < DFF ? (n0 >> 7) * 256 + (n0 & 127) : ((n0 - DFF) >> 7) * 256 + 128 + ((n0 - DFF) & 127));
        transpose_tile(W + n0, N, WT + (size_t)r0 * ldt, ldt, scr, 64 * (it / nblk), 0, F.lane); }
}
__device__ __forceinline__ void zero_bytes16(Frame& F, unsigned char* p, size_t nbytes) {
    const v4u z = {0u, 0u, 0u, 0u};
    for (size_t i = (size_t)blockIdx.x * NTHR + F.tid; i < nbytes / 16; i += (size_t)F.G * NTHR) ((GAS v4u*)p)[i] = z;
}

__device__ __forceinline__ void p0_prologue(Frame& F) {
    {
        LAS float* sS = (LAS float*)F.lds;
        LAS float* part = (LAS float*)(F.lds + 40960);
        float* MOD = (float*)(F.ws + WS_MOD);
        if ((int)blockIdx.x < 192) {
            for (int i = F.tid; i < 9 * 1024; i += NTHR) { const int r = i >> 10, k = i & 1023; const float v = r < 8 ? F.in[I_C][r * 1024 + k] : F.in[I_CCTX][k]; sS[i] = siluf_(v); }
            __syncthreads();
            for (int it = blockIdx.x; it < 192; it += F.G) {
                const int l = it / 96, n0 = (it % 96) * 64;
                const float* Wp = F.in[I_ADAW] + ((size_t)l * 1024 + 128 * F.wave) * 6144 + n0 + F.lane;
                float acc[9];
#pragma unroll
                for (int r = 0; r < 9; ++r) acc[r] = 0.f;
                for (int kk = 0; kk < 128; kk += 32) {
                    float wv[32];
#pragma unroll
                    for (int j = 0; j < 32; ++j) wv[j] = Wp[(size_t)(kk + j) * 6144];
#pragma unroll
                    for (int j = 0; j < 32; ++j)
#pragma unroll
                        for (int r = 0; r < 9; ++r) acc[r] += sS[r * 1024 + 128 * F.wave + kk + j] * wv[j];
                }
#pragma unroll
                for (int r = 0; r < 9; ++r) part[(F.wave * 9 + r) * 64 + F.lane] = acc[r];
                __syncthreads();
                for (int i = F.tid; i < 576; i += NTHR) { const int r = i >> 6, c = i & 63; float s = 0.f;
#pragma unroll
                    for (int w = 0; w < 8; ++w) s += part[(w * 9 + r) * 64 + c];
                    MOD[((size_t)l * 9 + r) * 6144 + n0 + c] = s + F.in[I_ADAB][l * 6144 + n0 + c]; }
                __syncthreads();
            }
        }
        __syncthreads();
    }
    {
        float* COS = (float*)(F.ws + WS_COS); float* SIN = (float*)(F.ws + WS_SIN);
        for (int i = blockIdx.x * NTHR + F.tid; i < 2048 * 32; i += F.G * NTHR) {
            const int pos = i >> 5, pi = i & 31; const int j = pi & 15;
            const float inv = (float)pow(10000.0, -(double)j / 16.0);
            const float p = (float)(pi < 16 ? (pos >> 6) : (pos & 63));
            const float ang = p * inv;
            COS[i] = (float)cos((double)ang); SIN[i] = (float)sin((double)ang);
        }
        if (blockIdx.x == 0) {
            float* SC = (float*)(F.ws + WS_SCAL);
            if (F.wave == 0) { const float* lv = F.in[I_EV_LAM]; const float a = wave_sum(lv[F.lane] * lv[64 + F.lane]), b = wave_sum(lv[128 + F.lane] * lv[192 + F.lane]);
                if (F.lane == 0) SC[0] = expf(a) - expf(b) + LAM_INIT0; }
            { const float t0 = F.in[I_LBT][F.tid], t1 = F.in[I_LBT][512 + F.tid]; SC[256 + F.tid] = 1.0f / (1.0f + expf(t0 - t1)); }
        }
    }
    {
        LAS float* scr = (LAS float*)(F.lds + F.wave * 16384);
        transpose_weight<false>(F, F.in[I_EV_WIN], 1024, EV_IN, (bf16*)(F.ws + WS_W_IN0), 1024, scr);
        transpose_weight<false>(F, F.in[I_EV_WOUT], 1024, 1024, (bf16*)(F.ws + WS_W_OUT0), 1024, scr);
        transpose_weight<true>(F, F.in[I_EV_W1], 1024, 2 * DFF, (bf16*)(F.ws + WS_W_FF1), 1024, scr);
        transpose_weight<false>(F, F.in[I_EV_W2], DFF, 1024, (bf16*)(F.ws + WS_W_FF2), DFF, scr);
        transpose_weight<false>(F, F.in[I_OD_WIN], 1024, OD_IN, (bf16*)(F.ws + WS_W_IN1), 1024, scr);
        transpose_weight<false>(F, F.in[I_OD_WUQ], 256, 768, (bf16*)(F.ws + WS_W_UQ), 256, scr);
        transpose_weight<false>(F, F.in[I_OD_WUKV], 128, 1024, (bf16*)(F.ws + WS_W_UKV), 256, scr);
        transpose_weight<false>(F, F.in[I_OD_WOUT], 1024, 1024, (bf16*)(F.ws + WS_W_OUT1), 1024, scr);
        for (int e = 0; e < NEXP; ++e) {
            transpose_weight<true>(F, F.in[I_OD_EW1] + (size_t)e * 1024 * 2 * DFF, 1024, 2 * DFF, (bf16*)(F.ws + WS_EXP_W1) + (size_t)e * 2 * DFF * 1024, 1024, scr);
            transpose_weight<false>(F, F.in[I_OD_EW2] + (size_t)e * DFF * 1024, DFF, 1024, (bf16*)(F.ws + WS_EXP_W2) + (size_t)e * 1024 * DFF, DFF, scr);
        }
        zero_bytes16(F, F.ws + WS_W_IN0 + (size_t)EV_IN * 1024 * 2, (size_t)(EV_INP - EV_IN) * 1024 * 2);
        zero_bytes16(F, F.ws + WS_W_IN1 + (size_t)OD_IN * 1024 * 2, (size_t)(OD_INP - OD_IN) * 1024 * 2);
        { const v4u z = {0u, 0u, 0u, 0u};
          for (int i = blockIdx.x * NTHR + F.tid; i < 1024 * 16; i += F.G * NTHR) *(GAS v4u*)(F.ws + WS_W_UKV + (size_t)(i >> 4) * 512 + 256 + (i & 15) * 16) = z; }
    }
}

__device__ __forceinline__ void store_bf16x4(bf16* p, f32x4 v) { *(GAS unsigned long long*)p = (unsigned long long)pk2(v.x, v.y) | ((unsigned long long)pk2(v.z, v.w) << 32); }
__device__ __forceinline__ void p_modulate0(Frame& F) {
    const float* MOD = (const float*)(F.ws + WS_MOD); bf16* H = (bf16*)(F.ws + WS_H);
    for (int m = F.gw; m < MT; m += F.NGW) {
        const float* xr = src_row(F, m); const float* mr = MOD + (size_t)(0 * 9 + mod_row(m)) * 6144;
#pragma unroll
        for (int j = 0; j < 4; ++j) { const int c = 4 * F.lane + 256 * j; const f32x4 v = *(const f32x4*)(xr + c), sh = *(const f32x4*)(mr + c), sc = *(const f32x4*)(mr + 1024 + c);
            store_bf16x4(H + (size_t)m * DM + c, v * (1.0f + sc) + sh); }
    }
}

__device__ __forceinline__ void p_post0(Frame& F) {
    const bf16* P = (const bf16*)(F.ws + WS_P); float* GK = (float*)(F.ws + WS_GK);
    const int d = F.lane >> 5, k0 = (F.lane & 31) * 8;
    for (int m = F.gw; m < MT; m += F.NGW) {
        const bf16* pr = P + (size_t)m * EV_INP + EV_LRF + d * 16;
        const v4u l0 = *(const GAS v4u*)pr, l1 = *(const GAS v4u*)(pr + 8);
        float lr[16]; lr[0] = bflo(l0.x); lr[1] = bfhi(l0.x); lr[2] = bflo(l0.y); lr[3] = bfhi(l0.y); lr[4] = bflo(l0.z); lr[5] = bfhi(l0.z); lr[6] = bflo(l0.w); lr[7] = bfhi(l0.w);
        lr[8] = bflo(l1.x); lr[9] = bfhi(l1.x); lr[10] = bflo(l1.y); lr[11] = bfhi(l1.y); lr[12] = bflo(l1.z); lr[13] = bfhi(l1.z); lr[14] = bflo(l1.w); lr[15] = bfhi(l1.w);
        const float* wb = F.in[I_EV_GKW2] + (size_t)d * 16 * 256 + k0;
        f32x4 a0 = *(const f32x4*)(F.in[I_EV_GKB] + d * 256 + k0), a1 = *(const f32x4*)(F.in[I_EV_GKB] + d * 256 + k0 + 4);
#pragma unroll
        for (int r = 0; r < 16; ++r) { a0 = a0 + *(const f32x4*)(wb + r * 256) * lr[r]; a1 = a1 + *(const f32x4*)(wb + r * 256 + 4) * lr[r]; }
        f32x4 o0, o1;
#pragma unroll
        for (int q = 0; q < 4; ++q) { o0[q] = logsigmoidf_(a0[q]) * (1.0f / 16.0f); o1[q] = logsigmoidf_(a1[q]) * (1.0f / 16.0f); }
        float* go = GK + ((size_t)d * MT + m) * 256 + k0; *(f32x4*)go = o0; *(f32x4*)(go + 4) = o1;
    }
}
namespace att {
typedef short bf16x8 __attribute__((ext_vector_type(8)));
typedef short s16x4 __attribute__((ext_vector_type(4)));
typedef float f32x16 __attribute__((ext_vector_type(16)));
typedef unsigned u32x4 __attribute__((ext_vector_type(4)));
constexpr int KVBLK = 64, SHM_V = KVBLK * 128 * 2;
constexpr float THR = 8.f;
#define ATT_SBAR() __builtin_amdgcn_sched_barrier(0)
__device__ __forceinline__ int crow(int r, int hi) { return (r & 3) + 8 * (r >> 2) + 4 * hi; }
__device__ __forceinline__ unsigned cvtpk(float lo, float hi) { unsigned r; asm volatile("v_cvt_pk_bf16_f32 %0, %1, %2" : "=v"(r) : "v"(lo), "v"(hi)); return r; }

__device__ __forceinline__ void partialSM(f32x16& p0, f32x16& p1, float& m_reg, float& mn, float& alpha, const float C, const float THRS) {
    float pmax = p0[0];
#pragma unroll
    for (int r = 1; r < 16; ++r) pmax = fmaxf(pmax, p0[r]);
#pragma unroll
    for (int r = 0; r < 16; ++r) pmax = fmaxf(pmax, p1[r]);
    { auto rr = __builtin_amdgcn_permlane32_swap(__float_as_uint(pmax), __float_as_uint(pmax), false, false);
      pmax = fmaxf(__uint_as_float(rr[0]), __uint_as_float(rr[1])); }
    if (__builtin_expect(__all(pmax - m_reg <= THRS), 1)) { mn = m_reg; alpha = 1.f; }
    else { mn = fmaxf(m_reg, pmax); alpha = __builtin_amdgcn_exp2f((m_reg - mn) * C); m_reg = mn; }
    const float mnC = -mn * C;
#pragma unroll
    for (int r = 0; r < 16; ++r) p0[r] = fmaf(p0[r], C, mnC);
#pragma unroll
    for (int r = 0; r < 16; ++r) p1[r] = fmaf(p1[r], C, mnC);
#pragma unroll
    for (int r = 0; r < 16; ++r) p0[r] = __builtin_amdgcn_exp2f(p0[r]);
}
__device__ __forceinline__ void finishSM(f32x16& p0, f32x16& p1, float alpha, float& l_reg, bf16x8& pa0, bf16x8& pa1, bf16x8& pa2, bf16x8& pa3) {
#pragma unroll
    for (int r = 0; r < 16; ++r) p1[r] = __builtin_amdgcn_exp2f(p1[r]);
    float ps = 0;
#pragma unroll
    for (int r = 0; r < 16; ++r) ps += p0[r];
#pragma unroll
    for (int r = 0; r < 16; ++r) ps += p1[r];
    { auto rr = __builtin_amdgcn_permlane32_swap(__float_as_uint(ps), __float_as_uint(ps), false, false);
      ps = __uint_as_float(rr[0]) + __uint_as_float(rr[1]); }
    l_reg = l_reg * alpha + ps;
#define ATT_PK4(P, BASE, OUT) do { unsigned a0 = cvtpk(P[BASE + 0], P[BASE + 1]), a1 = cvtpk(P[BASE + 2], P[BASE + 3]);   \
    unsigned b0 = cvtpk(P[BASE + 4], P[BASE + 5]), b1 = cvtpk(P[BASE + 6], P[BASE + 7]);                              \
    auto r0 = __builtin_amdgcn_permlane32_swap(a0, b0, false, false); auto r1 = __builtin_amdgcn_permlane32_swap(a1, b1, false, false); \
    u32x4 w = {r0[0], r1[0], r0[1], r1[1]}; OUT = __builtin_bit_cast(bf16x8, w); } while (0)
    ATT_PK4(p0, 0, pa0); ATT_PK4(p0, 8, pa1); ATT_PK4(p1, 0, pa2); ATT_PK4(p1, 8, pa3);
#undef ATT_PK4
}
__device__ __forceinline__ int v_st(int k, int c) { const int kk = (k & ~0xC) | ((k & 4) << 1) | ((k & 8) >> 1); return ((kk >> 3) * 4 + (c >> 5)) * 512 + ((kk & 7) * 32 + (c & 31)) * 2; }
__device__ __forceinline__ int v_rd_base(int lane) { return ((lane & 3) << 3) | (((lane >> 2) & 3) << 6) | (((lane >> 4) & 1) << 5) | (((lane >> 5) & 1) << 8); }
constexpr int v_rd_off(int d0, int ks, int half) { return d0 * 512 + ks * 4096 + half * 2048; }
template <int OFF> __device__ __forceinline__ s16x4 tr_read(int vb) { s16x4 r; asm volatile("ds_read_b64_tr_b16 %0, %1 offset:%2" : "=&v"(r) : "v"(vb), "i"(OFF) : "memory"); return r; }
template <int D0> __device__ __forceinline__ void pv_one(f32x16& od, int vb, bf16x8 pa0, bf16x8 pa1, bf16x8 pa2, bf16x8 pa3) {
    const s16x4 l0 = tr_read<v_rd_off(D0, 0, 0)>(vb), h0 = tr_read<v_rd_off(D0, 0, 1)>(vb), l1 = tr_read<v_rd_off(D0, 1, 0)>(vb), h1 = tr_read<v_rd_off(D0, 1, 1)>(vb);
    const s16x4 l2 = tr_read<v_rd_off(D0, 2, 0)>(vb), h2 = tr_read<v_rd_off(D0, 2, 1)>(vb), l3 = tr_read<v_rd_off(D0, 3, 0)>(vb), h3 = tr_read<v_rd_off(D0, 3, 1)>(vb);
    asm volatile("s_waitcnt lgkmcnt(0)" ::: "memory"); ATT_SBAR();
#define ATT_PK(L, H) (bf16x8){L[0], L[1], L[2], L[3], H[0], H[1], H[2], H[3]}
    od = __builtin_amdgcn_mfma_f32_32x32x16_bf16(pa0, ATT_PK(l0, h0), od, 0, 0, 0);
    od = __builtin_amdgcn_mfma_f32_32x32x16_bf16(pa1, ATT_PK(l1, h1), od, 0, 0, 0);
    od = __builtin_amdgcn_mfma_f32_32x32x16_bf16(pa2, ATT_PK(l2, h2), od, 0, 0, 0);
    od = __builtin_amdgcn_mfma_f32_32x32x16_bf16(pa3, ATT_PK(l3, h3), od, 0, 0, 0);
#undef ATT_PK
}
__device__ __forceinline__ void pv_d0(f32x16* o, int vb, bf16x8 pa0, bf16x8 pa1, bf16x8 pa2, bf16x8 pa3) {
    pv_one<0>(o[0], vb, pa0, pa1, pa2, pa3); pv_one<1>(o[1], vb, pa0, pa1, pa2, pa3); pv_one<2>(o[2], vb, pa0, pa1, pa2, pa3); pv_one<3>(o[3], vb, pa0, pa1, pa2, pa3);
}
__device__ __forceinline__ int k_st(int row, int c, int RB) { return row * RB + (((c & ~7) | ((c & 7) ^ ((row >> 1) & 7))) << 4); }
template <int NQ, int RB> __device__ __forceinline__ void qkt(f32x16& p0, f32x16& p1, const LAS unsigned char* kb  , const int (&kx)[4], const bf16x8* qr) {
    p0 = f32x16{}; p1 = f32x16{};
#pragma unroll
    for (int d0 = 0; d0 < NQ; ++d0) {
        const LAS unsigned char* a = kb + kx[d0 & 3] + (d0 >> 2) * 128;
        const bf16x8 b0 = *(const LAS bf16x8*)a, b1 = *(const LAS bf16x8*)(a + 32 * RB);
        p0 = __builtin_amdgcn_mfma_f32_32x32x16_bf16(b0, qr[d0], p0, 0, 0, 0);
        p1 = __builtin_amdgcn_mfma_f32_32x32x16_bf16(b1, qr[d0], p1, 0, 0, 0);
    }
}
struct Src { const bf16* kbase; int ldk; const bf16* k2base; int ldk2; const bf16* vbase; int ldv; int rowc, rowl, NT; };

template <int DQK, bool QROPE, bool PIPE>
__device__ __forceinline__ void attn_core(const bf16* Qw, const Src& S, LAS unsigned char* lds, const float C, const float THRS, f32x16 (&o)[4], float& l_out, int tid, const float* cs, const float* sn) {
    constexpr int NQ = DQK / 16, RB = DQK * 2, SHM_K = KVBLK * RB, KCH = DQK / 8, KPT = (KVBLK * KCH) / 512;
    static_assert(KPT * 512 == KVBLK * KCH, "K chunks divide over the threads");
    const int wid = tid >> 6, lane = tid & 63, r32 = lane & 31, hi = lane >> 5;
    LAS unsigned char* V_lds = lds; LAS unsigned char* K_lds = lds + 2 * SHM_V;
    LAS float* al_l = (LAS float*)(lds + 2 * SHM_V + 2 * SHM_K) + wid * 64 + 32;
    float m_reg = -1e30f, l_reg = 0;
#pragma unroll
    for (int d = 0; d < 4; ++d) o[d] = f32x16{};
    bf16x8 qr[NQ];
#pragma unroll
    for (int d0 = 0; d0 < NQ; ++d0) qr[d0] = *(const GAS bf16x8*)(Qw + d0 * 16);
    if constexpr (QROPE) {
#pragma unroll
        for (int d0 = NQ - 4; d0 < NQ; ++d0) { const int i0 = (d0 - (NQ - 4)) * 8 + hi * 4; const f32x4 c4 = *(const f32x4*)(cs + i0), s4 = *(const f32x4*)(sn + i0);
            const u32x4 w = __builtin_bit_cast(u32x4, qr[d0]); u32x4 ow;
#pragma unroll
            for (int p = 0; p < 4; ++p) { const float t0 = __uint_as_float(w[p] << 16), t1 = __uint_as_float(w[p] & 0xffff0000u); ow[p] = cvtpk(t0 * c4[p] - t1 * s4[p], t0 * s4[p] + t1 * c4[p]); }
            qr[d0] = __builtin_bit_cast(bf16x8, ow); }
    }
    const int sr = tid >> 4, sc = (tid & 15) * 8, vst0 = v_st(sr, sc), vst1 = v_st(32 + sr, sc);
    int kst[KPT]; unsigned koff[KPT];
#pragma unroll
    for (int i = 0; i < KPT; ++i) {
        int row, c; unsigned ld;
        if (DQK == 64) { row = tid >> 3; c = tid & 7; ld = (unsigned)S.ldk; koff[i] = (unsigned)row * ld + c * 8; }
        else if (i < 2) { row = (tid >> 4) + 32 * i; c = tid & 15; ld = (unsigned)S.ldk; koff[i] = (unsigned)row * ld + c * 8; }
        else { row = tid >> 3; c = 16 + (tid & 7); ld = (unsigned)S.ldk2; koff[i] = (unsigned)row * ld + (c - 16) * 8; }
        kst[i] = k_st(row, c, RB);
    }
    const unsigned voff0 = (unsigned)sr * (unsigned)S.ldv + sc, voff1 = voff0 + 32u * (unsigned)S.ldv;
    const int vb0 = (int)(unsigned)(size_t)(V_lds) + v_rd_base(lane);
    int kx[4]; { const int t = hi ^ ((r32 >> 1) & 7);
#pragma unroll
        for (int k = 0; k < 4; ++k) kx[k] = ((2 * k) ^ t) << 4; }
    const LAS unsigned char* kb0 = K_lds + r32 * RB; const LAS unsigned char* kb1 = kb0 + SHM_K;
    struct Slot { bf16x8 vs0, vs1; bf16x8 ks[KPT]; };
    Slot s0;
#define ATT_SLOAD(sl, j) do { const int _j = (j); const unsigned _r0 = (unsigned)(_j < 4 ? S.rowc + 64 * _j : S.rowl + 64 * (_j - 4)); \
        const bf16* _vb = S.vbase + (size_t)_r0 * S.ldv; sl.vs0 = *(const GAS bf16x8*)(_vb + voff0); sl.vs1 = *(const GAS bf16x8*)(_vb + voff1); \
        const bf16* _kb = S.kbase + (size_t)_r0 * S.ldk; \
        _Pragma("unroll") for (int _i = 0; _i < KPT; ++_i) { \
            if (DQK == 64 || _i < 2) sl.ks[_i] = *(const GAS bf16x8*)(_kb + koff[_i]); \
            else sl.ks[_i] = *(const GAS bf16x8*)(S.k2base + (size_t)_r0 * S.ldk2 + koff[_i]); } } while (0)
#define ATT_SWRITE(b, sl) do { *(LAS bf16x8*)(V_lds + (b) * SHM_V + vst0) = sl.vs0; *(LAS bf16x8*)(V_lds + (b) * SHM_V + vst1) = sl.vs1; \
        _Pragma("unroll") for (int _i = 0; _i < KPT; ++_i) *(LAS bf16x8*)(K_lds + (b) * SHM_K + kst[_i]) = sl.ks[_i]; } while (0)
#define ATT_SWAIT() asm volatile("s_waitcnt vmcnt(%0)" :: "n"(2 + KPT) : "memory")
#define ATT_RESC(a) do { if (__any((a) < 1.f)) { if (hi == 0) al_l[r32] = (a); asm volatile("s_waitcnt lgkmcnt(0)" ::: "memory"); \
        _Pragma("unroll") for (int d = 0; d < 4; ++d) _Pragma("unroll") for (int r = 0; r < 16; ++r) o[d][r] *= al_l[crow(r, hi)]; } } while (0)
    bf16x8 pa0, pa1, pa2, pa3; const int NT = S.NT;
    if constexpr (!PIPE) {
    f32x16 p0, p1; float mn, al;
    ATT_SLOAD(s0, 0); asm volatile("s_waitcnt vmcnt(0)" ::: "memory"); ATT_SWRITE(0, s0); ATT_SLOAD(s0, 1);
#define ATT_HALF(b, jj) do { \
        __syncthreads(); \
        if ((jj) + 1 < NT) { ATT_SWRITE((b) ^ 1, s0); if ((jj) + 2 < NT) ATT_SLOAD(s0, (jj) + 2); } \
        ATT_SBAR(); qkt<NQ, RB>(p0, p1, (b) ? kb1 : kb0, kx, qr); \
        partialSM(p0, p1, m_reg, mn, al, C, THRS); ATT_RESC(al); \
        finishSM(p0, p1, al, l_reg, pa0, pa1, pa2, pa3); ATT_SBAR(); \
        pv_d0(o, vb0 + (b) * SHM_V, pa0, pa1, pa2, pa3); } while (0)
    for (int j = 0; j < NT; j += 2) { ATT_HALF(0, j); ATT_HALF(1, j + 1); }
#undef ATT_HALF
    __syncthreads();
    } else {
    Slot s1; f32x16 pA0, pA1, pB0, pB1; float mnA, mnB, alA, alB;
    ATT_SLOAD(s0, 0); asm volatile("s_waitcnt vmcnt(0)" ::: "memory"); ATT_SWRITE(0, s0); __syncthreads();
    qkt<NQ, RB>(pA0, pA1, kb0, kx, qr); partialSM(pA0, pA1, m_reg, mnA, alA, C, THRS);
    ATT_SLOAD(s1, 1); if (2 < NT) ATT_SLOAD(s0, 2);
    ATT_SWAIT(); ATT_SWRITE(1, s1); __syncthreads();
    for (int j = 1; j + 1 < NT; j += 2) {
        ATT_SBAR(); qkt<NQ, RB>(pB0, pB1, kb1, kx, qr);
        finishSM(pA0, pA1, alA, l_reg, pa0, pa1, pa2, pa3); ATT_SBAR();
        ATT_SLOAD(s1, j + 2); ATT_SBAR();
        pv_d0(o, vb0, pa0, pa1, pa2, pa3); partialSM(pB0, pB1, m_reg, mnB, alB, C, THRS);
        __syncthreads(); ATT_SWAIT(); ATT_SWRITE(0, s0);
        ATT_RESC(alB); __syncthreads();
        ATT_SBAR(); qkt<NQ, RB>(pA0, pA1, kb0, kx, qr);
        finishSM(pB0, pB1, alB, l_reg, pa0, pa1, pa2, pa3); ATT_SBAR();
        if (j + 3 < NT) ATT_SLOAD(s0, j + 3); ATT_SBAR();
        pv_d0(o, vb0 + SHM_V, pa0, pa1, pa2, pa3); partialSM(pA0, pA1, m_reg, mnA, alA, C, THRS);
        __syncthreads(); ATT_SWAIT(); ATT_SWRITE(1, s1);
        ATT_RESC(alA); __syncthreads();
    }
    ATT_SBAR(); qkt<NQ, RB>(pB0, pB1, kb1, kx, qr);
    finishSM(pA0, pA1, alA, l_reg, pa0, pa1, pa2, pa3); ATT_SBAR();
    pv_d0(o, vb0, pa0, pa1, pa2, pa3); partialSM(pB0, pB1, m_reg, mnB, alB, C, THRS);
    __syncthreads(); ATT_RESC(alB);
    finishSM(pB0, pB1, alB, l_reg, pa0, pa1, pa2, pa3); ATT_SBAR();
    pv_d0(o, vb0 + SHM_V, pa0, pa1, pa2, pa3);
    __syncthreads();
    }
    l_out = l_reg;
#undef ATT_SLOAD
#undef ATT_SWRITE
#undef ATT_SWAIT
#undef ATT_RESC
}
__device__ __forceinline__ void row_inv(float l_reg, LAS unsigned char* lds, int SHM_K, int tid, float (&rli)[16]) {
    const int wid = tid >> 6, lane = tid & 63, r32 = lane & 31, hi = lane >> 5;
    LAS float* li_l = (LAS float*)(lds + 2 * SHM_V + 2 * SHM_K) + wid * 64;
    if (hi == 0) li_l[r32] = l_reg; asm volatile("s_waitcnt lgkmcnt(0)" ::: "memory");
#pragma unroll
    for (int r = 0; r < 16; ++r) rli[r] = __builtin_amdgcn_rcpf(li_l[crow(r, hi)]);
    asm volatile("s_waitcnt lgkmcnt(0)" ::: "memory");
}
}
__device__ __forceinline__ f32x4 ld_bf16x4(const bf16* p) { const unsigned long long w = *(const GAS unsigned long long*)p; return (f32x4){bflo((unsigned)w), bfhi((unsigned)w), bflo((unsigned)(w >> 32)), bfhi((unsigned)(w >> 32))}; }
__device__ __forceinline__ int key_row(int b, int j) { return j < CTXL ? ML + b * CTXL + j : b * SEQ + (j - CTXL); }
__device__ __forceinline__ float dot64_lds(const bf16* kp, const LAS float* q) {
    float s = 0.f;
#pragma unroll
    for (int c = 0; c < 8; ++c) { const v4u kv = *(const GAS v4u*)(kp + 8 * c); const LAS float* qq = q + 8 * c;
        s += bflo(kv.x) * qq[0] + bfhi(kv.x) * qq[1] + bflo(kv.y) * qq[2] + bfhi(kv.y) * qq[3] + bflo(kv.z) * qq[4] + bfhi(kv.z) * qq[5] + bflo(kv.w) * qq[6] + bfhi(kv.w) * qq[7]; }
    return s;
}
constexpr int ATT_WAVE_BYTES = 18944;
static_assert(8 * ATT_WAVE_BYTES <= SCR_BYTES, "attention scratch");

__device__ __forceinline__ void p_attn0_naive(Frame& F) {
    const bf16* P = (const bf16*)(F.ws + WS_P); float* OA = (float*)(F.ws + WS_OA);
    const float lam = *(const float*)(F.ws + WS_SCAL);
    LAS float* w1 = (LAS float*)(F.lds + F.wave * ATT_WAVE_BYTES); LAS float* w2 = w1 + 2304; LAS float* q = w2 + 2304;
    for (int it = F.gw; it < MT * 4; it += F.NGW) {
        const int m = it >> 2, h = it & 3;
        const int b = m < ML ? (m >> 11) : ((m - ML) >> 8), NK = m < ML ? (CTXL + SEQ) : CTXL;
        const bf16* qp = P + (size_t)m * EV_INP + EV_QA + h * 128;
        q[F.lane] = bf2f(qp[F.lane]); q[64 + F.lane] = bf2f(qp[64 + F.lane]);
        LDS_WAIT(); asm volatile("" ::: "memory");
        float mx1 = -3.0e38f, mx2 = -3.0e38f;
        for (int j = F.lane; j < NK; j += 64) { const bf16* kp = P + (size_t)key_row(b, j) * EV_INP + EV_KA + h * 128;
            const float s1 = dot64_lds(kp, q) * DA_SCALE, s2 = dot64_lds(kp + 64, q + 64) * DA_SCALE; w1[j] = s1; w2[j] = s2; mx1 = fmaxf(mx1, s1); mx2 = fmaxf(mx2, s2); }
        mx1 = wave_max(mx1); mx2 = wave_max(mx2);
        float sum1 = 0.f, sum2 = 0.f;
        for (int j = F.lane; j < NK; j += 64) { const float e1 = __expf(w1[j] - mx1), e2 = __expf(w2[j] - mx2); w1[j] = e1; w2[j] = e2; sum1 += e1; sum2 += e2; }
        const float inv1 = 1.0f / wave_sum(sum1), c2 = lam / wave_sum(sum2);
        for (int j = F.lane; j < NK; j += 64) w1[j] = w1[j] * inv1 - c2 * w2[j];
        LDS_WAIT(); asm volatile("" ::: "memory");
        float a0 = 0.f, a1 = 0.f;
        const bf16* vbase = P + EV_VA + h * 128 + 2 * F.lane;
        for (int j = 0; j < NK; j += 4) {
            unsigned vv[4]; float ww[4];
#pragma unroll
            for (int u = 0; u < 4; ++u) { vv[u] = *(const GAS unsigned*)(vbase + (size_t)key_row(b, j + u) * EV_INP); ww[u] = w1[j + u]; }
#pragma unroll
            for (int u = 0; u < 4; ++u) { a0 += ww[u] * bflo(vv[u]); a1 += ww[u] * bfhi(vv[u]); }
        }
        *(float2*)(OA + (size_t)m * 512 + h * 128 + 2 * F.lane) = make_float2(a0, a1);
        LDS_WAIT(); asm volatile("" ::: "memory");
    }
}

__device__ __forceinline__ void p_attn1_naive(Frame& F) {
    const bf16* P = (const bf16*)(F.ws + WS_P); const bf16* Q = (const bf16*)(F.ws + WS_Q); const bf16* KV = (const bf16*)(F.ws + WS_KV); float* OM = (float*)(F.ws + WS_OM);
    const float* COS = (const float*)(F.ws + WS_COS); const float* SIN = (const float*)(F.ws + WS_SIN);
    LAS float* w1 = (LAS float*)(F.lds + F.wave * ATT_WAVE_BYTES); LAS float* q = w1 + 2304;
    for (int it = F.gw; it < ML * 4; it += F.NGW) {
        const int m = it >> 2, h = it & 3, b = m >> 11, NK = CTXL + SEQ, t = m & (SEQ - 1);
        const bf16* qp = Q + (size_t)m * 768 + h * 192;
        q[F.lane] = bf2f(qp[F.lane]); q[64 + F.lane] = bf2f(qp[64 + F.lane]);
        if (F.lane < 32) { const float t0 = bf2f(qp[128 + 2 * F.lane]), t1 = bf2f(qp[129 + 2 * F.lane]), cs = COS[t * 32 + F.lane], sn = SIN[t * 32 + F.lane];
            q[128 + 2 * F.lane] = t0 * cs - t1 * sn; q[129 + 2 * F.lane] = t0 * sn + t1 * cs; }
        LDS_WAIT(); asm volatile("" ::: "memory");
        float mx = -3.0e38f;
        for (int j = F.lane; j < NK; j += 64) { const int kr = key_row(b, j); const bf16* kn = KV + (size_t)kr * 1024 + h * 256; const bf16* kp = P + (size_t)kr * OD_INP + OD_KR;
            const float s = (dot64_lds(kn, q) + dot64_lds(kn + 64, q + 64) + dot64_lds(kp, q + 128)) * MLA_SCALE; w1[j] = s; mx = fmaxf(mx, s); }
        mx = wave_max(mx);
        float sum = 0.f;
        for (int j = F.lane; j < NK; j += 64) { const float e = __expf(w1[j] - mx); w1[j] = e; sum += e; }
        const float inv = 1.0f / wave_sum(sum);
        LDS_WAIT(); asm volatile("" ::: "memory");
        float a0 = 0.f, a1 = 0.f;
        const bf16* vbase = KV + h * 256 + 128 + 2 * F.lane;
        for (int j = 0; j < NK; j += 4) {
            unsigned vv[4]; float ww[4];
#pragma unroll
            for (int u = 0; u < 4; ++u) { vv[u] = *(const GAS unsigned*)(vbase + (size_t)key_row(b, j + u) * 1024); ww[u] = w1[j + u]; }
#pragma unroll
            for (int u = 0; u < 4; ++u) { a0 += ww[u] * bflo(vv[u]); a1 += ww[u] * bfhi(vv[u]); }
        }
        *(float2*)(OM + (size_t)m * 512 + h * 128 + 2 * F.lane) = make_float2(a0 * inv, a1 * inv);
        LDS_WAIT(); asm volatile("" ::: "memory");
    }
}


__device__ __forceinline__ void p_attn0(Frame& F) {
    const bf16* P = (const bf16*)(F.ws + WS_P); float* OA = (float*)(F.ws + WS_OA);
    const float lam = *(const float*)(F.ws + WS_SCAL);
    const float C = DA_SCALE * 1.4426950408889634f, THRS = att::THR / DA_SCALE;
    const int r32 = F.lane & 31, hi = F.lane >> 5;
    for (int u = blockIdx.x; u < 288; u += F.G) {
        int bh, qb, NT;
        if (u < 256) { const int x = u & 7, y = u >> 3; bh = x * 4 + (y & 3); qb = y >> 2; NT = 36; } else { bh = u - 256; qb = 0; NT = 4; }
        const int b = bh >> 2, h = bh & 3;
        const int m0 = (u < 256 ? b * SEQ + qb * 256 : ML + b * CTXL) + F.wave * 32;
        const bf16* Qw = P + (size_t)(m0 + r32) * EV_INP + EV_QA + h * 128 + hi * 8;
#pragma unroll 1
        for (int pass = 0; pass < 2; ++pass) {
            att::Src S; S.kbase = P + EV_KA + h * 128 + 64 * pass; S.ldk = EV_INP; S.k2base = nullptr; S.ldk2 = 0; S.vbase = P + EV_VA + h * 128; S.ldv = EV_INP; S.rowc = ML + b * CTXL; S.rowl = b * SEQ; S.NT = NT;
            att::f32x16 o[4]; float l; float rli[16];
            att::attn_core<64, false, true>(Qw + 64 * pass, S, F.lds, C, THRS, o, l, F.tid, nullptr, nullptr);
            att::row_inv(l, F.lds, 64 * 128, F.tid, rli);
            const float sc = pass ? -lam : 1.0f;
            int lo_ = F.lane; asm volatile("" : "+v"(lo_));
            float* Ow = OA + (size_t)m0 * 512 + h * 128; const unsigned ob = (unsigned)((lo_ >> 5) * 4 * 512 + (lo_ & 31));
#pragma unroll
            for (int r = 0; r < 16; ++r)
#pragma unroll
                for (int d0 = 0; d0 < 4; ++d0) { float* p = Ow + (ob + (unsigned)(((r & 3) + 8 * (r >> 2)) * 512 + d0 * 32)); const float v = o[d0][r] * rli[r] * sc; *p = pass ? *p + v : v; if (d0 == 3 && (r & 1)) asm volatile("" ::: "memory"); }
        }
    }
}
__device__ __forceinline__ void p_attn1(Frame& F) {
    const bf16* P = (const bf16*)(F.ws + WS_P); const bf16* Q = (const bf16*)(F.ws + WS_Q); const bf16* KV = (const bf16*)(F.ws + WS_KV); float* OM = (float*)(F.ws + WS_OM);
    const float* COS = (const float*)(F.ws + WS_COS); const float* SIN = (const float*)(F.ws + WS_SIN);
    const float C = MLA_SCALE * 1.4426950408889634f, THRS = att::THR / MLA_SCALE;
    const int r32 = F.lane & 31, hi = F.lane >> 5;
    for (int u = blockIdx.x; u < 256; u += F.G) {
        const int x = u & 7, y = u >> 3, bh = x * 4 + (y & 3), qb = y >> 2, b = bh >> 2, h = bh & 3;
        const int m0 = b * SEQ + qb * 256 + F.wave * 32;
        att::Src S; S.kbase = KV + h * 256; S.ldk = 1024; S.k2base = P + OD_KR; S.ldk2 = OD_INP; S.vbase = KV + h * 256 + 128; S.ldv = 1024; S.rowc = ML + b * CTXL; S.rowl = b * SEQ; S.NT = 36;
        const int t = (m0 + r32) & (SEQ - 1);
        att::f32x16 o[4]; float l; float rli[16];
        att::attn_core<192, true, false>(Q + (size_t)(m0 + r32) * 768 + h * 192 + hi * 8, S, F.lds, C, THRS, o, l, F.tid, COS + t * 32, SIN + t * 32);
        att::row_inv(l, F.lds, 64 * 384, F.tid, rli);
        int lo_ = F.lane; asm volatile("" : "+v"(lo_));
        float* Ow = OM + (size_t)m0 * 512 + h * 128; const unsigned ob = (unsigned)((lo_ >> 5) * 4 * 512 + (lo_ & 31));
#pragma unroll
        for (int r = 0; r < 16; ++r)
#pragma unroll
            for (int d0 = 0; d0 < 4; ++d0) Ow[ob + (unsigned)(((r & 3) + 8 * (r >> 2)) * 512 + d0 * 32)] = o[d0][r] * rli[r];
    }
}
__device__ __forceinline__ int scan_row(int b, int d, int s) {
    if (s < CTXL) return ML + b * CTXL + (d ? (CTXL - 1 - s) : s);
    const int t = s - CTXL; return b * SEQ + (d ? (SEQ - 1 - t) : t);
}
__device__ __forceinline__ void p_scan0(Frame& F) {
    const bf16* P = (const bf16*)(F.ws + WS_P); const float* GK = (const float*)(F.ws + WS_GK);
    LAS float* qL = (LAS float*)F.lds; LAS float* kL = qL + 2048; LAS float* eL = kL + 2048; LAS float* vL = eL + 2048; LAS float* part = vL + 4096;
    const int v = F.tid & 127, kg = F.tid >> 7;
    for (int ch = blockIdx.x; ch < 64; ch += F.G) {
        const int b = ch >> 3, h = (ch >> 1) & 3, d = ch & 1;
        float* OB = (float*)(F.ws + (d ? WS_OBB : WS_OBF));
        float S[16];
#pragma unroll
        for (int i = 0; i < 16; ++i) S[i] = 0.f;
        for (int c = 0; c < (CTXL + SEQ) / 32; ++c) {
            for (int i = F.tid; i < 32 * 64; i += NTHR) { const int r = i >> 6, k = i & 63; const size_t row = (size_t)scan_row(b, d, c * 32 + r);
                qL[i] = bf2f(P[row * EV_INP + EV_QB + h * 64 + k]) * GLA_QSCALE; kL[i] = bf2f(P[row * EV_INP + EV_KB + h * 64 + k]); eL[i] = __expf(GK[((size_t)d * MT + row) * 256 + h * 64 + k]); }
            for (int i = F.tid; i < 32 * 128; i += NTHR) { const int r = i >> 7, vv = i & 127; const size_t row = (size_t)scan_row(b, d, c * 32 + r); vL[i] = bf2f(P[row * EV_INP + EV_VB + h * 128 + vv]); }
            __syncthreads();
            for (int r = 0; r < 32; ++r) { const float vv = vL[r * 128 + v]; float po = 0.f;
#pragma unroll
                for (int kk = 0; kk < 16; ++kk) { const int k = kg * 16 + kk; S[kk] = S[kk] * eL[r * 64 + k] + kL[r * 64 + k] * vv; po += S[kk] * qL[r * 64 + k]; }
                part[(r * 4 + kg) * 128 + v] = po; }
            __syncthreads();
            for (int i = F.tid; i < 32 * 128; i += NTHR) { const int r = i >> 7, vv = i & 127; const size_t row = (size_t)scan_row(b, d, c * 32 + r);
                OB[row * 512 + h * 128 + vv] = (part[(r * 4 + 0) * 128 + vv] + part[(r * 4 + 1) * 128 + vv]) + (part[(r * 4 + 2) * 128 + vv] + part[(r * 4 + 3) * 128 + vv]); }
            __syncthreads();
        }
    }
}
__device__ __forceinline__ void p_scan1(Frame& F) {
    const bf16* P = (const bf16*)(F.ws + WS_P); const float* LB = (const float*)(F.ws + WS_SCAL) + 256;
    LAS float* qL = (LAS float*)F.lds; LAS float* fL = qL + 4096; LAS float* vL = fL + 4096; LAS float* part = vL + 4096;
    const int v = F.tid & 127, kg = F.tid >> 7;
    for (int ch = blockIdx.x; ch < 64; ch += F.G) {
        const int b = ch >> 3, h = (ch >> 1) & 3, d = ch & 1;
        float* OH = (float*)(F.ws + (d ? WS_OHB : WS_OHF));
        const int fcol = (d ? OD_HFB : OD_HFF) + h * 128;
        float S[32];
#pragma unroll
        for (int i = 0; i < 32; ++i) S[i] = 0.f;
        for (int c = 0; c < (CTXL + SEQ) / 32; ++c) {
            for (int i = F.tid; i < 32 * 128; i += NTHR) { const int r = i >> 7, k = i & 127; const size_t row = (size_t)scan_row(b, d, c * 32 + r); const bf16* pr = P + row * OD_INP;
                const float lb = LB[h * 128 + k];
                qL[i] = bf2f(pr[OD_HQ + h * 128 + k]); fL[i] = lb + (1.0f - lb) * sigmoidf_(bf2f(pr[fcol + k])); vL[i] = bf2f(pr[OD_HI + h * 128 + k]); }
            __syncthreads();
            for (int r = 0; r < 32; ++r) { const float vv = vL[r * 128 + v]; float po = 0.f;
#pragma unroll
                for (int kk = 0; kk < 32; ++kk) { const int k = kg * 32 + kk; const float f = fL[r * 128 + k]; S[kk] = S[kk] * f + (1.0f - f) * vv; po += S[kk] * qL[r * 128 + k]; }
                part[(r * 4 + kg) * 128 + v] = po; }
            __syncthreads();
            if (c >= CTXL / 32) {
                for (int i = F.tid; i < 32 * 128; i += NTHR) { const int r = i >> 7, vv = i & 127; const size_t row = (size_t)scan_row(b, d, c * 32 + r);
                    OH[row * 512 + h * 128 + vv] = (part[(r * 4 + 0) * 128 + vv] + part[(r * 4 + 1) * 128 + vv]) + (part[(r * 4 + 2) * 128 + vv] + part[(r * 4 + 3) * 128 + vv]); }
            }
            __syncthreads();
        }
    }
}

namespace scn {
#define SCN_BAR() do { asm volatile("s_waitcnt lgkmcnt(0)" ::: "memory"); __builtin_amdgcn_s_barrier(); asm volatile("" ::: "memory"); } while (0)
typedef short bf16x8 __attribute__((ext_vector_type(8)));
typedef float f32x16 __attribute__((ext_vector_type(16)));
typedef unsigned u32x4 __attribute__((ext_vector_type(4)));
typedef unsigned u32x2 __attribute__((ext_vector_type(2)));
__device__ __forceinline__ unsigned cvtpk(float lo, float hi) { unsigned r; asm volatile("v_cvt_pk_bf16_f32 %0, %1, %2" : "=v"(r) : "v"(lo), "v"(hi)); return r; }
__device__ __forceinline__ int crow(int r, int hi) { return (r & 3) + 8 * (r >> 2) + 4 * hi; }
template <int DK> struct Lay {
    static constexpr int RS = DK * 2 + 16;
    static constexpr int TS = 80;
    static constexpr int QA = 0, KA = QA + 32 * RS, QB = KA + 32 * RS, KDT = QB + 32 * RS, VT = KDT + DK * TS, DEC = VT + 128 * TS, BUF = DEC + DK * 4;
};
__device__ __forceinline__ bf16x8 pack8(const f32x16& x, int s8) {
    u32x4 w; w.x = cvtpk(x[s8 + 0], x[s8 + 1]); w.y = cvtpk(x[s8 + 2], x[s8 + 3]); w.z = cvtpk(x[s8 + 4], x[s8 + 5]); w.w = cvtpk(x[s8 + 6], x[s8 + 7]); return __builtin_bit_cast(bf16x8, w);
}
__device__ __forceinline__ bf16x8 ld2x8(const LAS unsigned char* p) {
    const u32x2 a = *(const LAS u32x2*)p, b = *(const LAS u32x2*)(p + 16); u32x4 w; w.x = a.x; w.y = a.y; w.z = b.x; w.w = b.y; return __builtin_bit_cast(bf16x8, w);
}
__device__ __forceinline__ float dpp_f(float x, const int ctrl, const int row_mask, const bool bc) {
    return __builtin_bit_cast(float, ctrl == 0x111 ? __builtin_amdgcn_update_dpp(0, __builtin_bit_cast(int, x), 0x111, 0xf, 0xf, true)
                                   : ctrl == 0x112 ? __builtin_amdgcn_update_dpp(0, __builtin_bit_cast(int, x), 0x112, 0xf, 0xf, true)
                                   : ctrl == 0x114 ? __builtin_amdgcn_update_dpp(0, __builtin_bit_cast(int, x), 0x114, 0xf, 0xf, true)
                                   : ctrl == 0x118 ? __builtin_amdgcn_update_dpp(0, __builtin_bit_cast(int, x), 0x118, 0xf, 0xf, true)
                                   : __builtin_amdgcn_update_dpp(0, __builtin_bit_cast(int, x), 0x142, 0xa, 0xf, false));
}
__device__ __forceinline__ float prefix32(float x) {
    x += dpp_f(x, 0x111, 0xf, true); x += dpp_f(x, 0x112, 0xf, true); x += dpp_f(x, 0x114, 0xf, true); x += dpp_f(x, 0x118, 0xf, true); x += dpp_f(x, 0x142, 0xa, false);
    return x;
}
__device__ __forceinline__ float bcast_half(float x, const int l, int hi) {
    const float a = __builtin_bit_cast(float, __builtin_amdgcn_readlane(__builtin_bit_cast(int, x), l)), b = __builtin_bit_cast(float, __builtin_amdgcn_readlane(__builtin_bit_cast(int, x), l + 32));
    return hi ? b : a;
}
constexpr int NSEG = 4, SEGC = (CTXL + SEQ) / 32 / NSEG;
static_assert(SEGC % 3 == 0, "producer loop unrolled by 3");
template <int LAYER, bool OUT>
__device__ __forceinline__ void scan_seg(Frame& F, int u, LAS unsigned char* lds) {
    constexpr int DK = LAYER == 0 ? 64 : 128, NC = DK / 8, NMB = DK / 32, PITCH = LAYER == 0 ? EV_INP : OD_INP;
    typedef Lay<DK> LY;
    const int ch = u / NSEG, seg = u % NSEG, c0 = seg * SEGC;
    const int b = ch >> 3, h = (ch >> 1) & 3, d = ch & 1;
    const bf16* P = (const bf16*)(F.ws + WS_P);
    const int lane = F.lane, r32_o = lane & 31, hi = lane >> 5;
    const bool producer = F.wave >= 4; const int pw = F.wave & 3;
    constexpr int NCHUNK = SEGC;
    float* const EST = (float*)(F.ws + WS_SCAN_E); float* const DST = (float*)(F.ws + WS_SCAN_D);
    __syncthreads();
    if (producer) {
        const int kc0 = NC * (2 * pw + hi), vc0 = 32 * pw + 16 * hi;
        struct Raw { u32x4 rq[NC / 8]; u32x4 rk; u32x4 rv[2]; f32x4 rg[NC / 4]; };
        Raw RA, RB, RC;
        const float* GG = LAYER == 0 ? (const float*)(F.ws + WS_GK) + (size_t)d * MT * 256 + h * 64 + kc0 : (const float*)(F.ws + WS_GH) + (size_t)d * MT * 512 + h * 128 + kc0;
#define SCN_FETCH(X, n) do { const int _s = 32 * (c0 + (n)) + r32; const size_t _row = (size_t)scan_row(b, d, _s); const bf16* pr = P + _row * PITCH; const float* gr = GG + _row * (LAYER == 0 ? 256 : 512); \
        _Pragma("unroll") for (int _q = 0; _q < NC / 4; ++_q) X.rg[_q] = *(const f32x4*)(gr + 4 * _q); \
        if (LAYER == 0) { X.rq[0] = *(const GAS u32x4*)(pr + EV_QB + h * 64 + kc0); X.rk = *(const GAS u32x4*)(pr + EV_KB + h * 64 + kc0); \
            X.rv[0] = *(const GAS u32x4*)(pr + EV_VB + h * 128 + vc0); X.rv[1] = *(const GAS u32x4*)(pr + EV_VB + h * 128 + vc0 + 8); } \
        else { _Pragma("unroll") for (int _q = 0; _q < NC / 8; ++_q) X.rq[_q] = *(const GAS u32x4*)(pr + OD_HQ + h * 128 + kc0 + 8 * _q); \
            X.rv[0] = *(const GAS u32x4*)(pr + OD_HI + h * 128 + vc0); X.rv[1] = *(const GAS u32x4*)(pr + OD_HI + h * 128 + vc0 + 8); } } while (0)
#define SCN_STEP(X, n) do { \
            LAS unsigned char* buf = lds + ((n) & 1) * LY::BUF; \
            int r32 = r32_o; asm volatile("" : "+v"(r32)); \
            float qq[NC], kk[NC], gg[NC]; \
            _Pragma("unroll") for (int j = 0; j < NC; ++j) { const unsigned wq = X.rq[j >> 3][(j >> 1) & 3]; qq[j] = (j & 1) ? bfhi(wq) : bflo(wq); gg[j] = X.rg[j >> 2][j & 3]; } \
            if (LAYER == 0) { _Pragma("unroll") for (int j = 0; j < NC; ++j) { const unsigned wk = X.rk[(j >> 1) & 3]; kk[j] = (j & 1) ? bfhi(wk) : bflo(wk); qq[j] *= GLA_QSCALE; } } \
            else { _Pragma("unroll") for (int j = 0; j < NC; ++j) kk[j] = 1.0f - __expf(gg[j]); } \
            { LAS unsigned short* vt = (LAS unsigned short*)(buf + LY::VT); \
              _Pragma("unroll") for (int j = 0; j < 16; ++j) { const unsigned w = X.rv[j >> 3][(j >> 1) & 3]; vt[(vc0 + j) * (LY::TS / 2) + r32] = (unsigned short)((j & 1) ? (w >> 16) : (w & 0xffffu)); } } \
            if ((n) + 3 < NCHUNK) SCN_FETCH(X, (n) + 3); \
            u32x4 wqa[NC / 8], wka[NC / 8], wqb[NC / 8]; (void)wqa; (void)wka; (void)wqb; \
            LAS unsigned short* kdt = (LAS unsigned short*)(buf + LY::KDT); \
            LAS float* dec = (LAS float*)(buf + LY::DEC); \
            _Pragma("unroll") for (int j2 = 0; j2 < NC; j2 += 2) { \
                float oqa[2], oka[2], oqb[2]; \
                _Pragma("unroll") for (int u = 0; u < 2; ++u) { const int j = j2 + u; \
                    const float bc = prefix32(gg[j]), bref = bcast_half(bc, 15, hi), blast = bcast_half(bc, 31, hi); \
                    if (OUT) { oqa[u] = qq[j] * __expf(bc - bref); oka[u] = kk[j] * __expf(bref - bc); oqb[u] = qq[j] * __expf(bc); } else { oqa[u] = 0.f; oka[u] = 0.f; oqb[u] = 0.f; dsum[j] += blast; } \
                    const float kd = kk[j] * __expf(blast - bc); \
                    kdt[(kc0 + j) * (LY::TS / 2) + r32] = (unsigned short)(cvtpk(kd, 0.f) & 0xffffu); \
                    if (r32 == 31) dec[kc0 + j] = __expf(blast); } \
                if (OUT) { wqa[j2 >> 3][(j2 >> 1) & 3] = cvtpk(oqa[0], oqa[1]); wka[j2 >> 3][(j2 >> 1) & 3] = cvtpk(oka[0], oka[1]); wqb[j2 >> 3][(j2 >> 1) & 3] = cvtpk(oqb[0], oqb[1]); } } \
            if (OUT) { _Pragma("unroll") for (int q = 0; q < NC / 8; ++q) { const int off = r32 * LY::RS + (kc0 + 8 * q) * 2; \
                *(LAS u32x4*)(buf + LY::QA + off) = wqa[q]; *(LAS u32x4*)(buf + LY::KA + off) = wka[q]; *(LAS u32x4*)(buf + LY::QB + off) = wqb[q]; } } \
            SCN_BAR(); } while (0)
        float dsum[NC];
#pragma unroll
        for (int j = 0; j < NC; ++j) dsum[j] = 0.f;
        { const int r32 = r32_o; SCN_FETCH(RA, 0); SCN_FETCH(RB, 1); SCN_FETCH(RC, 2); }
        for (int n = 0; n < NCHUNK; n += 3) { SCN_STEP(RA, n); SCN_STEP(RB, n + 1); SCN_STEP(RC, n + 2); }
        SCN_BAR();
        if (!OUT && r32_o == 0) {
#pragma unroll
            for (int j = 0; j < NC; ++j) DST[(size_t)u * DK + kc0 + j] = __expf(dsum[j]);
        }
#undef SCN_FETCH
#undef SCN_STEP
    } else {
        const int w = pw;
        f32x16 S[NMB];
#pragma unroll
        for (int mb = 0; mb < NMB; ++mb) S[mb] = f32x16{};
        if (OUT) {
            for (int js = 0; js < seg; ++js) { const size_t uj = (size_t)ch * NSEG + js;
#pragma unroll
                for (int mb = 0; mb < NMB; ++mb) { const float* e = EST + uj * (DK * 128) + (size_t)((w * NMB + mb) * 16) * 64 + lane; const float* dd = DST + uj * DK + 32 * mb + 4 * hi;
#pragma unroll
                    for (int r = 0; r < 16; ++r) S[mb][r] = S[mb][r] * dd[(r & 3) + 8 * (r >> 2)] + e[r * 64]; } }
        }
        float* OB = (float*)(F.ws + (LAYER == 0 ? (d ? WS_OBB : WS_OBF) : (d ? WS_OHB : WS_OHF)));
        SCN_BAR();
        for (int n = 0; n < NCHUNK; ++n) {
            const LAS unsigned char* buf = lds + (n & 1) * LY::BUF;
            int r32 = r32_o; asm volatile("" : "+v"(r32));
            const LAS unsigned char* vtr = buf + LY::VT + (32 * w + r32) * LY::TS;
            if (OUT) {
            f32x16 at = f32x16{};
#pragma unroll
            for (int s = 0; s < DK / 16; ++s) { const int off = r32 * LY::RS + (16 * s + 8 * hi) * 2;
                at = __builtin_amdgcn_mfma_f32_32x32x16_bf16(*(const LAS bf16x8*)(buf + LY::KA + off), *(const LAS bf16x8*)(buf + LY::QA + off), at, 0, 0, 0); }
#pragma unroll
            for (int r = 0; r < 16; ++r) if (crow(r, hi) > r32) at[r] = 0.f;
            f32x16 o = f32x16{};
#pragma unroll
            for (int s = 0; s < 2; ++s) o = __builtin_amdgcn_mfma_f32_32x32x16_bf16(pack8(at, 8 * s), ld2x8(vtr + (16 * s + 4 * hi) * 2), o, 0, 0, 0);
#pragma unroll
            for (int mb = 0; mb < NMB; ++mb)
#pragma unroll
                for (int s = 0; s < 2; ++s)
                    o = __builtin_amdgcn_mfma_f32_32x32x16_bf16(ld2x8(buf + LY::QB + r32 * LY::RS + (32 * mb + 16 * s + 4 * hi) * 2), pack8(S[mb], 8 * s), o, 0, 0, 0);
            if (LAYER == 0 || c0 + n >= CTXL / 32) {
                const int row0 = scan_row(b, d, 32 * (c0 + n)), sg = d ? -1 : 1;
                float* ob = OB + (size_t)row0 * 512 + h * 128 + 32 * w + r32;
#pragma unroll
                for (int r = 0; r < 16; ++r) ob[(ptrdiff_t)(sg * crow(r, hi)) * 512] = o[r];
            }
            }
#pragma unroll
            for (int mb = 0; mb < NMB; ++mb) {
                const LAS float* dc = (const LAS float*)(buf + LY::DEC) + 32 * mb + 4 * hi;
#pragma unroll
                for (int g = 0; g < 4; ++g) { const f32x4 dv = *(const LAS f32x4*)(dc + 8 * g);
                    S[mb][4 * g + 0] *= dv.x; S[mb][4 * g + 1] *= dv.y; S[mb][4 * g + 2] *= dv.z; S[mb][4 * g + 3] *= dv.w; }
#pragma unroll
                for (int s = 0; s < 2; ++s)
                    S[mb] = __builtin_amdgcn_mfma_f32_32x32x16_bf16(*(const LAS bf16x8*)(buf + LY::KDT + (32 * mb + r32) * LY::TS + (16 * s + 8 * hi) * 2),
                                                                   *(const LAS bf16x8*)(vtr + (16 * s + 8 * hi) * 2), S[mb], 0, 0, 0);
            }
            SCN_BAR();
        }
        if (!OUT) {
#pragma unroll
            for (int mb = 0; mb < NMB; ++mb) { float* e = EST + (size_t)u * (DK * 128) + (size_t)((w * NMB + mb) * 16) * 64 + lane;
#pragma unroll
                for (int r = 0; r < 16; ++r) e[r * 64] = S[mb][r]; }
        }
    }
}
}

__device__ __forceinline__ int scan_unit(int p) { return ((p & 63) << 2) | (3 - (p >> 6)); }
template <int LAYER> __device__ __forceinline__ void p_scan_pass1(Frame& F) { for (int p = blockIdx.x; p < 64 * scn::NSEG; p += F.G) { const int u = scan_unit(p); if (u % scn::NSEG == scn::NSEG - 1) continue; scn::scan_seg<LAYER, false>(F, u, F.lds); __syncthreads(); } }
template <int LAYER> __device__ __forceinline__ void p_scan_pass2(Frame& F) { for (int p = blockIdx.x; p < 64 * scn::NSEG; p += F.G) { scn::scan_seg<LAYER, true>(F, scan_unit(p), F.lds); __syncthreads(); } }
__device__ __forceinline__ void p_merge0(Frame& F) {
    const bf16* P = (const bf16*)(F.ws + WS_P); const float* OA = (const float*)(F.ws + WS_OA); const float* OBF = (const float*)(F.ws + WS_OBF); const float* OBB = (const float*)(F.ws + WS_OBB);
    bf16* A = (bf16*)(F.ws + WS_H);
    const int c = 2 * F.lane;
    for (int it = F.gw; it < MT * 8; it += F.NGW) {
        const int m = it >> 3, seg = it & 7; float o0, o1;
        if (seg < 4) { const float2 v = *(const float2*)(OA + (size_t)m * 512 + seg * 128 + c);
            const float r = rsqrtf(wave_sum(v.x * v.x + v.y * v.y) * (1.0f / 128.0f) + RMS_EPS) * (1.0f - LAM_INIT0);
            o0 = v.x * r * F.in[I_EV_SUBLN][c]; o1 = v.y * r * F.in[I_EV_SUBLN][c + 1]; }
        else { const int h = seg - 4; const float2 a = *(const float2*)(OBF + (size_t)m * 512 + h * 128 + c), bq = *(const float2*)(OBB + (size_t)m * 512 + h * 128 + c);
            const float v0 = a.x + bq.x, v1 = a.y + bq.y; const float r = rsqrtf(wave_sum(v0 * v0 + v1 * v1) * (1.0f / 128.0f) + RMS_EPS);
            const unsigned gw_ = *(const GAS unsigned*)(P + (size_t)m * EV_INP + EV_GB + h * 128 + c);
            o0 = v0 * r * F.in[I_EV_GLAG][c] * siluf_(bflo(gw_)); o1 = v1 * r * F.in[I_EV_GLAG][c + 1] * siluf_(bfhi(gw_)); }
        *(GAS unsigned*)(A + (size_t)m * DM + seg * 128 + c) = pk2(o0, o1);
    }
}
__device__ __forceinline__ void p_merge1(Frame& F) {
    const bf16* P = (const bf16*)(F.ws + WS_P); const float* OM = (const float*)(F.ws + WS_OM); const float* OHF = (const float*)(F.ws + WS_OHF); const float* OHB = (const float*)(F.ws + WS_OHB);
    bf16* A = (bf16*)(F.ws + WS_H);
    const int c = 2 * F.lane;
    for (int it = F.gw; it < ML * 8; it += F.NGW) {
        const int m = it >> 3, seg = it & 7; float o0, o1;
        if (seg < 4) { const float2 v = *(const float2*)(OM + (size_t)m * 512 + seg * 128 + c); o0 = v.x; o1 = v.y; }
        else { const int h = seg - 4; const float2 a = *(const float2*)(OHF + (size_t)m * 512 + h * 128 + c), bq = *(const float2*)(OHB + (size_t)m * 512 + h * 128 + c);
            const float v0 = a.x + bq.x, v1 = a.y + bq.y; const float r = rsqrtf(wave_sum(v0 * v0 + v1 * v1) * (1.0f / 128.0f) + RMS_EPS);
            const unsigned gw_ = *(const GAS unsigned*)(P + (size_t)m * OD_INP + OD_HG + h * 128 + c);
            o0 = v0 * r * F.in[I_OD_HGG][c] * siluf_(bflo(gw_)); o1 = v1 * r * F.in[I_OD_HGG][c + 1] * siluf_(bfhi(gw_)); }
        *(GAS unsigned*)(A + (size_t)m * DM + seg * 128 + c) = pk2(o0, o1);
    }
}

template <bool BASE_SRC, bool DO_H, bool ROUTER>
__device__ __forceinline__ void p_ln(Frame& F, int nrows, const float* base, const bf16* y, int l, int gate_chunk, int ln_slot, float* xout, int hl, int hsc, int hsh, const float* ypart = nullptr, int nsp = 0) {
    const float* MOD = (const float*)(F.ws + WS_MOD); bf16* H = (bf16*)(F.ws + WS_H);
    const float* G = F.in[I_LNG] + (size_t)(l * 2 + ln_slot) * DM; const float* Bb = F.in[I_LNB] + (size_t)(l * 2 + ln_slot) * DM;
    for (int m = F.gw; m < nrows; m += F.NGW) {
        const float* br = BASE_SRC ? src_row(F, m) : base + (size_t)m * DM; const bf16* yr = y + (size_t)m * DM;
        const float* mr = MOD + (size_t)(l * 9 + mod_row(m)) * 6144 + gate_chunk * 1024;
        f32x4 t[4]; float s = 0.f;
#pragma unroll
        for (int j = 0; j < 4; ++j) { const int c = 4 * F.lane + 256 * j; f32x4 yv;
            if (nsp && m >= ML) { yv = (f32x4){0.f, 0.f, 0.f, 0.f}; for (int sp = 0; sp < nsp; ++sp) yv = yv + *(const f32x4*)(ypart + ((size_t)sp * MC + (m - ML)) * DM + c); }
            else yv = ld_bf16x4(yr + c);
            t[j] = *(const f32x4*)(br + c) * DN_ALPHA + *(const f32x4*)(mr + c) * yv; s += (t[j].x + t[j].y) + (t[j].z + t[j].w); }
        const float mean = wave_sum(s) * (1.0f / DM); float s2 = 0.f;
#pragma unroll
        for (int j = 0; j < 4; ++j) { t[j] = t[j] - mean; s2 += (t[j].x * t[j].x + t[j].y * t[j].y) + (t[j].z * t[j].z + t[j].w * t[j].w); }
        const float rstd = rsqrtf(wave_sum(s2) * (1.0f / DM) + LN_EPS);
        float lg[8];
#pragma unroll
        for (int e = 0; e < 8; ++e) lg[e] = 0.f;
#pragma unroll
        for (int j = 0; j < 4; ++j) { const int c = 4 * F.lane + 256 * j; const f32x4 xo = t[j] * rstd * *(const f32x4*)(G + c) + *(const f32x4*)(Bb + c);
            if (xout) *(f32x4*)(xout + (size_t)m * DM + c) = xo;
            if (DO_H) { const float* hr = MOD + (size_t)(hl * 9 + mod_row(m)) * 6144; const f32x4 hv = xo * (1.0f + *(const f32x4*)(hr + hsc * 1024 + c)) + *(const f32x4*)(hr + hsh * 1024 + c);
                store_bf16x4(H + (size_t)m * DM + c, hv);
                if (ROUTER) { const float* wr = F.in[I_OD_ROUTER] + (size_t)c * 8;
#pragma unroll
                    for (int q = 0; q < 4; ++q) { const f32x4 wa = *(const f32x4*)(wr + q * 8), wb = *(const f32x4*)(wr + q * 8 + 4); const float hq = hv[q];
                        lg[0] += hq * wa.x; lg[1] += hq * wa.y; lg[2] += hq * wa.z; lg[3] += hq * wa.w; lg[4] += hq * wb.x; lg[5] += hq * wb.y; lg[6] += hq * wb.z; lg[7] += hq * wb.w; } } }
        }
        if (ROUTER) {
#pragma unroll
            for (int e = 0; e < 8; ++e) lg[e] = wave_sum(lg[e]);
            int i0 = 0; float v0 = lg[0];
#pragma unroll
            for (int e = 1; e < 8; ++e) if (lg[e] > v0) { v0 = lg[e]; i0 = e; }
            int i1 = -1; float v1 = -3.0e38f;
#pragma unroll
            for (int e = 0; e < 8; ++e) if (e != i0 && lg[e] > v1) { v1 = lg[e]; i1 = e; }
            const float g0 = 1.0f / (1.0f + __expf(v1 - v0)), g1 = 1.0f - g0;
            if (F.lane == 0) { v4u o; o.x = (unsigned)i0; o.y = (unsigned)i1; o.z = __float_as_uint(g0); o.w = __float_as_uint(g1); *(GAS v4u*)(F.ws + WS_ROUTE + (size_t)m * 16) = o; }
        }
    }
}

__device__ __forceinline__ void p_post1(Frame& F) {
    bf16* P = (bf16*)(F.ws + WS_P); bf16* NQ = (bf16*)(F.ws + WS_NQ); bf16* NKV = (bf16*)(F.ws + WS_NKV);
    const float* COS = (const float*)(F.ws + WS_COS); const float* SIN = (const float*)(F.ws + WS_SIN);
    for (int m = F.gw; m < MT; m += F.NGW) {
        bf16* pr = P + (size_t)m * OD_INP;
        if (m < ML) {
            const int c = 4 * F.lane; const unsigned long long w = *(const GAS unsigned long long*)(pr + OD_CQ + c);
            const float v0 = bflo((unsigned)w), v1 = bfhi((unsigned)w), v2 = bflo((unsigned)(w >> 32)), v3 = bfhi((unsigned)(w >> 32));
            const float r = rsqrtf(wave_sum((v0 * v0 + v1 * v1) + (v2 * v2 + v3 * v3)) * (1.0f / 256.0f) + RMS_EPS);
            const f32x4 g = *(const f32x4*)(F.in[I_OD_QNG] + c);
            store_bf16x4(NQ + (size_t)m * 256 + c, (f32x4){v0 * r * g.x, v1 * r * g.y, v2 * r * g.z, v3 * r * g.w});
        }
        { const int c = 2 * F.lane; const unsigned w = *(const GAS unsigned*)(pr + OD_CKV + c); const float v0 = bflo(w), v1 = bfhi(w);
          const float r = rsqrtf(wave_sum(v0 * v0 + v1 * v1) * (1.0f / 128.0f) + RMS_EPS);
          *(GAS unsigned*)(NKV + (size_t)m * 256 + c) = pk2(v0 * r * F.in[I_OD_KVNG][c], v1 * r * F.in[I_OD_KVNG][c + 1]);
          *(GAS unsigned*)(NKV + (size_t)m * 256 + 128 + c) = 0u; }
        {
          const float* LB = (const float*)(F.ws + WS_SCAL) + 256; float* GH = (float*)(F.ws + WS_GH);
#pragma unroll
          for (int d = 0; d < 2; ++d) { const int c = 8 * F.lane; const v4u w = *(const GAS v4u*)(pr + (d ? OD_HFB : OD_HFF) + c);
              const f32x4 l0 = *(const f32x4*)(LB + c), l1 = *(const f32x4*)(LB + c + 4); f32x4 o0, o1;
              o0.x = __logf(l0.x + (1.0f - l0.x) * sigmoidf_(bflo(w.x))); o0.y = __logf(l0.y + (1.0f - l0.y) * sigmoidf_(bfhi(w.x))); o0.z = __logf(l0.z + (1.0f - l0.z) * sigmoidf_(bflo(w.y))); o0.w = __logf(l0.w + (1.0f - l0.w) * sigmoidf_(bfhi(w.y)));
              o1.x = __logf(l1.x + (1.0f - l1.x) * sigmoidf_(bflo(w.z))); o1.y = __logf(l1.y + (1.0f - l1.y) * sigmoidf_(bfhi(w.z))); o1.z = __logf(l1.z + (1.0f - l1.z) * sigmoidf_(bflo(w.w))); o1.w = __logf(l1.w + (1.0f - l1.w) * sigmoidf_(bfhi(w.w)));
              float* go = GH + ((size_t)d * MT + m) * 512 + c; *(f32x4*)go = o0; *(f32x4*)(go + 4) = o1; } }
        if (m < ML && F.lane < 32) { const int t = m & (SEQ - 1); const float cs = COS[t * 32 + F.lane], sn = SIN[t * 32 + F.lane];
            const unsigned w = *(const GAS unsigned*)(pr + OD_KR + 2 * F.lane); const float t0 = bflo(w), t1 = bfhi(w);
            *(GAS unsigned*)(pr + OD_KR + 2 * F.lane) = pk2(t0 * cs - t1 * sn, t0 * sn + t1 * cs); }
    }
}

__device__ __forceinline__ void p_act(Frame& F, int nrows) {
    const bf16* U = (const bf16*)(F.ws + WS_U); bf16* ACT = (bf16*)(F.ws + WS_ACT);
    const size_t n8 = (size_t)nrows * (DFF / 8);
    for (size_t i = (size_t)blockIdx.x * NTHR + F.tid; i < n8; i += (size_t)F.G * NTHR) {
        const size_t m = i / (DFF / 8); const int j = (int)(i % (DFF / 8)) * 8;
        const v4u g = *(const GAS v4u*)(U + m * (2 * DFF) + j), u = *(const GAS v4u*)(U + m * (2 * DFF) + DFF + j);
        v4u o; o.x = pk2(siluf_(bflo(g.x)) * bflo(u.x), siluf_(bfhi(g.x)) * bfhi(u.x)); o.y = pk2(siluf_(bflo(g.y)) * bflo(u.y), siluf_(bfhi(g.y)) * bfhi(u.y));
        o.z = pk2(siluf_(bflo(g.z)) * bflo(u.z), siluf_(bfhi(g.z)) * bfhi(u.z)); o.w = pk2(siluf_(bflo(g.w)) * bflo(u.w), siluf_(bfhi(g.w)) * bfhi(u.w));
        *(GAS v4u*)(ACT + m * DFF + j) = o;
    }
}

struct MoeOff { int t1, t2, t3, t4, t5, t6, t7, t8; };
__device__ __forceinline__ MoeOff moe_offsets(const Frame& F) {
    const unsigned* cnt = (const unsigned*)(F.ctl + CW_CNT);
    int n[8];
#pragma unroll
    for (int e = 0; e < 8; ++e) n[e] = (int)((__builtin_amdgcn_readfirstlane((int)cnt[16 * e]) + 255) >> 8);
    MoeOff o; o.t1 = n[0]; o.t2 = o.t1 + n[1]; o.t3 = o.t2 + n[2]; o.t4 = o.t3 + n[3]; o.t5 = o.t4 + n[4]; o.t6 = o.t5 + n[5]; o.t7 = o.t6 + n[6]; o.t8 = o.t7 + n[7];
    return o;
}
__device__ __forceinline__ int moe_tile0(const MoeOff& o, int e) { return e == 0 ? 0 : e == 1 ? o.t1 : e == 2 ? o.t2 : e == 3 ? o.t3 : e == 4 ? o.t4 : e == 5 ? o.t5 : e == 6 ? o.t6 : o.t7; }

__device__ __forceinline__ void p_ln1_router(Frame& F) {
    const float* MOD = (const float*)(F.ws + WS_MOD); bf16* H = (bf16*)(F.ws + WS_H);
    const float* X2 = (const float*)(F.ws + WS_X2); const bf16* Y = (const bf16*)(F.ws + WS_YF); float* X1 = (float*)(F.ws + WS_X1);
    const float* G = F.in[I_LNG] + (size_t)(1 * 2 + 0) * DM; const float* Bb = F.in[I_LNB] + (size_t)(1 * 2 + 0) * DM;
    LAS int* sel = (LAS int*)F.lds; LAS int* base = sel + 128;
    unsigned* POS = (unsigned*)(F.ws + WS_POS);
    for (int mb = blockIdx.x * 64; mb < ML; mb += F.G * 64) {
        for (int rl = F.wave; rl < 64; rl += NWAVES) {
            const int m = mb + rl;
            const float* br = X2 + (size_t)m * DM; const bf16* yr = Y + (size_t)m * DM; const float* mr = MOD + (size_t)(1 * 9 + mod_row(m)) * 6144;
            f32x4 t[4]; float s = 0.f;
#pragma unroll
            for (int j = 0; j < 4; ++j) { const int c = 4 * F.lane + 256 * j; t[j] = *(const f32x4*)(br + c) * DN_ALPHA + *(const f32x4*)(mr + 2 * 1024 + c) * ld_bf16x4(yr + c); s += (t[j].x + t[j].y) + (t[j].z + t[j].w); }
            const float mean = wave_sum(s) * (1.0f / DM); float s2 = 0.f;
#pragma unroll
            for (int j = 0; j < 4; ++j) { t[j] = t[j] - mean; s2 += (t[j].x * t[j].x + t[j].y * t[j].y) + (t[j].z * t[j].z + t[j].w * t[j].w); }
            const float rstd = rsqrtf(wave_sum(s2) * (1.0f / DM) + LN_EPS);
            float lg[8];
#pragma unroll
            for (int e = 0; e < 8; ++e) lg[e] = 0.f;
#pragma unroll
            for (int j = 0; j < 4; ++j) { const int c = 4 * F.lane + 256 * j; const f32x4 xo = t[j] * rstd * *(const f32x4*)(G + c) + *(const f32x4*)(Bb + c);
                *(f32x4*)(X1 + (size_t)m * DM + c) = xo;
                const f32x4 hv = xo * (1.0f + *(const f32x4*)(mr + 4 * 1024 + c)) + *(const f32x4*)(mr + 3 * 1024 + c);
                store_bf16x4(H + (size_t)m * DM + c, hv);
                const float* wr = F.in[I_OD_ROUTER] + (size_t)c * 8;
#pragma unroll
                for (int q = 0; q < 4; ++q) { const f32x4 wa = *(const f32x4*)(wr + q * 8), wb = *(const f32x4*)(wr + q * 8 + 4); const float hq = hv[q];
                    lg[0] += hq * wa.x; lg[1] += hq * wa.y; lg[2] += hq * wa.z; lg[3] += hq * wa.w; lg[4] += hq * wb.x; lg[5] += hq * wb.y; lg[6] += hq * wb.z; lg[7] += hq * wb.w; } }
#pragma unroll
            for (int e = 0; e < 8; ++e) lg[e] = wave_sum(lg[e]);
            int i0 = 0; float v0 = lg[0];
#pragma unroll
            for (int e = 1; e < 8; ++e) if (lg[e] > v0) { v0 = lg[e]; i0 = e; }
            int i1 = -1; float v1 = -3.0e38f;
#pragma unroll
            for (int e = 0; e < 8; ++e) if (e != i0 && lg[e] > v1) { v1 = lg[e]; i1 = e; }
            const float g0 = 1.0f / (1.0f + __expf(v1 - v0)), g1 = 1.0f - g0;
            if (F.lane == 0) { v4u o; o.x = (unsigned)i0; o.y = (unsigned)i1; o.z = __float_as_uint(g0); o.w = __float_as_uint(g1); *(GAS v4u*)(F.ws + WS_ROUTE + (size_t)m * 16) = o;
                sel[rl * 2] = i0; sel[rl * 2 + 1] = i1; }
        }
        __syncthreads();
        if (F.tid < 8) { int c = 0; for (int i = 0; i < 128; ++i) c += (sel[i] == F.tid) ? 1 : 0;
            base[F.tid] = (int)__hip_atomic_fetch_add((unsigned*)(F.ctl + CW_CNT) + 16 * F.tid, (unsigned)c, __ATOMIC_RELAXED, __HIP_MEMORY_SCOPE_AGENT); }
        __syncthreads();
        if (F.tid < 128) { const int e = sel[F.tid]; int rank = 0; for (int i = 0; i < F.tid; ++i) rank += (sel[i] == e) ? 1 : 0; POS[(size_t)mb * 2 + F.tid] = (unsigned)(base[e] + rank); }
        __syncthreads();
    }
}
__device__ __forceinline__ void p_moe_dispatch(Frame& F) {
    const MoeOff o = moe_offsets(F);
    const bf16* H = (const bf16*)(F.ws + WS_H); bf16* HG = (bf16*)(F.ws + WS_HG); const unsigned* POS = (const unsigned*)(F.ws + WS_POS);
    for (int m = F.gw; m < ML; m += F.NGW) {
        const v4u r = *(const GAS v4u*)(F.ws + WS_ROUTE + (size_t)m * 16);
        const int s0 = moe_tile0(o, (int)r.x) * 256 + (int)POS[(size_t)m * 2], s1 = moe_tile0(o, (int)r.y) * 256 + (int)POS[(size_t)m * 2 + 1];
        const v4u a = *(const GAS v4u*)(H + (size_t)m * DM + 8 * F.lane), c = *(const GAS v4u*)(H + (size_t)m * DM + 512 + 8 * F.lane);
        *(GAS v4u*)(HG + (size_t)s0 * DM + 8 * F.lane) = a; *(GAS v4u*)(HG + (size_t)s0 * DM + 512 + 8 * F.lane) = c;
        *(GAS v4u*)(HG + (size_t)s1 * DM + 8 * F.lane) = a; *(GAS v4u*)(HG + (size_t)s1 * DM + 512 + 8 * F.lane) = c;
    }
}
template <class Epi> __device__ __forceinline__ void run_gemm_moe(Frame& F, const bf16* A, const bf16* Bt, int N, int K, size_t estride_bytes, int nsplit, const Epi& E) {
    const MoeOff o = moe_offsets(F);
    pg8::Gemm g{A, Bt, nsplit * o.t8 * 256, N, K, nsplit > 1 ? K / nsplit / 64 : 0}; pg8::GroupedOrder S; S.init(nsplit * o.t8 * 256, N, F.G, (int)blockIdx.x);
    S.t1 = o.t1; S.t2 = o.t2; S.t3 = o.t3; S.t4 = o.t4; S.t5 = o.t5; S.t6 = o.t6; S.t7 = o.t7; S.estride = estride_bytes;
    S.mt = nsplit > 1 ? o.t8 : 0; S.kbytes = (size_t)(K / nsplit) * 2;
    pg8::gemm_phase<Epi, pg8::GroupedOrder, true, true>(F.lds, g, S, E);
}
__device__ __forceinline__ void p_ln_final(Frame& F) {
    const MoeOff o = moe_offsets(F);
    const float* MOD = (const float*)(F.ws + WS_MOD); const float* X1 = (const float*)(F.ws + WS_X1); const bf16* F2 = (const bf16*)(F.ws + WS_F2); const unsigned* POS = (const unsigned*)(F.ws + WS_POS);
    const float* G = F.in[I_LNG] + (size_t)(1 * 2 + 1) * DM; const float* Bb = F.in[I_LNB] + (size_t)(1 * 2 + 1) * DM;
    const size_t half = (size_t)o.t8 * 256 * DM;
    for (int m = F.gw; m < ML; m += F.NGW) {
        const v4u r = *(const GAS v4u*)(F.ws + WS_ROUTE + (size_t)m * 16);
        const int s0 = moe_tile0(o, (int)r.x) * 256 + (int)POS[(size_t)m * 2], s1 = moe_tile0(o, (int)r.y) * 256 + (int)POS[(size_t)m * 2 + 1];
        const float g0 = __uint_as_float(r.z), g1 = __uint_as_float(r.w);
        const float* br = X1 + (size_t)m * DM; const bf16* f0 = F2 + (size_t)s0 * DM; const bf16* f1 = F2 + (size_t)s1 * DM; const float* mr = MOD + (size_t)(1 * 9 + mod_row(m)) * 6144 + 5 * 1024;
        f32x4 t[4]; float s = 0.f;
#pragma unroll
        for (int j = 0; j < 4; ++j) { const int c = 4 * F.lane + 256 * j;
            const f32x4 fv = (ld_bf16x4(f0 + c) + ld_bf16x4(f0 + half + c)) * g0 + (ld_bf16x4(f1 + c) + ld_bf16x4(f1 + half + c)) * g1;
            t[j] = *(const f32x4*)(br + c) * DN_ALPHA + *(const f32x4*)(mr + c) * fv; s += (t[j].x + t[j].y) + (t[j].z + t[j].w); }
        const float mean = wave_sum(s) * (1.0f / DM); float s2 = 0.f;
#pragma unroll
        for (int j = 0; j < 4; ++j) { t[j] = t[j] - mean; s2 += (t[j].x * t[j].x + t[j].y * t[j].y) + (t[j].z * t[j].z + t[j].w * t[j].w); }
        const float rstd = rsqrtf(wave_sum(s2) * (1.0f / DM) + LN_EPS);
#pragma unroll
        for (int j = 0; j < 4; ++j) { const int c = 4 * F.lane + 256 * j; *(f32x4*)(F.out + (size_t)m * DM + c) = t[j] * rstd * *(const f32x4*)(G + c) + *(const f32x4*)(Bb + c); }
    }
}

template <class Epi> __device__ __forceinline__ void run_gemm(Frame& F, const bf16* A, const bf16* Bt, int M, int N, int K, const Epi& E) {
    pg8::Gemm g{A, Bt, M, N, K, 0}; pg8::StaticOrder S; S.init(M, N, F.G, (int)blockIdx.x);
    pg8::gemm_phase<Epi, pg8::StaticOrder, true, true>(F.lds, g, S, E);
}
template <class Epi> __device__ __forceinline__ void run_gemm_split(Frame& F, const bf16* A, const bf16* Bt, int mt, int N, int Kpitch, int nsplit, int ksplit, const Epi& E) {
    pg8::Gemm g{A, Bt, nsplit * mt * 256, N, Kpitch, ksplit / 64}; pg8::SplitOrder S; S.init(nsplit * mt * 256, N, F.G, (int)blockIdx.x); S.mt = mt; S.kbytes = (size_t)ksplit * 2;
    pg8::gemm_phase<Epi, pg8::SplitOrder, true, true>(F.lds, g, S, E);
}

constexpr int NPHASE = 24;
struct Args { const float* in[28]; float* out; unsigned char* ws; int ph_lo, ph_hi, li, pad; };
__global__ void __launch_bounds__(NTHR, 2) fwd(Args args) {
    extern __shared__ __attribute__((aligned(16))) unsigned char lds[];
    Frame F;
    F.lds = (LAS unsigned char*)lds; F.MISC = (volatile LAS unsigned*)(F.lds + MISC_OFF);
    F.tid = threadIdx.x; F.lane = F.tid & 63; F.wave = __builtin_amdgcn_readfirstlane(F.tid >> 6);
    F.G = gridDim.x; F.gw = blockIdx.x * NWAVES + F.wave; F.NGW = F.G * NWAVES;
    F.ws = args.ws; F.ctl = (gu32*)(args.ws + WS_CTL); F.out = args.out;
#pragma unroll
    for (int i = 0; i < 28; ++i) F.in[i] = args.in[i];
    for (int u = F.tid; u < (LDS_BYTES - MISC_OFF) / 4; u += NTHR) ((LAS unsigned*)(F.lds + MISC_OFF))[u] = 0u;
    __syncthreads();
    XcdBarrier bar = xcd_barrier_post((unsigned*)(F.ctl + CW_BAR) + args.li * XCD_BAR_WORDS, F.MISC + 8);
    const int lo = args.ph_lo, hi = args.ph_hi;
#define IN(k) (lo <= (k) && (k) < hi && (frame_refresh(F), true))
#define SEAM(k) do { if (IN(k) && IN((k) + 1)) xcd_barrier(bar); } while (0)
#ifndef DUPK
#define DUPK (-1)
#endif
#define PHB(k, ...) if (IN(k)) { __VA_ARGS__; if ((k) == DUPK) { xcd_barrier(bar); __VA_ARGS__; } } SEAM(k);
    bf16* const Hb = (bf16*)(F.ws + WS_H); bf16* const Pb = (bf16*)(F.ws + WS_P); bf16* const ACTb = (bf16*)(F.ws + WS_ACT);
    float* const YF = (float*)(F.ws + WS_YF); bf16* const YB = (bf16*)(F.ws + WS_YF); float* const YP = (float*)(F.ws + WS_YPART); float* const X1 = (float*)(F.ws + WS_X1); float* const X2 = (float*)(F.ws + WS_X2);

    PHB(0, { p0_prologue(F); })
    PHB(1, { p_modulate0(F); })
    PHB(2, { pg8::EpiRope E{Pb, EV_INP, (const float*)(F.ws + WS_COS), (const float*)(F.ws + WS_SIN), 4, ML}; run_gemm(F, Hb, (const bf16*)(F.ws + WS_W_IN0), MT, EV_INP, DM, E); })
    PHB(3, { p_post0(F); })
    PHB(4, { p_scan_pass1<0>(F); p_attn0(F); })
    PHB(5, { p_scan_pass2<0>(F); })
    PHB(6, { p_merge0(F); })
    PHB(7, { { pg8::EpiBf16<0> E{YB, DM, nullptr, 0, 0, 1.f}; run_gemm(F, Hb, (const bf16*)(F.ws + WS_W_OUT0), ML, DM, DM, E); }
             { pg8::EpiF32 E{YP, DM, nullptr}; run_gemm_split(F, Hb + (size_t)ML * DM, (const bf16*)(F.ws + WS_W_OUT0), MC / 256, DM, DM, 4, 256, E); } })
    PHB(8, { p_ln<true, true, false>(F, MT, nullptr, YB, 0, 2, 0, X1, 0, 4, 3, YP, 4); })
    PHB(9, { pg8::EpiSwiGLU E{ACTb, DFF}; run_gemm(F, Hb, (const bf16*)(F.ws + WS_W_FF1), MT, 2 * DFF, DM, E); })
    PHB(10, { { pg8::EpiBf16<0> E{YB, DM, nullptr, 0, 0, 1.f}; run_gemm(F, ACTb, (const bf16*)(F.ws + WS_W_FF2), ML, DM, DFF, E); }
              { pg8::EpiF32 E{YP, DM, nullptr}; run_gemm_split(F, ACTb + (size_t)ML * DFF, (const bf16*)(F.ws + WS_W_FF2), MC / 256, DM, DFF, 7, 512, E); } })
    PHB(11, { p_ln<false, true, false>(F, MT, X1, YB, 0, 5, 1, X2, 1, 1, 0, YP, 7); })
    PHB(12, { pg8::EpiBf16<0> E{Pb, OD_INP, nullptr, 0, 0, 1.f}; run_gemm(F, Hb, (const bf16*)(F.ws + WS_W_IN1), MT, OD_INP, DM, E); })
    PHB(13, { p_post1(F); })
    PHB(14, { { pg8::EpiBf16<0> E{(bf16*)(F.ws + WS_Q), 768, nullptr, 0, 0, 1.f}; run_gemm(F, (const bf16*)(F.ws + WS_NQ), (const bf16*)(F.ws + WS_W_UQ), ML, 768, 256, E); }
              { pg8::EpiBf16<0> E{(bf16*)(F.ws + WS_KV), 1024, nullptr, 0, 0, 1.f}; run_gemm(F, (const bf16*)(F.ws + WS_NKV), (const bf16*)(F.ws + WS_W_UKV), MT, 1024, 256, E); } })
    PHB(15, { p_scan_pass1<1>(F); p_attn1(F); })
    PHB(16, { p_scan_pass2<1>(F); })
    PHB(17, { p_merge1(F); })
    PHB(18, { pg8::EpiBf16<0> E{YB, DM, nullptr, 0, 0, 1.f}; run_gemm(F, Hb, (const bf16*)(F.ws + WS_W_OUT1), ML, DM, DM, E); })
    PHB(19, { p_ln1_router(F); })
    PHB(20, { p_moe_dispatch(F); })
    PHB(21, { pg8::EpiSwiGLU E{(bf16*)(F.ws + WS_ACT2), DFF}; run_gemm_moe(F, (const bf16*)(F.ws + WS_HG), (const bf16*)(F.ws + WS_EXP_W1), 2 * DFF, DM, (size_t)2 * DFF * DM * 2, 1, E); })
    PHB(22, { pg8::EpiBf16<0> E{(bf16*)(F.ws + WS_F2), DM, nullptr, 0, 0, 1.f}; run_gemm_moe(F, (const bf16*)(F.ws + WS_ACT2), (const bf16*)(F.ws + WS_EXP_W2), DM, DFF, (size_t)DM * DFF * 2, 2, E); })
    PHB(23, { p_ln_final(F); })
#undef IN
#undef SEAM
#undef PHB
}

#ifndef MK_ONE_LAUNCH
#define MK_ONE_LAUNCH 1
#endif
extern "C" void kernel_launch(void* const* d_in, const int* in_sizes, int n_in, void* d_out, int out_size, void* d_ws, size_t ws_size, hipStream_t stream) {
    static int grid = 0;
    if (grid == 0) {
        if (n_in != 28 || in_sizes[0] != ML * DM || out_size != ML * DM || ws_size < WS_END) { fprintf(stderr, "kernel_launch: unexpected shapes (n_in %d, in0 %d, out %d, ws %zu)\n", n_in, n_in > 0 ? in_sizes[0] : -1, out_size, ws_size); grid = -1; return; }
        int dev = 0, cus = 0;
        if (hipGetDevice(&dev) != hipSuccess || hipDeviceGetAttribute(&cus, hipDeviceAttributeMultiprocessorCount, dev) != hipSuccess) { grid = -1; return; }
        if (hipFuncSetAttribute((const void*)fwd, hipFuncAttributeMaxDynamicSharedMemorySize, LDS_BYTES) != hipSuccess) { fprintf(stderr, "kernel_launch: hipFuncSetAttribute failed\n"); grid = -1; return; }
        int per_cu = 0;
        if (hipOccupancyMaxActiveBlocksPerMultiprocessor(&per_cu, (const void*)fwd, NTHR, LDS_BYTES) != hipSuccess || per_cu < 1) fprintf(stderr, "kernel_launch: occupancy query reports %d\n", per_cu);
        (void)hipGetLastError();
        grid = cus;
    }
    if (grid < 0) return;
    if (hipMemsetAsync((char*)d_ws + WS_CTL, 0, CTL_ZERO_BYTES, stream) != hipSuccess) return;
    Args a{};
    for (int i = 0; i < 28; ++i) a.in[i] = (const float*)d_in[i];
    a.out = (float*)d_out; a.ws = (unsigned char*)d_ws; a.pad = 0;
#if MK_ONE_LAUNCH
    a.ph_lo = 0; a.ph_hi = NPHASE; a.li = 0;
    hipLaunchKernelGGL(fwd, dim3(grid), dim3(NTHR), LDS_BYTES, stream, a);
#else
    for (int p = 0; p < NPHASE; ++p) { a.ph_lo = p; a.ph_hi = p + 1; a.li = p; hipLaunchKernelGGL(fwd, dim3(grid), dim3(NTHR), LDS_BYTES, stream, a); }
#endif
    const hipError_t le = hipPeekAtLastError();
    if (le != hipSuccess) fprintf(stderr, "kernel_launch: launch failed: %s\n", hipGetErrorName(le));
}
```

```cpp
#include <hip/hip_runtime.h>
#include <cstdio>
#include <cstdint>
#define DUPK -1
namespace pg8 {
#define PG8_LAS __attribute__((address_space(3)))
typedef unsigned short bf16_t;
typedef short bf16x8 __attribute__((ext_vector_type(8)));
typedef float f32x4 __attribute__((ext_vector_type(4)));
typedef unsigned u32x4 __attribute__((ext_vector_type(4)));
constexpr int BM = 256, BK = 64, HALF = 128, HTB = HALF * BK * 2  , STAGE_BYTES = 8 * HTB, NXCD = 8, WGM = 4;

__host__ __device__ __forceinline__ int lds_byte(int r, int c) { const int st = (r >> 4) * 2 + (c >> 5), rr = r & 15, cc = c & 31, ob = rr * 64 + cc * 2; return st * 1024 + (ob ^ (((ob >> 9) & 1) << 5)); }
__host__ __device__ __forceinline__ void stage_rc(int b, int& R, int& C) { const int st = b / 1024, sb = b % 1024, swz = sb ^ (((sb >> 9) & 1) << 5); R = (st >> 1) * 16 + swz / 64; C = (st & 1) * 32 + (swz % 64) / 2; }
__host__ __device__ __forceinline__ int perm32(int rho) { const int n = rho >> 4, i = rho & 15; return 8 * (i >> 2) + 4 * n + (i & 3); }

struct Unit { int pm, pn; };
struct Gemm { const bf16_t* A; const bf16_t* Bt; int M, N, K; int kt; };

struct StaticOrder {
    int nM, nN, nwg, G, c;
    __host__ __device__ void init(int M, int N, int G_, int c_) { nM = M / BM; nN = N / BM; nwg = nM * nN; G = G_; c = c_; }
    __host__ __device__ bool next(int i, Unit& u) const {
        const long L = (long)i * G + c; if (L >= nwg) return false;
        int wgid = (int)L; { const int q = nwg / NXCD, r = nwg % NXCD, xcd = wgid % NXCD, off = wgid / NXCD; wgid = (xcd < r ? xcd * (q + 1) : r * (q + 1) + (xcd - r) * q) + off; }
        const int nig = WGM * nN, gid = wgid / nig, fm = gid * WGM, gsz = (nM - fm) < WGM ? (nM - fm) : WGM;
        u.pm = fm + ((wgid % nig) % gsz); u.pn = (wgid % nig) / gsz; return true;
    }
    __device__ __forceinline__ void a_ready(const Unit&) const {}
    __device__ __forceinline__ void done(const Unit&) const {}
    __device__ __forceinline__ const char* bptr(const char* Bt, const Unit& u, size_t tstep) const { return Bt + (size_t)u.pn * tstep; }
    __device__ __forceinline__ const char* aptr(const char* A, const Unit& u, size_t tstep) const { return A + (size_t)u.pm * tstep; }
};
struct SplitOrder : StaticOrder {
    int mt; size_t kbytes;
    __device__ __forceinline__ const char* aptr(const char* A, const Unit& u, size_t tstep) const { return A + (size_t)(u.pm % mt) * tstep + (size_t)(u.pm / mt) * kbytes; }
    __device__ __forceinline__ const char* bptr(const char* Bt, const Unit& u, size_t tstep) const { return Bt + (size_t)u.pn * tstep + (size_t)(u.pm / mt) * kbytes; }
};
struct GroupedOrder : StaticOrder {
    int t1, t2, t3, t4, t5, t6, t7; size_t estride;
    int mt; size_t kbytes;
    __device__ __forceinline__ const char* aptr(const char* A, const Unit& u, size_t tstep) const { return mt ? A + (size_t)(u.pm % mt) * tstep + (size_t)(u.pm / mt) * kbytes : A + (size_t)u.pm * tstep; }
    __device__ __forceinline__ const char* bptr(const char* Bt, const Unit& u, size_t tstep) const {
        const int pm = mt ? u.pm % mt : u.pm; const size_t ko = mt ? (size_t)(u.pm / mt) * kbytes : 0;
        const int e = (pm >= t1) + (pm >= t2) + (pm >= t3) + (pm >= t4) + (pm >= t5) + (pm >= t6) + (pm >= t7);
        return Bt + (size_t)e * estride + (size_t)u.pn * tstep + ko; }
};


__device__ __forceinline__ unsigned cvt_pk_bf16(float lo, float hi) { unsigned r; asm volatile("v_cvt_pk_bf16_f32 %0, %1, %2" : "=v"(r) : "v"(lo), "v"(hi)); return r; }
typedef float f32x2 __attribute__((ext_vector_type(2)));
__device__ __forceinline__ f32x2 gelu_pk(f32x2 v) {
    const f32x2 av = __builtin_elementwise_abs(v), d = av * 0.2316418882f + 1.0f;
    f32x2 t; t.x = __builtin_amdgcn_rcpf(d.x); t.y = __builtin_amdgcn_rcpf(d.y);
    f32x2 q = t * 0.5307027145f + (-0.7265760135f); q = q * t + 0.7107068705f; q = q * t + (-0.142248368f); q = q * t + 0.127414796f; q = q * t;
    const f32x2 s = (v * v) * (-0.72134752044f);
    f32x2 e; e.x = __builtin_amdgcn_exp2f(s.x); e.y = __builtin_amdgcn_exp2f(s.y);
    const f32x2 m = v * (q * e), r = v - m;
    f32x2 o; o.x = v.x < 0.f ? m.x : r.x; o.y = v.y < 0.f ? m.y : r.y; return o;
}

template <int ACT  > struct EpiBf16 {
    static constexpr bool PERM = true, AFTER_DRAIN = false; static_assert(ACT == 0 || ACT == 1, "EpiBf16: ACT is 0 (none) or 1 (gelu_pk)");
    bf16_t* O; int ldc; const float* bias; int split_cols; size_t split_stride; float scale0;
    __device__ __forceinline__ void operator()(const f32x4 (&acc)[2][2][4][2], const Unit& u, int wr, int wc, int fr, int fq) const {
        const int row0 = u.pm * BM + wr * 64 + fr; int colt = u.pn * BM; bf16_t* base = O;
        float sc = 1.f; if (split_cols) { const int t = colt / split_cols; base += (size_t)t * split_stride; colt -= t * split_cols; if (t == 0) sc = scale0; }
        const int col0 = colt + wc * 32 + 8 * fq, bcol0 = u.pn * BM + wc * 32 + 8 * fq;
        f32x4 bv[2][2];
#pragma unroll
        for (int bj = 0; bj < 2; ++bj)
#pragma unroll
            for (int n = 0; n < 2; ++n) bv[bj][n] = bias ? *(const f32x4*)(bias + bcol0 + bj * HALF + 4 * n) : (f32x4){0.f, 0.f, 0.f, 0.f};
#pragma unroll
        for (int ai = 0; ai < 2; ++ai)
#pragma unroll
            for (int m = 0; m < 4; ++m) { bf16_t* rowp = base + (size_t)(row0 + ai * HALF + m * 16) * ldc + col0;
#pragma unroll
                for (int bj = 0; bj < 2; ++bj) { f32x4 v0 = acc[ai][bj][m][0] + bv[bj][0], v1 = acc[ai][bj][m][1] + bv[bj][1];
                    if (ACT == 1) { f32x2 a = gelu_pk((f32x2){v0[0], v0[1]}), b = gelu_pk((f32x2){v0[2], v0[3]}), c = gelu_pk((f32x2){v1[0], v1[1]}), d = gelu_pk((f32x2){v1[2], v1[3]});
                        v0 = (f32x4){a.x, a.y, b.x, b.y}; v1 = (f32x4){c.x, c.y, d.x, d.y}; }
                    v0 = v0 * sc; v1 = v1 * sc; u32x4 w; w.x = cvt_pk_bf16(v0[0], v0[1]); w.y = cvt_pk_bf16(v0[2], v0[3]); w.z = cvt_pk_bf16(v1[0], v1[1]); w.w = cvt_pk_bf16(v1[2], v1[3]);
                    *(u32x4*)(rowp + bj * HALF) = w; } }
    }
};
struct EpiF32 {
    static constexpr bool PERM = false, AFTER_DRAIN = false;
    float* C; int ldc; const float* bias;
    __device__ __forceinline__ void operator()(const f32x4 (&acc)[2][2][4][2], const Unit& u, int wr, int wc, int fr, int fq) const {
        const int row0 = u.pm * BM + wr * 64 + fr, col0 = u.pn * BM + wc * 32 + 4 * fq;
        f32x4 bv[2][2];
#pragma unroll
        for (int bj = 0; bj < 2; ++bj)
#pragma unroll
            for (int n = 0; n < 2; ++n) bv[bj][n] = bias ? *(const f32x4*)(bias + col0 + bj * HALF + n * 16) : (f32x4){0.f, 0.f, 0.f, 0.f};
#pragma unroll
        for (int ai = 0; ai < 2; ++ai)
#pragma unroll
            for (int m = 0; m < 4; ++m) { float* rowp = C + (size_t)(row0 + ai * HALF + m * 16) * ldc + col0;
#pragma unroll
                for (int bj = 0; bj < 2; ++bj)
#pragma unroll
                    for (int n = 0; n < 2; ++n) *(f32x4*)(rowp + bj * HALF + n * 16) = acc[ai][bj][m][n] + bv[bj][n]; }
    }
};
struct EpiSwiGLU {
    static constexpr bool PERM = true, AFTER_DRAIN = false;
    bf16_t* O; int ldc;
    __device__ __forceinline__ void operator()(const f32x4 (&acc)[2][2][4][2], const Unit& u, int wr, int wc, int fr, int fq) const {
        const int row0 = u.pm * BM + wr * 64 + fr, col0 = u.pn * HALF + wc * 32 + 8 * fq;
#pragma unroll
        for (int ai = 0; ai < 2; ++ai)
#pragma unroll
            for (int m = 0; m < 4; ++m) { bf16_t* rowp = O + (size_t)(row0 + ai * HALF + m * 16) * ldc + col0;
                f32x4 v0, v1;
#pragma unroll
                for (int i = 0; i < 4; ++i) { const float g0 = acc[ai][0][m][0][i], g1 = acc[ai][0][m][1][i];
                    v0[i] = g0 * __builtin_amdgcn_rcpf(1.0f + __builtin_amdgcn_exp2f(-1.4426950408889634f * g0)) * acc[ai][1][m][0][i]; v1[i] = g1 * __builtin_amdgcn_rcpf(1.0f + __builtin_amdgcn_exp2f(-1.4426950408889634f * g1)) * acc[ai][1][m][1][i]; }
                u32x4 w; w.x = cvt_pk_bf16(v0[0], v0[1]); w.y = cvt_pk_bf16(v0[2], v0[3]); w.z = cvt_pk_bf16(v1[0], v1[1]); w.w = cvt_pk_bf16(v1[2], v1[3]);
                *(u32x4*)rowp = w; }
    }
};

struct EpiRope {
    static constexpr bool PERM = true, AFTER_DRAIN = false;
    bf16_t* O; int ldc; const float* cs; const float* sn; int rope_tiles, rope_rows;
    __device__ __forceinline__ void operator()(const f32x4 (&acc)[2][2][4][2], const Unit& u, int wr, int wc, int fr, int fq) const {
        const int row0 = u.pm * BM + wr * 64 + fr, col0 = u.pn * BM + wc * 32 + 8 * fq;
        const bool rot = u.pn < rope_tiles && u.pm * BM < rope_rows;
        const int i0 = 16 * (wc & 1) + 4 * fq;
#pragma unroll
        for (int ai = 0; ai < 2; ++ai)
#pragma unroll
            for (int m = 0; m < 4; ++m) { const int row = row0 + ai * HALF + m * 16; bf16_t* rowp = O + (size_t)row * ldc + col0;
                f32x4 c4 = {1.f, 1.f, 1.f, 1.f}, s4 = {0.f, 0.f, 0.f, 0.f};
                if (rot) { const int t = row & 2047; c4 = *(const f32x4*)(cs + t * 32 + i0); s4 = *(const f32x4*)(sn + t * 32 + i0); }
#pragma unroll
                for (int bj = 0; bj < 2; ++bj) { const f32x4 v0 = acc[ai][bj][m][0], v1 = acc[ai][bj][m][1];
                    u32x4 w; w.x = cvt_pk_bf16(v0[0] * c4[0] - v0[1] * s4[0], v0[0] * s4[0] + v0[1] * c4[0]); w.y = cvt_pk_bf16(v0[2] * c4[1] - v0[3] * s4[1], v0[2] * s4[1] + v0[3] * c4[1]);
                    w.z = cvt_pk_bf16(v1[0] * c4[2] - v1[1] * s4[2], v1[0] * s4[2] + v1[1] * c4[2]); w.w = cvt_pk_bf16(v1[2] * c4[3] - v1[3] * s4[3], v1[2] * s4[3] + v1[3] * c4[3]);
                    *(u32x4*)(rowp + bj * HALF) = w; } }
    }
};
template <class Epi, class Sched, bool ALIGN_EPI = false, bool SP2 = false>
__device__ __forceinline__ void gemm_phase(PG8_LAS unsigned char* lds, const Gemm g, const Sched& S, const Epi& E) {
    int tid_ = threadIdx.x; asm volatile("" : "+v"(tid_));
    const int tid = tid_, wid = __builtin_amdgcn_readfirstlane(tid >> 6), lane = tid & 63, wr = wid >> 2, wc = wid & 3, fr = lane & 15, fq = lane >> 4;
    const int K = g.K, nt = g.kt ? g.kt : K / BK;
    unsigned voffA[2], voffB[2];
#pragma unroll
    for (int i = 0; i < 2; ++i) { int R, C; stage_rc(tid * 16 + i * 8192, R, C); const int Rb = Epi::PERM ? ((R & ~31) + perm32(R & 31)) : R;
        voffA[i] = (unsigned)(R * K + C) * 2u; voffB[i] = (unsigned)(Rb * K + C) * 2u; }
    const size_t kstep = (size_t)(BK * 2);
    const size_t hstep = (size_t)HALF * K * 2;
    const size_t tstep = 2 * hstep;
    const unsigned ldsw = (unsigned)wid * 1024u;
    const int aoff = lds_byte(wr * 64 + fr, fq * 8), boff = lds_byte(wc * 32 + fr, fq * 8);
#define PG8_SA(b, h) (((b) * 2 + (h)) * HTB)
#define PG8_SB(b, h) ((4 + (b) * 2 + (h)) * HTB)
#define PG8_STAGE(bufoff, gbase, voff) do { _Pragma("unroll") for (int _i = 0; _i < 2; ++_i) \
        __builtin_amdgcn_global_load_lds((const unsigned*)((const char*)(gbase) + (voff)[_i]), (PG8_LAS unsigned*)(lds + (bufoff) + ldsw + _i * 8192), 16, 0, 0); } while (0)
#define PG8_LDA(dst, b, h) do { _Pragma("unroll") for (int m = 0; m < 4; ++m) _Pragma("unroll") for (int k = 0; k < 2; ++k) dst[m][k] = *(const PG8_LAS bf16x8*)(lds + PG8_SA(b, h) + aoff + m * 2048 + k * 1024); } while (0)
#define PG8_LDB(dst, b, h) do { _Pragma("unroll") for (int n = 0; n < 2; ++n) _Pragma("unroll") for (int k = 0; k < 2; ++k) dst[n][k] = *(const PG8_LAS bf16x8*)(lds + PG8_SB(b, h) + boff + n * 2048 + k * 1024); } while (0)
#define PG8_MMA(ai, bj, At, Bt) do { __builtin_amdgcn_s_setprio(1); _Pragma("unroll") for (int m = 0; m < 4; ++m) _Pragma("unroll") for (int n = 0; n < 2; ++n) _Pragma("unroll") for (int k = 0; k < 2; ++k) \
        acc[ai][bj][m][n] = __builtin_amdgcn_mfma_f32_16x16x32_bf16(Bt[n][k], At[m][k], acc[ai][bj][m][n], 0, 0, 0); __builtin_amdgcn_s_setprio(0); } while (0)
#define PG8_WAIT_V(n) asm volatile("s_waitcnt vmcnt(" #n ")" ::: "memory")
#define PG8_WAIT_L(n) asm volatile("s_waitcnt lgkmcnt(" #n ")" ::: "memory")
#define PG8_BAR __builtin_amdgcn_s_barrier()
#define PG8_SCHED __builtin_amdgcn_sched_barrier(0)
    Unit cur, nxt; int ui = 0;
    if (!S.next(0, cur)) return;
    f32x4 acc[2][2][4][2];
#pragma unroll
    for (int a = 0; a < 2; ++a)
#pragma unroll
        for (int b = 0; b < 2; ++b)
#pragma unroll
            for (int m = 0; m < 4; ++m)
#pragma unroll
                for (int n = 0; n < 2; ++n) acc[a][b][m][n] = (f32x4){0.f, 0.f, 0.f, 0.f};
    bf16x8 At[4][2], B0[2][2], B1[2][2];
    const char* cA = S.aptr((const char*)g.A, cur, tstep); const char* cB = S.bptr((const char*)g.Bt, cur, tstep);
    S.a_ready(cur);
    if constexpr (SP2) {
        PG8_STAGE(PG8_SB(0, 0), cB, voffB); PG8_STAGE(PG8_SB(0, 1), cB + hstep, voffB); PG8_STAGE(PG8_SA(0, 0), cA, voffA); PG8_STAGE(PG8_SA(0, 1), cA + hstep, voffA);
        if (wr == 1) PG8_BAR;
        PG8_WAIT_V(2); PG8_BAR;
        PG8_STAGE(PG8_SB(1, 0), cB + kstep, voffB); PG8_STAGE(PG8_SA(1, 0), cA + kstep, voffA); PG8_STAGE(PG8_SB(1, 1), cB + hstep + kstep, voffB);
        PG8_WAIT_V(6); PG8_BAR;
    } else {
        PG8_STAGE(PG8_SB(0, 0), cB, voffB); PG8_STAGE(PG8_SA(0, 0), cA, voffA); PG8_STAGE(PG8_SB(0, 1), cB + hstep, voffB); PG8_STAGE(PG8_SA(0, 1), cA + hstep, voffA);
        if (wr == 1) PG8_BAR;
        PG8_WAIT_V(4); PG8_BAR;
        PG8_STAGE(PG8_SB(1, 0), cB + kstep, voffB); PG8_STAGE(PG8_SA(1, 0), cA + kstep, voffA); PG8_STAGE(PG8_SB(1, 1), cB + hstep + kstep, voffB);
        PG8_WAIT_V(6); PG8_BAR;
    }
    for (;;) {
        const bool has_next = S.next(ui + 1, nxt);
        const char* nA = has_next ? S.aptr((const char*)g.A, nxt, tstep) : cA; const char* nB = has_next ? S.bptr((const char*)g.Bt, nxt, tstep) : cB;
        for (int t = 0; t < nt; t += 2) {
            const bool last = (t == nt - 2);
            const char* a1 = cA + (size_t)(t + 1) * kstep;
            const char* a2 = last ? nA : cA + (size_t)(t + 2) * kstep; const char* b2 = last ? nB : cB + (size_t)(t + 2) * kstep;
            const char* a3 = a2 + kstep; const char* b3 = b2 + kstep;
            if (last && has_next) S.a_ready(nxt);
            if constexpr (SP2) {
            PG8_LDB(B0, 0, 0); PG8_LDB(B1, 0, 1); PG8_SCHED; PG8_LDA(At, 0, 0); PG8_STAGE(PG8_SA(1, 1), a1 + hstep, voffA);
            PG8_WAIT_V(8); PG8_WAIT_L(0); PG8_BAR; PG8_MMA(0, 0, At, B0); PG8_MMA(0, 1, At, B1); PG8_BAR; PG8_SCHED;
            PG8_LDA(At, 0, 1); PG8_STAGE(PG8_SB(0, 0), b2, voffB); PG8_STAGE(PG8_SB(0, 1), b2 + hstep, voffB); PG8_STAGE(PG8_SA(0, 0), a2, voffA);
            PG8_WAIT_V(8); PG8_WAIT_L(0); PG8_BAR; PG8_MMA(1, 0, At, B0); PG8_MMA(1, 1, At, B1); PG8_BAR; PG8_SCHED;
            PG8_LDB(B0, 1, 0); PG8_LDB(B1, 1, 1); PG8_SCHED; PG8_LDA(At, 1, 0); PG8_STAGE(PG8_SA(0, 1), a2 + hstep, voffA);
            PG8_WAIT_V(8); PG8_WAIT_L(0); PG8_BAR; PG8_MMA(0, 0, At, B0); PG8_MMA(0, 1, At, B1); PG8_BAR; PG8_SCHED;
            PG8_LDA(At, 1, 1); PG8_STAGE(PG8_SB(1, 0), b3, voffB); PG8_STAGE(PG8_SB(1, 1), b3 + hstep, voffB); PG8_STAGE(PG8_SA(1, 0), a3, voffA);
            PG8_WAIT_V(8); PG8_WAIT_L(0); PG8_BAR; PG8_MMA(1, 0, At, B0); PG8_MMA(1, 1, At, B1); PG8_BAR; PG8_SCHED;
            } else {
            PG8_LDB(B0, 0, 0); PG8_SCHED; PG8_LDA(At, 0, 0); PG8_STAGE(PG8_SA(1, 1), a1 + hstep, voffA);
            PG8_WAIT_L(8); PG8_BAR; PG8_WAIT_L(0); PG8_MMA(0, 0, At, B0); PG8_BAR; PG8_SCHED;
            PG8_LDB(B1, 0, 1); PG8_STAGE(PG8_SB(0, 0), b2, voffB);
            PG8_BAR; PG8_WAIT_L(0); PG8_MMA(0, 1, At, B1); PG8_BAR;
            PG8_LDA(At, 0, 1); PG8_STAGE(PG8_SA(0, 0), a2, voffA);
            PG8_BAR; PG8_WAIT_L(0); PG8_MMA(1, 0, At, B0); PG8_BAR; PG8_SCHED;
            PG8_STAGE(PG8_SB(0, 1), b2 + hstep, voffB);
            PG8_WAIT_V(6); PG8_BAR; PG8_MMA(1, 1, At, B1); PG8_BAR;
            PG8_LDB(B0, 1, 0); PG8_SCHED; PG8_LDA(At, 1, 0); PG8_STAGE(PG8_SA(0, 1), a2 + hstep, voffA);
            PG8_WAIT_L(8); PG8_BAR; PG8_WAIT_L(0); PG8_MMA(0, 0, At, B0); PG8_BAR; PG8_SCHED;
            PG8_LDB(B1, 1, 1); PG8_STAGE(PG8_SB(1, 0), b3, voffB);
            PG8_BAR; PG8_WAIT_L(0); PG8_MMA(0, 1, At, B1); PG8_BAR;
            PG8_LDA(At, 1, 1); PG8_STAGE(PG8_SA(1, 0), a3, voffA);
            PG8_BAR; PG8_WAIT_L(0); PG8_MMA(1, 0, At, B0); PG8_BAR; PG8_SCHED;
            PG8_STAGE(PG8_SB(1, 1), b3 + hstep, voffB);
            PG8_WAIT_V(6); PG8_BAR; PG8_MMA(1, 1, At, B1); PG8_BAR;
            }
        }
        if constexpr (ALIGN_EPI) { if (wr == 0) PG8_BAR; }
        if constexpr (!Epi::AFTER_DRAIN) { E(acc, cur, wr, wc, fr, fq); S.done(cur); }
        if (!has_next) break;
#pragma unroll
        for (int a = 0; a < 2; ++a)
#pragma unroll
            for (int b = 0; b < 2; ++b)
#pragma unroll
                for (int m = 0; m < 4; ++m)
#pragma unroll
                    for (int n = 0; n < 2; ++n) acc[a][b][m][n] = (f32x4){0.f, 0.f, 0.f, 0.f};
        cur = nxt; cA = nA; cB = nB; ++ui;
        if constexpr (ALIGN_EPI) { if (wr == 1) PG8_BAR; }
    }
    PG8_WAIT_V(0);
    if constexpr (!ALIGN_EPI) { if (wr == 0) PG8_BAR; }
    PG8_BAR;
    if constexpr (Epi::AFTER_DRAIN) { E.fused(acc, cur, wr, wc, fr, fq, lds, wid, lane); S.done(cur); }
#undef PG8_SA
#undef PG8_SB
#undef PG8_STAGE
#undef PG8_LDA
#undef PG8_LDB
#undef PG8_MMA
#undef PG8_WAIT_V
#undef PG8_WAIT_L
#undef PG8_BAR
#undef PG8_SCHED
}
}
#define GAS __attribute__((address_space(1)))
#define LAS __attribute__((address_space(3)))
typedef unsigned short bf16;
typedef unsigned v4u __attribute__((ext_vector_type(4)));
typedef float f32x4 __attribute__((ext_vector_type(4)));
typedef short bf16x8 __attribute__((ext_vector_type(8)));
typedef GAS unsigned gu32;
typedef GAS unsigned long long gu64;
#define RLX_AGENT __ATOMIC_RELAXED, __HIP_MEMORY_SCOPE_AGENT
#define LDS_WAIT() asm volatile("s_waitcnt lgkmcnt(0)" ::: "memory")
#define VM_WAIT() asm volatile("s_waitcnt vmcnt(0)" ::: "memory")
__device__ __forceinline__ unsigned long long rt() { return __builtin_amdgcn_s_memrealtime(); }
__device__ __forceinline__ unsigned f2bf(float f) { unsigned u = __builtin_bit_cast(unsigned, f); return (u + 0x7fffu + ((u >> 16) & 1u)) >> 16; }
__device__ __forceinline__ unsigned pk2(float lo, float hi) { return f2bf(lo) | (f2bf(hi) << 16); }

#define XB_TMO      128
#define XB_XCNT(j)  (256  + 64 * (j))
#define XB_XSUB(j)  (1280 + 64 * (j))
#define XB_XGEN(j)  (2304 + 64 * (j))
#define XB_TOP      3328
#define XB_TOPGEN   3392
#define XCD_BAR_WORDS 3456
#define XB_SPIN_CAP (1u << 22)

__device__ __forceinline__ unsigned xb_ld(unsigned* p)              { return __hip_atomic_load(p, __ATOMIC_RELAXED, __HIP_MEMORY_SCOPE_AGENT); }
__device__ __forceinline__ unsigned xb_add(unsigned* p, unsigned v) { return __hip_atomic_fetch_add(p, v, __ATOMIC_RELAXED, __HIP_MEMORY_SCOPE_AGENT); }
__device__ __forceinline__ unsigned xb_xcc_id() { return (unsigned)__builtin_amdgcn_s_getreg((3 << 11) | 20) & 0xFu; }
#define XB_SPIN(cond, bar) do { unsigned _sp = 0; while (cond) { __builtin_amdgcn_s_sleep(1); \
    if ((++_sp & 255u) == 0u) { if (xb_ld(&(bar)[XB_TMO])) break; if (_sp > XB_SPIN_CAP) { atomicAdd(&(bar)[XB_TMO], 1u); break; } } } } while (0)

struct XcdBarrier {
    unsigned* bar; unsigned x;
    volatile LAS unsigned* st;
};

__device__ __forceinline__ XcdBarrier xcd_barrier_post(unsigned* bar, volatile LAS unsigned* st) {
    XcdBarrier b; b.bar = bar; b.x = xb_xcc_id(); b.st = st;
    if (threadIdx.x == 0) (void)xb_add(&bar[XB_XCNT(b.x)], 1u);
    return b;
}
__device__ __forceinline__ void xcd_barrier_complete(unsigned* bar, unsigned x, unsigned& nloc, unsigned& nx) {
    const unsigned G = gridDim.x * gridDim.y * gridDim.z;
    unsigned sum, cnt, mine, sp = 0u;
    for (;;) {
        sum = 0u; cnt = 0u; mine = 0u;
#pragma unroll
        for (unsigned j = 0; j < 16; ++j) { const unsigned c = xb_ld(&bar[XB_XCNT(j)]); sum += c; cnt += (c > 0u) ? 1u : 0u; mine = (j == x) ? c : mine; }
        if (sum == G) break;
        __builtin_amdgcn_s_sleep(1);
        if ((++sp & 255u) == 0u) { if (xb_ld(&bar[XB_TMO])) break; if (sp > XB_SPIN_CAP) { atomicAdd(&bar[XB_TMO], 1u); break; } }
    }
    nloc = mine > 0u ? mine : 1u; nx = cnt > 0u ? cnt : 1u;
}

__device__ __forceinline__ void xcd_barrier(const XcdBarrier& b) {
    asm volatile("s_waitcnt vmcnt(0)" ::: "memory");
    __syncthreads();
    if (threadIdx.x == 0) {
        unsigned* bar = b.bar;
        __builtin_amdgcn_s_waitcnt(0);
        unsigned nloc = b.st[0], nx = b.st[1];
        if (nloc == 0u) { xcd_barrier_complete(bar, b.x, nloc, nx); b.st[0] = nloc; b.st[1] = nx; }
        const unsigned old = xb_add(&bar[XB_XSUB(b.x)], 1u);
        const unsigned gen = old / nloc;
        if (old + 1u == (gen + 1u) * nloc) {
            __builtin_amdgcn_fence(__ATOMIC_RELEASE, "agent");
            asm volatile("s_waitcnt vmcnt(0)" ::: "memory");
            const unsigned og = xb_add(&bar[XB_TOP], 1u);
            const unsigned tg = og / nx;
            if (og + 1u == (tg + 1u) * nx) xb_add(&bar[XB_TOPGEN], 1u);
            else XB_SPIN(xb_ld(&bar[XB_TOPGEN]) == tg, bar);
            __builtin_amdgcn_fence(__ATOMIC_ACQUIRE, "agent");
            xb_add(&bar[XB_XGEN(b.x)], 1u);
            asm volatile("s_waitcnt vmcnt(0)" ::: "memory");
        } else {
            XB_SPIN(xb_ld(&bar[XB_XGEN(b.x)]) == gen, bar);
            __builtin_amdgcn_fence(__ATOMIC_ACQUIRE, "agent");
            asm volatile("s_waitcnt vmcnt(0)" ::: "memory");
        }
    }
    __syncthreads();
}

constexpr int NWAVES = 8, NTHR = 512;
constexpr int NB = 8, SEQ = 2048, DM = 1024, CTXL = 256;
constexpr int ML = NB * SEQ, MC = NB * CTXL, MT = ML + MC;
constexpr int EV_IN = 3104, EV_INP = 3328, OD_IN = 3008, OD_INP = 3072, DFF = 3584, NEXP = 8;
constexpr int EV_QA = 0, EV_KA = 512, EV_VA = 1024, EV_QB = 1536, EV_KB = 1792, EV_VB = 2048, EV_GB = 2560, EV_LRF = 3072, EV_LRB = 3088;
constexpr int OD_CQ = 0, OD_CKV = 256, OD_KR = 384, OD_HQ = 448, OD_HFF = 960, OD_HFB = 1472, OD_HI = 1984, OD_HG = 2496;
constexpr float LN_EPS = 1e-5f, RMS_EPS = 1e-6f, DN_ALPHA = 1.41421356237f, LAM_INIT0 = 0.2f;
constexpr float DA_SCALE = 0.125f, GLA_QSCALE = 0.125f, MLA_SCALE = 0.07216878364870322f;

constexpr size_t MiB = 1u << 20;
constexpr size_t WS_CTL = 0, CTL_ZERO_BYTES = 1 * MiB;
constexpr size_t WS_MOD = 1 * MiB;
constexpr size_t WS_COS = 2 * MiB, WS_SIN = 2 * MiB + 262144;
constexpr size_t WS_SCAL = 2 * MiB + 524288;
constexpr size_t WS_ROUTE = 3 * MiB;
constexpr size_t WS_W_IN0 = 8 * MiB, WS_W_OUT0 = 15 * MiB, WS_W_FF1 = 17 * MiB, WS_W_FF2 = 31 * MiB, WS_W_IN1 = 38 * MiB, WS_W_UQ = 44 * MiB, WS_W_UKV = 45 * MiB, WS_W_OUT1 = 46 * MiB;
constexpr size_t WS_EXP_W1 = 48 * MiB, WS_EXP_W2 = 160 * MiB;
constexpr size_t WS_H = 216 * MiB, WS_X1 = 252 * MiB, WS_X2 = 324 * MiB, WS_BIG = 396 * MiB, WS_ACT = 648 * MiB, WS_YF = 774 * MiB, WS_SPARE = 846 * MiB, WS_END = 864 * MiB;
constexpr size_t WS_P = WS_BIG, WS_U = WS_BIG;
constexpr size_t WS_GK = WS_ACT, WS_OA = WS_ACT + 36 * MiB, WS_OBF = WS_ACT + 72 * MiB, WS_OBB = WS_YF;
constexpr size_t WS_Q = WS_ACT, WS_KV = WS_ACT + 24 * MiB, WS_OM = WS_ACT + 60 * MiB, WS_OHF = WS_ACT + 92 * MiB, WS_OHB = WS_YF, WS_NQ = WS_SPARE, WS_NKV = WS_SPARE + 8 * MiB;
constexpr size_t WS_FSUM = WS_X2;
constexpr size_t WS_YPART = WS_BIG;
constexpr size_t WS_SCAN_E = WS_YF + 40 * MiB, WS_SCAN_D = WS_YF + 60 * MiB;
constexpr size_t WS_GH = WS_BIG + 112 * MiB;
constexpr size_t WS_POS = WS_ROUTE + 262144;
constexpr int MOE_MAXROWS = 2 * ML + NEXP * 256;
constexpr size_t WS_HG = WS_ACT;
constexpr size_t WS_ACT2 = WS_BIG;
constexpr size_t WS_F2 = WS_ACT;
static_assert(WS_ACT2 + (size_t)MOE_MAXROWS * DFF * 2 <= WS_ACT && WS_F2 + (size_t)MOE_MAXROWS * DM * 4 <= WS_SPARE, "moe ws map");
constexpr int CW_CNT = 1024;
static_assert(WS_OHF + 32 * MiB <= WS_YF && WS_NKV + 9 * MiB <= WS_END, "ws map");
constexpr int CW_BAR = 4096;
constexpr int MAX_LAUNCHES = 64;
static_assert((CW_BAR + MAX_LAUNCHES * XCD_BAR_WORDS) * 4 <= (int)CTL_ZERO_BYTES, "CTL words inside the memset region");

constexpr int SCR_BYTES = 151552;
constexpr int MISC_OFF = SCR_BYTES;
constexpr int LDS_BYTES = 155648;

struct Frame {
    LAS unsigned char* lds;
    volatile LAS unsigned* MISC;
    gu32* ctl;
    int tid, lane, wave, G, gw, NGW;
    unsigned char* ws;
    const float* in[28];
    float* out;
};
enum InIdx { I_X = 0, I_C, I_CTX, I_CCTX, I_ADAW, I_ADAB, I_LNG, I_LNB, I_LBT, I_EV_WIN, I_EV_LAM, I_EV_SUBLN, I_EV_GKW2, I_EV_GKB, I_EV_GLAG, I_EV_WOUT, I_EV_W1, I_EV_W2,
             I_OD_WIN, I_OD_QNG, I_OD_KVNG, I_OD_WUQ, I_OD_WUKV, I_OD_HGG, I_OD_WOUT, I_OD_ROUTER, I_OD_EW1, I_OD_EW2 };

__device__ __forceinline__ float bf2f(unsigned short b) { return __uint_as_float(((unsigned)b) << 16); }
__device__ __forceinline__ float bflo(unsigned w) { return __uint_as_float(w << 16); }
__device__ __forceinline__ float bfhi(unsigned w) { return __uint_as_float(w & 0xffff0000u); }
__device__ __forceinline__ float wave_sum(float v) {
#pragma unroll
    for (int o = 1; o < 64; o <<= 1) v += __shfl_xor(v, o);
    return v;
}
__device__ __forceinline__ float wave_max(float v) {
#pragma unroll
    for (int o = 1; o < 64; o <<= 1) v = fmaxf(v, __shfl_xor(v, o));
    return v;
}
__device__ __forceinline__ float sigmoidf_(float x) { return 1.0f / (1.0f + __expf(-x)); }
__device__ __forceinline__ float siluf_(float x) { return x / (1.0f + __expf(-x)); }
__device__ __forceinline__ float logsigmoidf_(float x) { return fminf(x, 0.0f) - log1pf(__expf(-fabsf(x))); }
__device__ __forceinline__ int mod_row(int m) { return m < ML ? (m >> 11) : NB; }
__device__ __forceinline__ void frame_refresh(Frame& F) {
    int t = threadIdx.x; asm volatile("" : "+v"(t));
    F.tid = t; F.lane = t & 63; F.wave = __builtin_amdgcn_readfirstlane(t >> 6); F.gw = blockIdx.x * NWAVES + F.wave;
}
__device__ __forceinline__ const float* src_row(const Frame& F, int m) { return m < ML ? F.in[I_X] + (size_t)m * DM : F.in[I_CTX] + (size_t)(m - ML) * DM; }

__device__ __forceinline__ void transpose_tile(const float* W, int N, bf16* WT, int ldt, LAS float* scr, int k0, int n0, int lane) {
    float tv[32];
#pragma unroll
    for (int i = 0; i < 32; ++i) { const int kk = 2 * i + (lane >> 5); tv[i] = W[(size_t)(k0 + kk) * N + n0 + (lane & 31)]; }
#pragma unroll
    for (int i = 0; i < 32; ++i) { const int kk = 2 * i + (lane >> 5); scr[kk * 33 + (lane & 31)] = tv[i]; }
    LDS_WAIT(); asm volatile("" ::: "memory");
    const int c = lane & 7;
#pragma unroll
    for (int j = 0; j < 4; ++j) { const int n = (lane >> 3) + 8 * j; const LAS float* s = scr + (8 * c) * 33 + n;
        v4u o; o.x = pk2(s[0 * 33], s[1 * 33]); o.y = pk2(s[2 * 33], s[3 * 33]); o.z = pk2(s[4 * 33], s[5 * 33]); o.w = pk2(s[6 * 33], s[7 * 33]);
        *(GAS v4u*)(WT + (size_t)(n0 + n) * ldt + k0 + 8 * c) = o; }
    LDS_WAIT(); asm volatile("" ::: "memory");
}
template <bool SWI>
__device__ __forceinline__ void transpose_weight(Frame& F, const float* W, int K, int N, bf16* WT, int ldt, LAS float* scr) {
    const int nblk = N / 32, items = (K / 64) * nblk;
    for (int it = F.gw; it < items; it += F.NGW) { const int n0 = 32 * (it % nblk);
        const int r0 = !SWI ? n0 : (n0 < DFF ? (n0 >> 7) * 256 + (n0 & 127) : ((n0 - DFF) >> 7) * 256 + 128 + ((n0 - DFF) & 127));
        transpose_tile(W + n0, N, WT + (size_t)r0 * ldt, ldt, scr, 64 * (it / nblk), 0, F.lane); }
}
__device__ __forceinline__ void zero_bytes16(Frame& F, unsigned char* p, size_t nbytes) {
    const v4u z = {0u, 0u, 0u, 0u};
    for (size_t i = (size_t)blockIdx.x * NTHR + F.tid; i < nbytes / 16; i += (size_t)F.G * NTHR) ((GAS v4u*)p)[i] = z;
}

__device__ __forceinline__ void p0_prologue(Frame& F) {
    {
        LAS float* sS = (LAS float*)F.lds;
        LAS float* part = (LAS float*)(F.lds + 40960);
        float* MOD = (float*)(F.ws + WS_MOD);
        if ((int)blockIdx.x < 192) {
            for (int i = F.tid; i < 9 * 1024; i += NTHR) { const int r = i >> 10, k = i & 1023; const float v = r < 8 ? F.in[I_C][r * 1024 + k] : F.in[I_CCTX][k]; sS[i] = siluf_(v); }
            __syncthreads();
            for (int it = blockIdx.x; it < 192; it += F.G) {
                const int l = it / 96, n0 = (it % 96) * 64;
                const float* Wp = F.in[I_ADAW] + ((size_t)l * 1024 + 128 * F.wave) * 6144 + n0 + F.lane;
                float acc[9];
#pragma unroll
                for (int r = 0; r < 9; ++r) acc[r] = 0.f;
                for (int kk = 0; kk < 128; kk += 32) {
                    float wv[32];
#pragma unroll
                    for (int j = 0; j < 32; ++j) wv[j] = Wp[(size_t)(kk + j) * 6144];
#pragma unroll
                    for (int j = 0; j < 32; ++j)
#pragma unroll
                        for (int r = 0; r < 9; ++r) acc[r] += sS[r * 1024 + 128 * F.wave + kk + j] * wv[j];
                }
#pragma unroll
                for (int r = 0; r < 9; ++r) part[(F.wave * 9 + r) * 64 + F.lane] = acc[r];
                __syncthreads();
                for (int i = F.tid; i < 576; i += NTHR) { const int r = i >> 6, c = i & 63; float s = 0.f;
#pragma unroll
                    for (int w = 0; w < 8; ++w) s += part[(w * 9 + r) * 64 + c];
                    MOD[((size_t)l * 9 + r) * 6144 + n0 + c] = s + F.in[I_ADAB][l * 6144 + n0 + c]; }
                __syncthreads();
            }
        }
        __syncthreads();
    }
    {
        float* COS = (float*)(F.ws + WS_COS); float* SIN = (float*)(F.ws + WS_SIN);
        for (int i = blockIdx.x * NTHR + F.tid; i < 2048 * 32; i += F.G * NTHR) {
            const int pos = i >> 5, pi = i & 31; const int j = pi & 15;
            const float inv = (float)pow(10000.0, -(double)j / 16.0);
            const float p = (float)(pi < 16 ? (pos >> 6) : (pos & 63));
            const float ang = p * inv;
            COS[i] = (float)cos((double)ang); SIN[i] = (float)sin((double)ang);
        }
        if (blockIdx.x == 0) {
            float* SC = (float*)(F.ws + WS_SCAL);
            if (F.wave == 0) { const float* lv = F.in[I_EV_LAM]; const float a = wave_sum(lv[F.lane] * lv[64 + F.lane]), b = wave_sum(lv[128 + F.lane] * lv[192 + F.lane]);
                if (F.lane == 0) SC[0] = expf(a) - expf(b) + LAM_INIT0; }
            { const float t0 = F.in[I_LBT][F.tid], t1 = F.in[I_LBT][512 + F.tid]; SC[256 + F.tid] = 1.0f / (1.0f + expf(t0 - t1)); }
        }
    }
    {
        LAS float* scr = (LAS float*)(F.lds + F.wave * 16384);
        transpose_weight<false>(F, F.in[I_EV_WIN], 1024, EV_IN, (bf16*)(F.ws + WS_W_IN0), 1024, scr);
        transpose_weight<false>(F, F.in[I_EV_WOUT], 1024, 1024, (bf16*)(F.ws + WS_W_OUT0), 1024, scr);
        transpose_weight<true>(F, F.in[I_EV_W1], 1024, 2 * DFF, (bf16*)(F.ws + WS_W_FF1), 1024, scr);
        transpose_weight<false>(F, F.in[I_EV_W2], DFF, 1024, (bf16*)(F.ws + WS_W_FF2), DFF, scr);
        transpose_weight<false>(F, F.in[I_OD_WIN], 1024, OD_IN, (bf16*)(F.ws + WS_W_IN1), 1024, scr);
        transpose_weight<false>(F, F.in[I_OD_WUQ], 256, 768, (bf16*)(F.ws + WS_W_UQ), 256, scr);
        transpose_weight<false>(F, F.in[I_OD_WUKV], 128, 1024, (bf16*)(F.ws + WS_W_UKV), 256, scr);
        transpose_weight<false>(F, F.in[I_OD_WOUT], 1024, 1024, (bf16*)(F.ws + WS_W_OUT1), 1024, scr);
        for (int e = 0; e < NEXP; ++e) {
            transpose_weight<true>(F, F.in[I_OD_EW1] + (size_t)e * 1024 * 2 * DFF, 1024, 2 * DFF, (bf16*)(F.ws + WS_EXP_W1) + (size_t)e * 2 * DFF * 1024, 1024, scr);
            transpose_weight<false>(F, F.in[I_OD_EW2] + (size_t)e * DFF * 1024, DFF, 1024, (bf16*)(F.ws + WS_EXP_W2) + (size_t)e * 1024 * DFF, DFF, scr);
        }
        zero_bytes16(F, F.ws + WS_W_IN0 + (size_t)EV_IN * 1024 * 2, (size_t)(EV_INP - EV_IN) * 1024 * 2);
        zero_bytes16(F, F.ws + WS_W_IN1 + (size_t)OD_IN * 1024 * 2, (size_t)(OD_INP - OD_IN) * 1024 * 2);
        { const v4u z = {0u, 0u, 0u, 0u};
          for (int i = blockIdx.x * NTHR + F.tid; i < 1024 * 16; i += F.G * NTHR) *(GAS v4u*)(F.ws + WS_W_UKV + (size_t)(i >> 4) * 512 + 256 + (i & 15) * 16) = z; }
    }
}

__device__ __forceinline__ void store_bf16x4(bf16* p, f32x4 v) { *(GAS unsigned long long*)p = (unsigned long long)pk2(v.x, v.y) | ((unsigned long long)pk2(v.z, v.w) << 32); }
__device__ __forceinline__ void p_modulate0(Frame& F) {
    const float* MOD = (const float*)(F.ws + WS_MOD); bf16* H = (bf16*)(F.ws + WS_H);
    for (int m = F.gw; m < MT; m += F.NGW) {
        const float* xr = src_row(F, m); const float* mr = MOD + (size_t)(0 * 9 + mod_row(m)) * 6144;
#pragma unroll
        for (int j = 0; j < 4; ++j) { const int c = 4 * F.lane + 256 * j; const f32x4 v = *(const f32x4*)(xr + c), sh = *(const f32x4*)(mr + c), sc = *(const f32x4*)(mr + 1024 + c);
            store_bf16x4(H + (size_t)m * DM + c, v * (1.0f + sc) + sh); }
    }
}

__device__ __forceinline__ void p_post0(Frame& F) {
    const bf16* P = (const bf16*)(F.ws + WS_P); float* GK = (float*)(F.ws + WS_GK);
    const int d = F.lane >> 5, k0 = (F.lane & 31) * 8;
    for (int m = F.gw; m < MT; m += F.NGW) {
        const bf16* pr = P + (size_t)m * EV_INP + EV_LRF + d * 16;
        const v4u l0 = *(const GAS v4u*)pr, l1 = *(const GAS v4u*)(pr + 8);
        float lr[16]; lr[0] = bflo(l0.x); lr[1] = bfhi(l0.x); lr[2] = bflo(l0.y); lr[3] = bfhi(l0.y); lr[4] = bflo(l0.z); lr[5] = bfhi(l0.z); lr[6] = bflo(l0.w); lr[7] = bfhi(l0.w);
        lr[8] = bflo(l1.x); lr[9] = bfhi(l1.x); lr[10] = bflo(l1.y); lr[11] = bfhi(l1.y); lr[12] = bflo(l1.z); lr[13] = bfhi(l1.z); lr[14] = bflo(l1.w); lr[15] = bfhi(l1.w);
        const float* wb = F.in[I_EV_GKW2] + (size_t)d * 16 * 256 + k0;
        f32x4 a0 = *(const f32x4*)(F.in[I_EV_GKB] + d * 256 + k0), a1 = *(const f32x4*)(F.in[I_EV_GKB] + d * 256 + k0 + 4);
#pragma unroll
        for (int r = 0; r < 16; ++r) { a0 = a0 + *(const f32x4*)(wb + r * 256) * lr[r]; a1 = a1 + *(const f32x4*)(wb + r * 256 + 4) * lr[r]; }
        f32x4 o0, o1;
#pragma unroll
        for (int q = 0; q < 4; ++q) { o0[q] = logsigmoidf_(a0[q]) * (1.0f / 16.0f); o1[q] = logsigmoidf_(a1[q]) * (1.0f / 16.0f); }
        float* go = GK + ((size_t)d * MT + m) * 256 + k0; *(f32x4*)go = o0; *(f32x4*)(go + 4) = o1;
    }
}
namespace att {
typedef short bf16x8 __attribute__((ext_vector_type(8)));
typedef short s16x4 __attribute__((ext_vector_type(4)));
typedef float f32x16 __attribute__((ext_vector_type(16)));
typedef unsigned u32x4 __attribute__((ext_vector_type(4)));
constexpr int KVBLK = 64, SHM_V = KVBLK * 128 * 2;
constexpr float THR = 8.f;
#define ATT_SBAR() __builtin_amdgcn_sched_barrier(0)
__device__ __forceinline__ int crow(int r, int hi) { return (r & 3) + 8 * (r >> 2) + 4 * hi; }
__device__ __forceinline__ unsigned cvtpk(float lo, float hi) { unsigned r; asm volatile("v_cvt_pk_bf16_f32 %0, %1, %2" : "=v"(r) : "v"(lo), "v"(hi)); return r; }

__device__ __forceinline__ void partialSM(f32x16& p0, f32x16& p1, float& m_reg, float& mn, float& alpha, const float C, const float THRS) {
    float pmax = p0[0];
#pragma unroll
    for (int r = 1; r < 16; ++r) pmax = fmaxf(pmax, p0[r]);
#pragma unroll
    for (int r = 0; r < 16; ++r) pmax = fmaxf(pmax, p1[r]);
    { auto rr = __builtin_amdgcn_permlane32_swap(__float_as_uint(pmax), __float_as_uint(pmax), false, false);
      pmax = fmaxf(__uint_as_float(rr[0]), __uint_as_float(rr[1])); }
    if (__builtin_expect(__all(pmax - m_reg <= THRS), 1)) { mn = m_reg; alpha = 1.f; }
    else { mn = fmaxf(m_reg, pmax); alpha = __builtin_amdgcn_exp2f((m_reg - mn) * C); m_reg = mn; }
    const float mnC = -mn * C;
#pragma unroll
    for (int r = 0; r < 16; ++r) p0[r] = fmaf(p0[r], C, mnC);
#pragma unroll
    for (int r = 0; r < 16; ++r) p1[r] = fmaf(p1[r], C, mnC);
#pragma unroll
    for (int r = 0; r < 16; ++r) p0[r] = __builtin_amdgcn_exp2f(p0[r]);
}
__device__ __forceinline__ void finishSM(f32x16& p0, f32x16& p1, float alpha, float& l_reg, bf16x8& pa0, bf16x8& pa1, bf16x8& pa2, bf16x8& pa3) {
#pragma unroll
    for (int r = 0; r < 16; ++r) p1[r] = __builtin_amdgcn_exp2f(p1[r]);
    float ps = 0;
#pragma unroll
    for (int r = 0; r < 16; ++r) ps += p0[r];
#pragma unroll
    for (int r = 0; r < 16; ++r) ps += p1[r];
    { auto rr = __builtin_amdgcn_permlane32_swap(__float_as_uint(ps), __float_as_uint(ps), false, false);
      ps = __uint_as_float(rr[0]) + __uint_as_float(rr[1]); }
    l_reg = l_reg * alpha + ps;
#define ATT_PK4(P, BASE, OUT) do { unsigned a0 = cvtpk(P[BASE + 0], P[BASE + 1]), a1 = cvtpk(P[BASE + 2], P[BASE + 3]);   \
    unsigned b0 = cvtpk(P[BASE + 4], P[BASE + 5]), b1 = cvtpk(P[BASE + 6], P[BASE + 7]);                              \
    auto r0 = __builtin_amdgcn_permlane32_swap(a0, b0, false, false); auto r1 = __builtin_amdgcn_permlane32_swap(a1, b1, false, false); \
    u32x4 w = {r0[0], r1[0], r0[1], r1[1]}; OUT = __builtin_bit_cast(bf16x8, w); } while (0)
    ATT_PK4(p0, 0, pa0); ATT_PK4(p0, 8, pa1); ATT_PK4(p1, 0, pa2); ATT_PK4(p1, 8, pa3);
#undef ATT_PK4
}
__device__ __forceinline__ int v_st(int k, int c) { const int kk = (k & ~0xC) | ((k & 4) << 1) | ((k & 8) >> 1); return ((kk >> 3) * 4 + (c >> 5)) * 512 + ((kk & 7) * 32 + (c & 31)) * 2; }
__device__ __forceinline__ int v_rd_base(int lane) { return ((lane & 3) << 3) | (((lane >> 2) & 3) << 6) | (((lane >> 4) & 1) << 5) | (((lane >> 5) & 1) << 8); }
constexpr int v_rd_off(int d0, int ks, int half) { return d0 * 512 + ks * 4096 + half * 2048; }
template <int OFF> __device__ __forceinline__ s16x4 tr_read(int vb) { s16x4 r; asm volatile("ds_read_b64_tr_b16 %0, %1 offset:%2" : "=&v"(r) : "v"(vb), "i"(OFF) : "memory"); return r; }
template <int D0> __device__ __forceinline__ void pv_one(f32x16& od, int vb, bf16x8 pa0, bf16x8 pa1, bf16x8 pa2, bf16x8 pa3) {
    const s16x4 l0 = tr_read<v_rd_off(D0, 0, 0)>(vb), h0 = tr_read<v_rd_off(D0, 0, 1)>(vb), l1 = tr_read<v_rd_off(D0, 1, 0)>(vb), h1 = tr_read<v_rd_off(D0, 1, 1)>(vb);
    const s16x4 l2 = tr_read<v_rd_off(D0, 2, 0)>(vb), h2 = tr_read<v_rd_off(D0, 2, 1)>(vb), l3 = tr_read<v_rd_off(D0, 3, 0)>(vb), h3 = tr_read<v_rd_off(D0, 3, 1)>(vb);
    asm volatile("s_waitcnt lgkmcnt(0)" ::: "memory"); ATT_SBAR();
#define ATT_PK(L, H) (bf16x8){L[0], L[1], L[2], L[3], H[0], H[1], H[2], H[3]}
    od = __builtin_amdgcn_mfma_f32_32x32x16_bf16(pa0, ATT_PK(l0, h0), od, 0, 0, 0);
    od = __builtin_amdgcn_mfma_f32_32x32x16_bf16(pa1, ATT_PK(l1, h1), od, 0, 0, 0);
    od = __builtin_amdgcn_mfma_f32_32x32x16_bf16(pa2, ATT_PK(l2, h2), od, 0, 0, 0);
    od = __builtin_amdgcn_mfma_f32_32x32x16_bf16(pa3, ATT_PK(l3, h3), od, 0, 0, 0);
#undef ATT_PK
}
__device__ __forceinline__ void pv_d0(f32x16* o, int vb, bf16x8 pa0, bf16x8 pa1, bf16x8 pa2, bf16x8 pa3) {
    pv_one<0>(o[0], vb, pa0, pa1, pa2, pa3); pv_one<1>(o[1], vb, pa0, pa1, pa2, pa3); pv_one<2>(o[2], vb, pa0, pa1, pa2, pa3); pv_one<3>(o[3], vb, pa0, pa1, pa2, pa3);
}
__device__ __forceinline__ int k_st(int row, int c, int RB) { return row * RB + (((c & ~7) | ((c & 7) ^ ((row >> 1) & 7))) << 4); }
template <int NQ, int RB> __device__ __forceinline__ void qkt(f32x16& p0, f32x16& p1, const LAS unsigned char* kb  , const int (&kx)[4], const bf16x8* qr) {
    p0 = f32x16{}; p1 = f32x16{};
#pragma unroll
    for (int d0 = 0; d0 < NQ; ++d0) {
        const LAS unsigned char* a = kb + kx[d0 & 3] + (d0 >> 2) * 128;
        const bf16x8 b0 = *(const LAS bf16x8*)a, b1 = *(const LAS bf16x8*)(a + 32 * RB);
        p0 = __builtin_amdgcn_mfma_f32_32x32x16_bf16(b0, qr[d0], p0, 0, 0, 0);
        p1 = __builtin_amdgcn_mfma_f32_32x32x16_bf16(b1, qr[d0], p1, 0, 0, 0);
    }
}
struct Src { const bf16* kbase; int ldk; const bf16* k2base; int ldk2; const bf16* vbase; int ldv; int rowc, rowl, NT; };

template <int DQK, bool QROPE, bool PIPE>
__device__ __forceinline__ void attn_core(const bf16* Qw, const Src& S, LAS unsigned char* lds, const float C, const float THRS, f32x16 (&o)[4], float& l_out, int tid, const float* cs, const float* sn) {
    constexpr int NQ = DQK / 16, RB = DQK * 2, SHM_K = KVBLK * RB, KCH = DQK / 8, KPT = (KVBLK * KCH) / 512;
    static_assert(KPT * 512 == KVBLK * KCH, "K chunks divide over the threads");
    const int wid = tid >> 6, lane = tid & 63, r32 = lane & 31, hi = lane >> 5;
    LAS unsigned char* V_lds = lds; LAS unsigned char* K_lds = lds + 2 * SHM_V;
    LAS float* al_l = (LAS float*)(lds + 2 * SHM_V + 2 * SHM_K) + wid * 64 + 32;
    float m_reg = -1e30f, l_reg = 0;
#pragma unroll
    for (int d = 0; d < 4; ++d) o[d] = f32x16{};
    bf16x8 qr[NQ];
#pragma unroll
    for (int d0 = 0; d0 < NQ; ++d0) qr[d0] = *(const GAS bf16x8*)(Qw + d0 * 16);
    if constexpr (QROPE) {
#pragma unroll
        for (int d0 = NQ - 4; d0 < NQ; ++d0) { const int i0 = (d0 - (NQ - 4)) * 8 + hi * 4; const f32x4 c4 = *(const f32x4*)(cs + i0), s4 = *(const f32x4*)(sn + i0);
            const u32x4 w = __builtin_bit_cast(u32x4, qr[d0]); u32x4 ow;
#pragma unroll
            for (int p = 0; p < 4; ++p) { const float t0 = __uint_as_float(w[p] << 16), t1 = __uint_as_float(w[p] & 0xffff0000u); ow[p] = cvtpk(t0 * c4[p] - t1 * s4[p], t0 * s4[p] + t1 * c4[p]); }
            qr[d0] = __builtin_bit_cast(bf16x8, ow); }
    }
    const int sr = tid >> 4, sc = (tid & 15) * 8, vst0 = v_st(sr, sc), vst1 = v_st(32 + sr, sc);
    int kst[KPT]; unsigned koff[KPT];
#pragma unroll
    for (int i = 0; i < KPT; ++i) {
        int row, c; unsigned ld;
        if (DQK == 64) { row = tid >> 3; c = tid & 7; ld = (unsigned)S.ldk; koff[i] = (unsigned)row * ld + c * 8; }
        else if (i < 2) { row = (tid >> 4) + 32 * i; c = tid & 15; ld = (unsigned)S.ldk; koff[i] = (unsigned)row * ld + c * 8; }
        else { row = tid >> 3; c = 16 + (tid & 7); ld = (unsigned)S.ldk2; koff[i] = (unsigned)row * ld + (c - 16) * 8; }
        kst[i] = k_st(row, c, RB);
    }
    const unsigned voff0 = (unsigned)sr * (unsigned)S.ldv + sc, voff1 = voff0 + 32u * (unsigned)S.ldv;
    const int vb0 = (int)(unsigned)(size_t)(V_lds) + v_rd_base(lane);
    int kx[4]; { const int t = hi ^ ((r32 >> 1) & 7);
#pragma unroll
        for (int k = 0; k < 4; ++k) kx[k] = ((2 * k) ^ t) << 4; }
    const LAS unsigned char* kb0 = K_lds + r32 * RB; const LAS unsigned char* kb1 = kb0 + SHM_K;
    struct Slot { bf16x8 vs0, vs1; bf16x8 ks[KPT]; };
    Slot s0;
#define ATT_SLOAD(sl, j) do { const int _j = (j); const unsigned _r0 = (unsigned)(_j < 4 ? S.rowc + 64 * _j : S.rowl + 64 * (_j - 4)); \
        const bf16* _vb = S.vbase + (size_t)_r0 * S.ldv; sl.vs0 = *(const GAS bf16x8*)(_vb + voff0); sl.vs1 = *(const GAS bf16x8*)(_vb + voff1); \
        const bf16* _kb = S.kbase + (size_t)_r0 * S.ldk; \
        _Pragma("unroll") for (int _i = 0; _i < KPT; ++_i) { \
            if (DQK == 64 || _i < 2) sl.ks[_i] = *(const GAS bf16x8*)(_kb + koff[_i]); \
            else sl.ks[_i] = *(const GAS bf16x8*)(S.k2base + (size_t)_r0 * S.ldk2 + koff[_i]); } } while (0)
#define ATT_SWRITE(b, sl) do { *(LAS bf16x8*)(V_lds + (b) * SHM_V + vst0) = sl.vs0; *(LAS bf16x8*)(V_lds + (b) * SHM_V + vst1) = sl.vs1; \
        _Pragma("unroll") for (int _i = 0; _i < KPT; ++_i) *(LAS bf16x8*)(K_lds + (b) * SHM_K + kst[_i]) = sl.ks[_i]; } while (0)
#define ATT_SWAIT() asm volatile("s_waitcnt vmcnt(%0)" :: "n"(2 + KPT) : "memory")
#define ATT_RESC(a) do { if (__any((a) < 1.f)) { if (hi == 0) al_l[r32] = (a); asm volatile("s_waitcnt lgkmcnt(0)" ::: "memory"); \
        _Pragma("unroll") for (int d = 0; d < 4; ++d) _Pragma("unroll") for (int r = 0; r < 16; ++r) o[d][r] *= al_l[crow(r, hi)]; } } while (0)
    bf16x8 pa0, pa1, pa2, pa3; const int NT = S.NT;
    if constexpr (!PIPE) {
    f32x16 p0, p1; float mn, al;
    ATT_SLOAD(s0, 0); asm volatile("s_waitcnt vmcnt(0)" ::: "memory"); ATT_SWRITE(0, s0); ATT_SLOAD(s0, 1);
#define ATT_HALF(b, jj) do { \
        __syncthreads(); \
        if ((jj) + 1 < NT) { ATT_SWRITE((b) ^ 1, s0); if ((jj) + 2 < NT) ATT_SLOAD(s0, (jj) + 2); } \
        ATT_SBAR(); qkt<NQ, RB>(p0, p1, (b) ? kb1 : kb0, kx, qr); \
        partialSM(p0, p1, m_reg, mn, al, C, THRS); ATT_RESC(al); \
        finishSM(p0, p1, al, l_reg, pa0, pa1, pa2, pa3); ATT_SBAR(); \
        pv_d0(o, vb0 + (b) * SHM_V, pa0, pa1, pa2, pa3); } while (0)
    for (int j = 0; j < NT; j += 2) { ATT_HALF(0, j); ATT_HALF(1, j + 1); }
#undef ATT_HALF
    __syncthreads();
    } else {
    Slot s1; f32x16 pA0, pA1, pB0, pB1; float mnA, mnB, alA, alB;
    ATT_SLOAD(s0, 0); asm volatile("s_waitcnt vmcnt(0)" ::: "memory"); ATT_SWRITE(0, s0); __syncthreads();
    qkt<NQ, RB>(pA0, pA1, kb0, kx, qr); partialSM(pA0, pA1, m_reg, mnA, alA, C, THRS);
    ATT_SLOAD(s1, 1); if (2 < NT) ATT_SLOAD(s0, 2);
    ATT_SWAIT(); ATT_SWRITE(1, s1); __syncthreads();
    for (int j = 1; j + 1 < NT; j += 2) {
        ATT_SBAR(); qkt<NQ, RB>(pB0, pB1, kb1, kx, qr);
        finishSM(pA0, pA1, alA, l_reg, pa0, pa1, pa2, pa3); ATT_SBAR();
        ATT_SLOAD(s1, j + 2); ATT_SBAR();
        pv_d0(o, vb0, pa0, pa1, pa2, pa3); partialSM(pB0, pB1, m_reg, mnB, alB, C, THRS);
        __syncthreads(); ATT_SWAIT(); ATT_SWRITE(0, s0);
        ATT_RESC(alB); __syncthreads();
        ATT_SBAR(); qkt<NQ, RB>(pA0, pA1, kb0, kx, qr);
        finishSM(pB0, pB1, alB, l_reg, pa0, pa1, pa2, pa3); ATT_SBAR();
        if (j + 3 < NT) ATT_SLOAD(s0, j + 3); ATT_SBAR();
        pv_d0(o, vb0 + SHM_V, pa0, pa1, pa2, pa3); partialSM(pA0, pA1, m_reg, mnA, alA, C, THRS);
        __syncthreads(); ATT_SWAIT(); ATT_SWRITE(1, s1);
        ATT_RESC(alA); __syncthreads();
    }
    ATT_SBAR(); qkt<NQ, RB>(pB0, pB1, kb1, kx, qr);
    finishSM(pA0, pA1, alA, l_reg, pa0, pa1, pa2, pa3); ATT_SBAR();
    pv_d0(o, vb0, pa0, pa1, pa2, pa3); partialSM(pB0, pB1, m_reg, mnB, alB, C, THRS);
    __syncthreads(); ATT_RESC(alB);
    finishSM(pB0, pB1, alB, l_reg, pa0, pa1, pa2, pa3); ATT_SBAR();
    pv_d0(o, vb0 + SHM_V, pa0, pa1, pa2, pa3);
    __syncthreads();
    }
    l_out = l_reg;
#undef ATT_SLOAD
#undef ATT_SWRITE
#undef ATT_SWAIT
#undef ATT_RESC
}
__device__ __forceinline__ void row_inv(float l_reg, LAS unsigned char* lds, int SHM_K, int tid, float (&rli)[16]) {
    const int wid = tid >> 6, lane = tid & 63, r32 = lane & 31, hi = lane >> 5;
    LAS float* li_l = (LAS float*)(lds + 2 * SHM_V + 2 * SHM_K) + wid * 64;
    if (hi == 0) li_l[r32] = l_reg; asm volatile("s_waitcnt lgkmcnt(0)" ::: "memory");
#pragma unroll
    for (int r = 0; r < 16; ++r) rli[r] = __builtin_amdgcn_rcpf(li_l[crow(r, hi)]);
    asm volatile("s_waitcnt lgkmcnt(0)" ::: "memory");
}
}
__device__ __forceinline__ f32x4 ld_bf16x4(const bf16* p) { const unsigned long long w = *(const GAS unsigned long long*)p; return (f32x4){bflo((unsigned)w), bfhi((unsigned)w), bflo((unsigned)(w >> 32)), bfhi((unsigned)(w >> 32))}; }
__device__ __forceinline__ int key_row(int b, int j) { return j < CTXL ? ML + b * CTXL + j : b * SEQ + (j - CTXL); }
__device__ __forceinline__ float dot64_lds(const bf16* kp, const LAS float* q) {
    float s = 0.f;
#pragma unroll
    for (int c = 0; c < 8; ++c) { const v4u kv = *(const GAS v4u*)(kp + 8 * c); const LAS float* qq = q + 8 * c;
        s += bflo(kv.x) * qq[0] + bfhi(kv.x) * qq[1] + bflo(kv.y) * qq[2] + bfhi(kv.y) * qq[3] + bflo(kv.z) * qq[4] + bfhi(kv.z) * qq[5] + bflo(kv.w) * qq[6] + bfhi(kv.w) * qq[7]; }
    return s;
}
constexpr int ATT_WAVE_BYTES = 18944;
static_assert(8 * ATT_WAVE_BYTES <= SCR_BYTES, "attention scratch");

__device__ __forceinline__ void p_attn0_naive(Frame& F) {
    const bf16* P = (const bf16*)(F.ws + WS_P); float* OA = (float*)(F.ws + WS_OA);
    const float lam = *(const float*)(F.ws + WS_SCAL);
    LAS float* w1 = (LAS float*)(F.lds + F.wave * ATT_WAVE_BYTES); LAS float* w2 = w1 + 2304; LAS float* q = w2 + 2304;
    for (int it = F.gw; it < MT * 4; it += F.NGW) {
        const int m = it >> 2, h = it & 3;
        const int b = m < ML ? (m >> 11) : ((m - ML) >> 8), NK = m < ML ? (CTXL + SEQ) : CTXL;
        const bf16* qp = P + (size_t)m * EV_INP + EV_QA + h * 128;
        q[F.lane] = bf2f(qp[F.lane]); q[64 + F.lane] = bf2f(qp[64 + F.lane]);
        LDS_WAIT(); asm volatile("" ::: "memory");
        float mx1 = -3.0e38f, mx2 = -3.0e38f;
        for (int j = F.lane; j < NK; j += 64) { const bf16* kp = P + (size_t)key_row(b, j) * EV_INP + EV_KA + h * 128;
            const float s1 = dot64_lds(kp, q) * DA_SCALE, s2 = dot64_lds(kp + 64, q + 64) * DA_SCALE; w1[j] = s1; w2[j] = s2; mx1 = fmaxf(mx1, s1); mx2 = fmaxf(mx2, s2); }
        mx1 = wave_max(mx1); mx2 = wave_max(mx2);
        float sum1 = 0.f, sum2 = 0.f;
        for (int j = F.lane; j < NK; j += 64) { const float e1 = __expf(w1[j] - mx1), e2 = __expf(w2[j] - mx2); w1[j] = e1; w2[j] = e2; sum1 += e1; sum2 += e2; }
        const float inv1 = 1.0f / wave_sum(sum1), c2 = lam / wave_sum(sum2);
        for (int j = F.lane; j < NK; j += 64) w1[j] = w1[j] * inv1 - c2 * w2[j];
        LDS_WAIT(); asm volatile("" ::: "memory");
        float a0 = 0.f, a1 = 0.f;
        const bf16* vbase = P + EV_VA + h * 128 + 2 * F.lane;
        for (int j = 0; j < NK; j += 4) {
            unsigned vv[4]; float ww[4];
#pragma unroll
            for (int u = 0; u < 4; ++u) { vv[u] = *(const GAS unsigned*)(vbase + (size_t)key_row(b, j + u) * EV_INP); ww[u] = w1[j + u]; }
#pragma unroll
            for (int u = 0; u < 4; ++u) { a0 += ww[u] * bflo(vv[u]); a1 += ww[u] * bfhi(vv[u]); }
        }
        *(float2*)(OA + (size_t)m * 512 + h * 128 + 2 * F.lane) = make_float2(a0, a1);
        LDS_WAIT(); asm volatile("" ::: "memory");
    }
}

__device__ __forceinline__ void p_attn1_naive(Frame& F) {
    const bf16* P = (const bf16*)(F.ws + WS_P); const bf16* Q = (const bf16*)(F.ws + WS_Q); const bf16* KV = (const bf16*)(F.ws + WS_KV); float* OM = (float*)(F.ws + WS_OM);
    const float* COS = (const float*)(F.ws + WS_COS); const float* SIN = (const float*)(F.ws + WS_SIN);
    LAS float* w1 = (LAS float*)(F.lds + F.wave * ATT_WAVE_BYTES); LAS float* q = w1 + 2304;
    for (int it = F.gw; it < ML * 4; it += F.NGW) {
        const int m = it >> 2, h = it & 3, b = m >> 11, NK = CTXL + SEQ, t = m & (SEQ - 1);
        const bf16* qp = Q + (size_t)m * 768 + h * 192;
        q[F.lane] = bf2f(qp[F.lane]); q[64 + F.lane] = bf2f(qp[64 + F.lane]);
        if (F.lane < 32) { const float t0 = bf2f(qp[128 + 2 * F.lane]), t1 = bf2f(qp[129 + 2 * F.lane]), cs = COS[t * 32 + F.lane], sn = SIN[t * 32 + F.lane];
            q[128 + 2 * F.lane] = t0 * cs - t1 * sn; q[129 + 2 * F.lane] = t0 * sn + t1 * cs; }
        LDS_WAIT(); asm volatile("" ::: "memory");
        float mx = -3.0e38f;
        for (int j = F.lane; j < NK; j += 64) { const int kr = key_row(b, j); const bf16* kn = KV + (size_t)kr * 1024 + h * 256; const bf16* kp = P + (size_t)kr * OD_INP + OD_KR;
            const float s = (dot64_lds(kn, q) + dot64_lds(kn + 64, q + 64) + dot64_lds(kp, q + 128)) * MLA_SCALE; w1[j] = s; mx = fmaxf(mx, s); }
        mx = wave_max(mx);
        float sum = 0.f;
        for (int j = F.lane; j < NK; j += 64) { const float e = __expf(w1[j] - mx); w1[j] = e; sum += e; }
        const float inv = 1.0f / wave_sum(sum);
        LDS_WAIT(); asm volatile("" ::: "memory");
        float a0 = 0.f, a1 = 0.f;
        const bf16* vbase = KV + h * 256 + 128 + 2 * F.lane;
        for (int j = 0; j < NK; j += 4) {
            unsigned vv[4]; float ww[4];
#pragma unroll
            for (int u = 0; u < 4; ++u) { vv[u] = *(const GAS unsigned*)(vbase + (size_t)key_row(b, j + u) * 1024); ww[u] = w1[j + u]; }
#pragma unroll
            for (int u = 0; u < 4; ++u) { a0 += ww[u] * bflo(vv[u]); a1 += ww[u] * bfhi(vv[u]); }
        }
        *(float2*)(OM + (size_t)m * 512 + h * 128 + 2 * F.lane) = make_float2(a0 * inv, a1 * inv);
        LDS_WAIT(); asm volatile("" ::: "memory");
    }
}


__device__ __forceinline__ void p_attn0(Frame& F) {
    const bf16* P = (const bf16*)(F.ws + WS_P); float* OA = (float*)(F.ws + WS_OA);
    const float lam = *(const float*)(F.ws + WS_SCAL);
    const float C = DA_SCALE * 1.4426950408889634f, THRS = att::THR / DA_SCALE;
    const int r32 = F.lane & 31, hi = F.lane >> 5;
    for (int u = blockIdx.x; u < 288; u += F.G) {
        int bh, qb, NT;
        if (u < 256) { const int x = u & 7, y = u >> 3; bh = x * 4 + (y & 3); qb = y >> 2; NT = 36; } else { bh = u - 256; qb = 0; NT = 4; }
        const int b = bh >> 2, h = bh & 3;
        const int m0 = (u < 256 ? b * SEQ + qb * 256 : ML + b * CTXL) + F.wave * 32;
        const bf16* Qw = P + (size_t)(m0 + r32) * EV_INP + EV_QA + h * 128 + hi * 8;
#pragma unroll 1
        for (int pass = 0; pass < 2; ++pass) {
            att::Src S; S.kbase = P + EV_KA + h * 128 + 64 * pass; S.ldk = EV_INP; S.k2base = nullptr; S.ldk2 = 0; S.vbase = P + EV_VA + h * 128; S.ldv = EV_INP; S.rowc = ML + b * CTXL; S.rowl = b * SEQ; S.NT = NT;
            att::f32x16 o[4]; float l; float rli[16];
            att::attn_core<64, false, true>(Qw + 64 * pass, S, F.lds, C, THRS, o, l, F.tid, nullptr, nullptr);
            att::row_inv(l, F.lds, 64 * 128, F.tid, rli);
            const float sc = pass ? -lam : 1.0f;
            int lo_ = F.lane; asm volatile("" : "+v"(lo_));
            float* Ow = OA + (size_t)m0 * 512 + h * 128; const unsigned ob = (unsigned)((lo_ >> 5) * 4 * 512 + (lo_ & 31));
#pragma unroll
            for (int r = 0; r < 16; ++r)
#pragma unroll
                for (int d0 = 0; d0 < 4; ++d0) { float* p = Ow + (ob + (unsigned)(((r & 3) + 8 * (r >> 2)) * 512 + d0 * 32)); const float v = o[d0][r] * rli[r] * sc; *p = pass ? *p + v : v; if (d0 == 3 && (r & 1)) asm volatile("" ::: "memory"); }
        }
    }
}
__device__ __forceinline__ void p_attn1(Frame& F) {
    const bf16* P = (const bf16*)(F.ws + WS_P); const bf16* Q = (const bf16*)(F.ws + WS_Q); const bf16* KV = (const bf16*)(F.ws + WS_KV); float* OM = (float*)(F.ws + WS_OM);
    const float* COS = (const float*)(F.ws + WS_COS); const float* SIN = (const float*)(F.ws + WS_SIN);
    const float C = MLA_SCALE * 1.4426950408889634f, THRS = att::THR / MLA_SCALE;
    const int r32 = F.lane & 31, hi = F.lane >> 5;
    for (int u = blockIdx.x; u < 256; u += F.G) {
        const int x = u & 7, y = u >> 3, bh = x * 4 + (y & 3), qb = y >> 2, b = bh >> 2, h = bh & 3;
        const int m0 = b * SEQ + qb * 256 + F.wave * 32;
        att::Src S; S.kbase = KV + h * 256; S.ldk = 1024; S.k2base = P + OD_KR; S.ldk2 = OD_INP; S.vbase = KV + h * 256 + 128; S.ldv = 1024; S.rowc = ML + b * CTXL; S.rowl = b * SEQ; S.NT = 36;
        const int t = (m0 + r32) & (SEQ - 1);
        att::f32x16 o[4]; float l; float rli[16];
        att::attn_core<192, true, false>(Q + (size_t)(m0 + r32) * 768 + h * 192 + hi * 8, S, F.lds, C, THRS, o, l, F.tid, COS + t * 32, SIN + t * 32);
        att::row_inv(l, F.lds, 64 * 384, F.tid, rli);
        int lo_ = F.lane; asm volatile("" : "+v"(lo_));
        bf16* Ow = (bf16*)(F.ws + WS_H) + (size_t)m0 * DM + h * 128; const unsigned ob = (unsigned)((lo_ >> 5) * 4 * DM + (lo_ & 31));
#pragma unroll
        for (int r = 0; r < 16; ++r)
#pragma unroll
            for (int d0 = 0; d0 < 4; ++d0) Ow[ob + (unsigned)(((r & 3) + 8 * (r >> 2)) * DM + d0 * 32)] = (bf16)(att::cvtpk(o[d0][r] * rli[r], 0.f) & 0xffffu);
    }
}
__device__ __forceinline__ int scan_row(int b, int d, int s) {
    if (s < CTXL) return ML + b * CTXL + (d ? (CTXL - 1 - s) : s);
    const int t = s - CTXL; return b * SEQ + (d ? (SEQ - 1 - t) : t);
}
__device__ __forceinline__ void p_scan0(Frame& F) {
    const bf16* P = (const bf16*)(F.ws + WS_P); const float* GK = (const float*)(F.ws + WS_GK);
    LAS float* qL = (LAS float*)F.lds; LAS float* kL = qL + 2048; LAS float* eL = kL + 2048; LAS float* vL = eL + 2048; LAS float* part = vL + 4096;
    const int v = F.tid & 127, kg = F.tid >> 7;
    for (int ch = blockIdx.x; ch < 64; ch += F.G) {
        const int b = ch >> 3, h = (ch >> 1) & 3, d = ch & 1;
        float* OB = (float*)(F.ws + (d ? WS_OBB : WS_OBF));
        float S[16];
#pragma unroll
        for (int i = 0; i < 16; ++i) S[i] = 0.f;
        for (int c = 0; c < (CTXL + SEQ) / 32; ++c) {
            for (int i = F.tid; i < 32 * 64; i += NTHR) { const int r = i >> 6, k = i & 63; const size_t row = (size_t)scan_row(b, d, c * 32 + r);
                qL[i] = bf2f(P[row * EV_INP + EV_QB + h * 64 + k]) * GLA_QSCALE; kL[i] = bf2f(P[row * EV_INP + EV_KB + h * 64 + k]); eL[i] = __expf(GK[((size_t)d * MT + row) * 256 + h * 64 + k]); }
            for (int i = F.tid; i < 32 * 128; i += NTHR) { const int r = i >> 7, vv = i & 127; const size_t row = (size_t)scan_row(b, d, c * 32 + r); vL[i] = bf2f(P[row * EV_INP + EV_VB + h * 128 + vv]); }
            __syncthreads();
            for (int r = 0; r < 32; ++r) { const float vv = vL[r * 128 + v]; float po = 0.f;
#pragma unroll
                for (int kk = 0; kk < 16; ++kk) { const int k = kg * 16 + kk; S[kk] = S[kk] * eL[r * 64 + k] + kL[r * 64 + k] * vv; po += S[kk] * qL[r * 64 + k]; }
                part[(r * 4 + kg) * 128 + v] = po; }
            __syncthreads();
            for (int i = F.tid; i < 32 * 128; i += NTHR) { const int r = i >> 7, vv = i & 127; const size_t row = (size_t)scan_row(b, d, c * 32 + r);
                OB[row * 512 + h * 128 + vv] = (part[(r * 4 + 0) * 128 + vv] + part[(r * 4 + 1) * 128 + vv]) + (part[(r * 4 + 2) * 128 + vv] + part[(r * 4 + 3) * 128 + vv]); }
            __syncthreads();
        }
    }
}
__device__ __forceinline__ void p_scan1(Frame& F) {
    const bf16* P = (const bf16*)(F.ws + WS_P); const float* LB = (const float*)(F.ws + WS_SCAL) + 256;
    LAS float* qL = (LAS float*)F.lds; LAS float* fL = qL + 4096; LAS float* vL = fL + 4096; LAS float* part = vL + 4096;
    const int v = F.tid & 127, kg = F.tid >> 7;
    for (int ch = blockIdx.x; ch < 64; ch += F.G) {
        const int b = ch >> 3, h = (ch >> 1) & 3, d = ch & 1;
        float* OH = (float*)(F.ws + (d ? WS_OHB : WS_OHF));
        const int fcol = (d ? OD_HFB : OD_HFF) + h * 128;
        float S[32];
#pragma unroll
        for (int i = 0; i < 32; ++i) S[i] = 0.f;
        for (int c = 0; c < (CTXL + SEQ) / 32; ++c) {
            for (int i = F.tid; i < 32 * 128; i += NTHR) { const int r = i >> 7, k = i & 127; const size_t row = (size_t)scan_row(b, d, c * 32 + r); const bf16* pr = P + row * OD_INP;
                const float lb = LB[h * 128 + k];
                qL[i] = bf2f(pr[OD_HQ + h * 128 + k]); fL[i] = lb + (1.0f - lb) * sigmoidf_(bf2f(pr[fcol + k])); vL[i] = bf2f(pr[OD_HI + h * 128 + k]); }
            __syncthreads();
            for (int r = 0; r < 32; ++r) { const float vv = vL[r * 128 + v]; float po = 0.f;
#pragma unroll
                for (int kk = 0; kk < 32; ++kk) { const int k = kg * 32 + kk; const float f = fL[r * 128 + k]; S[kk] = S[kk] * f + (1.0f - f) * vv; po += S[kk] * qL[r * 128 + k]; }
                part[(r * 4 + kg) * 128 + v] = po; }
            __syncthreads();
            if (c >= CTXL / 32) {
                for (int i = F.tid; i < 32 * 128; i += NTHR) { const int r = i >> 7, vv = i & 127; const size_t row = (size_t)scan_row(b, d, c * 32 + r);
                    OH[row * 512 + h * 128 + vv] = (part[(r * 4 + 0) * 128 + vv] + part[(r * 4 + 1) * 128 + vv]) + (part[(r * 4 + 2) * 128 + vv] + part[(r * 4 + 3) * 128 + vv]); }
            }
            __syncthreads();
        }
    }
}

namespace scn {
#define SCN_BAR() do { asm volatile("s_waitcnt lgkmcnt(0)" ::: "memory"); __builtin_amdgcn_s_barrier(); asm volatile("" ::: "memory"); } while (0)
typedef short bf16x8 __attribute__((ext_vector_type(8)));
typedef float f32x16 __attribute__((ext_vector_type(16)));
typedef unsigned u32x4 __attribute__((ext_vector_type(4)));
typedef unsigned u32x2 __attribute__((ext_vector_type(2)));
__device__ __forceinline__ unsigned cvtpk(float lo, float hi) { unsigned r; asm volatile("v_cvt_pk_bf16_f32 %0, %1, %2" : "=v"(r) : "v"(lo), "v"(hi)); return r; }
__device__ __forceinline__ int crow(int r, int hi) { return (r & 3) + 8 * (r >> 2) + 4 * hi; }
template <int DK> struct Lay {
    static constexpr int RS = DK * 2 + 16;
    static constexpr int TS = 80;
    static constexpr int QA = 0, KA = QA + 32 * RS, QB = KA + 32 * RS, KDT = QB + 32 * RS, VT = KDT + DK * TS, DEC = VT + 128 * TS, BUF = DEC + DK * 4;
};
__device__ __forceinline__ bf16x8 pack8(const f32x16& x, int s8) {
    u32x4 w; w.x = cvtpk(x[s8 + 0], x[s8 + 1]); w.y = cvtpk(x[s8 + 2], x[s8 + 3]); w.z = cvtpk(x[s8 + 4], x[s8 + 5]); w.w = cvtpk(x[s8 + 6], x[s8 + 7]); return __builtin_bit_cast(bf16x8, w);
}
__device__ __forceinline__ bf16x8 ld2x8(const LAS unsigned char* p) {
    const u32x2 a = *(const LAS u32x2*)p, b = *(const LAS u32x2*)(p + 16); u32x4 w; w.x = a.x; w.y = a.y; w.z = b.x; w.w = b.y; return __builtin_bit_cast(bf16x8, w);
}
__device__ __forceinline__ float dpp_f(float x, const int ctrl, const int row_mask, const bool bc) {
    return __builtin_bit_cast(float, ctrl == 0x111 ? __builtin_amdgcn_update_dpp(0, __builtin_bit_cast(int, x), 0x111, 0xf, 0xf, true)
                                   : ctrl == 0x112 ? __builtin_amdgcn_update_dpp(0, __builtin_bit_cast(int, x), 0x112, 0xf, 0xf, true)
                                   : ctrl == 0x114 ? __builtin_amdgcn_update_dpp(0, __builtin_bit_cast(int, x), 0x114, 0xf, 0xf, true)
                                   : ctrl == 0x118 ? __builtin_amdgcn_update_dpp(0, __builtin_bit_cast(int, x), 0x118, 0xf, 0xf, true)
                                   : __builtin_amdgcn_update_dpp(0, __builtin_bit_cast(int, x), 0x142, 0xa, 0xf, false));
}
__device__ __forceinline__ float prefix32(float x) {
    x += dpp_f(x, 0x111, 0xf, true); x += dpp_f(x, 0x112, 0xf, true); x += dpp_f(x, 0x114, 0xf, true); x += dpp_f(x, 0x118, 0xf, true); x += dpp_f(x, 0x142, 0xa, false);
    return x;
}
__device__ __forceinline__ float bcast_half(float x, const int l, int hi) {
    const float a = __builtin_bit_cast(float, __builtin_amdgcn_readlane(__builtin_bit_cast(int, x), l)), b = __builtin_bit_cast(float, __builtin_amdgcn_readlane(__builtin_bit_cast(int, x), l + 32));
    return hi ? b : a;
}
constexpr int NSEG = 4, SEGC = (CTXL + SEQ) / 32 / NSEG;
static_assert(SEGC % 3 == 0, "producer loop unrolled by 3");
template <int LAYER, bool OUT>
__device__ __forceinline__ void scan_seg(Frame& F, int u, LAS unsigned char* lds) {
    constexpr int DK = LAYER == 0 ? 64 : 128, NC = DK / 8, NMB = DK / 32, PITCH = LAYER == 0 ? EV_INP : OD_INP;
    typedef Lay<DK> LY;
    const int ch = u / NSEG, seg = u % NSEG, c0 = seg * SEGC;
    const int b = ch >> 3, h = (ch >> 1) & 3, d = ch & 1;
    const bf16* P = (const bf16*)(F.ws + WS_P);
    const int lane = F.lane, r32_o = lane & 31, hi = lane >> 5;
    const bool producer = F.wave >= 4; const int pw = F.wave & 3;
    constexpr int NCHUNK = SEGC;
    float* const EST = (float*)(F.ws + WS_SCAN_E); float* const DST = (float*)(F.ws + WS_SCAN_D);
    __syncthreads();
    if (producer) {
        const int kc0 = NC * (2 * pw + hi), vc0 = 32 * pw + 16 * hi;
        struct Raw { u32x4 rq[NC / 8]; u32x4 rk; u32x4 rv[2]; f32x4 rg[NC / 4]; };
        Raw RA, RB, RC;
        const float* GG = LAYER == 0 ? (const float*)(F.ws + WS_GK) + (size_t)d * MT * 256 + h * 64 + kc0 : (const float*)(F.ws + WS_GH) + (size_t)d * MT * 512 + h * 128 + kc0;
#define SCN_FETCH(X, n) do { const int _s = 32 * (c0 + (n)) + r32; const size_t _row = (size_t)scan_row(b, d, _s); const bf16* pr = P + _row * PITCH; const float* gr = GG + _row * (LAYER == 0 ? 256 : 512); \
        _Pragma("unroll") for (int _q = 0; _q < NC / 4; ++_q) X.rg[_q] = *(const f32x4*)(gr + 4 * _q); \
        if (LAYER == 0) { X.rq[0] = *(const GAS u32x4*)(pr + EV_QB + h * 64 + kc0); X.rk = *(const GAS u32x4*)(pr + EV_KB + h * 64 + kc0); \
            X.rv[0] = *(const GAS u32x4*)(pr + EV_VB + h * 128 + vc0); X.rv[1] = *(const GAS u32x4*)(pr + EV_VB + h * 128 + vc0 + 8); } \
        else { _Pragma("unroll") for (int _q = 0; _q < NC / 8; ++_q) X.rq[_q] = *(const GAS u32x4*)(pr + OD_HQ + h * 128 + kc0 + 8 * _q); \
            X.rv[0] = *(const GAS u32x4*)(pr + OD_HI + h * 128 + vc0); X.rv[1] = *(const GAS u32x4*)(pr + OD_HI + h * 128 + vc0 + 8); } } while (0)
#define SCN_STEP(X, n) do { \
            LAS unsigned char* buf = lds + ((n) & 1) * LY::BUF; \
            int r32 = r32_o; asm volatile("" : "+v"(r32)); \
            float qq[NC], kk[NC], gg[NC]; \
            _Pragma("unroll") for (int j = 0; j < NC; ++j) { const unsigned wq = X.rq[j >> 3][(j >> 1) & 3]; qq[j] = (j & 1) ? bfhi(wq) : bflo(wq); gg[j] = X.rg[j >> 2][j & 3]; } \
            if (LAYER == 0) { _Pragma("unroll") for (int j = 0; j < NC; ++j) { const unsigned wk = X.rk[(j >> 1) & 3]; kk[j] = (j & 1) ? bfhi(wk) : bflo(wk); qq[j] *= GLA_QSCALE; } } \
            else { _Pragma("unroll") for (int j = 0; j < NC; ++j) kk[j] = 1.0f - __expf(gg[j]); } \
            { LAS unsigned short* vt = (LAS unsigned short*)(buf + LY::VT); \
              _Pragma("unroll") for (int j = 0; j < 16; ++j) { const unsigned w = X.rv[j >> 3][(j >> 1) & 3]; vt[(vc0 + j) * (LY::TS / 2) + r32] = (unsigned short)((j & 1) ? (w >> 16) : (w & 0xffffu)); } } \
            if ((n) + 3 < NCHUNK) SCN_FETCH(X, (n) + 3); \
            u32x4 wqa[NC / 8], wka[NC / 8], wqb[NC / 8]; (void)wqa; (void)wka; (void)wqb; \
            LAS unsigned short* kdt = (LAS unsigned short*)(buf + LY::KDT); \
            LAS float* dec = (LAS float*)(buf + LY::DEC); \
            _Pragma("unroll") for (int j2 = 0; j2 < NC; j2 += 2) { \
                float oqa[2], oka[2], oqb[2]; \
                _Pragma("unroll") for (int u = 0; u < 2; ++u) { const int j = j2 + u; \
                    const float bc = prefix32(gg[j]), bref = bcast_half(bc, 15, hi), blast = bcast_half(bc, 31, hi); \
                    float kd, dcv; \
                    if (OUT) { const float E = __expf(bc - bref), Ei = __builtin_amdgcn_rcpf(E), cq = __expf(bref), ck = __expf(blast - bref); \
                        oqa[u] = qq[j] * E; oka[u] = kk[j] * Ei; oqb[u] = oqa[u] * cq; kd = oka[u] * ck; dcv = cq * ck; } \
                    else { oqa[u] = 0.f; oka[u] = 0.f; oqb[u] = 0.f; dsum[j] += blast; kd = kk[j] * __expf(blast - bc); dcv = __expf(blast); } \
                    kdt[(kc0 + j) * (LY::TS / 2) + r32] = (unsigned short)(cvtpk(kd, 0.f) & 0xffffu); \
                    if (r32 == 31) dec[kc0 + j] = dcv; } \
                if (OUT) { wqa[j2 >> 3][(j2 >> 1) & 3] = cvtpk(oqa[0], oqa[1]); wka[j2 >> 3][(j2 >> 1) & 3] = cvtpk(oka[0], oka[1]); wqb[j2 >> 3][(j2 >> 1) & 3] = cvtpk(oqb[0], oqb[1]); } } \
            if (OUT) { _Pragma("unroll") for (int q = 0; q < NC / 8; ++q) { const int off = r32 * LY::RS + (kc0 + 8 * q) * 2; \
                *(LAS u32x4*)(buf + LY::QA + off) = wqa[q]; *(LAS u32x4*)(buf + LY::KA + off) = wka[q]; *(LAS u32x4*)(buf + LY::QB + off) = wqb[q]; } } \
            SCN_BAR(); } while (0)
        float dsum[NC];
#pragma unroll
        for (int j = 0; j < NC; ++j) dsum[j] = 0.f;
        { const int r32 = r32_o; SCN_FETCH(RA, 0); SCN_FETCH(RB, 1); SCN_FETCH(RC, 2); }
        for (int n = 0; n < NCHUNK; n += 3) { SCN_STEP(RA, n); SCN_STEP(RB, n + 1); SCN_STEP(RC, n + 2); }
        SCN_BAR();
        if (!OUT && r32_o == 0) {
#pragma unroll
            for (int j = 0; j < NC; ++j) DST[(size_t)u * DK + kc0 + j] = __expf(dsum[j]);
        }
#undef SCN_FETCH
#undef SCN_STEP
    } else {
        const int w = pw;
        f32x16 S[NMB];
#pragma unroll
        for (int mb = 0; mb < NMB; ++mb) S[mb] = f32x16{};
        if (OUT) {
            for (int js = 0; js < seg; ++js) { const size_t uj = (size_t)ch * NSEG + js;
#pragma unroll
                for (int mb = 0; mb < NMB; ++mb) { const float* e = EST + uj * (DK * 128) + (size_t)((w * NMB + mb) * 16) * 64 + lane; const float* dd = DST + uj * DK + 32 * mb + 4 * hi;
#pragma unroll
                    for (int r = 0; r < 16; ++r) S[mb][r] = S[mb][r] * dd[(r & 3) + 8 * (r >> 2)] + e[r * 64]; } }
        }
        bf16* OB = (bf16*)(F.ws + (LAYER == 0 ? (d ? WS_OBB : WS_OBF) : (d ? WS_OHB : WS_OHF)));
        SCN_BAR();
        for (int n = 0; n < NCHUNK; ++n) {
            const LAS unsigned char* buf = lds + (n & 1) * LY::BUF;
            int r32 = r32_o; asm volatile("" : "+v"(r32));
            const LAS unsigned char* vtr = buf + LY::VT + (32 * w + r32) * LY::TS;
            if (OUT) {
            f32x16 at = f32x16{};
#pragma unroll
            for (int s = 0; s < DK / 16; ++s) { const int off = r32 * LY::RS + (16 * s + 8 * hi) * 2;
                at = __builtin_amdgcn_mfma_f32_32x32x16_bf16(*(const LAS bf16x8*)(buf + LY::KA + off), *(const LAS bf16x8*)(buf + LY::QA + off), at, 0, 0, 0); }
#pragma unroll
            for (int r = 0; r < 16; ++r) if (crow(r, hi) > r32) at[r] = 0.f;
            f32x16 o = f32x16{};
#pragma unroll
            for (int s = 0; s < 2; ++s) o = __builtin_amdgcn_mfma_f32_32x32x16_bf16(pack8(at, 8 * s), ld2x8(vtr + (16 * s + 4 * hi) * 2), o, 0, 0, 0);
#pragma unroll
            for (int mb = 0; mb < NMB; ++mb)
#pragma unroll
                for (int s = 0; s < 2; ++s)
                    o = __builtin_amdgcn_mfma_f32_32x32x16_bf16(ld2x8(buf + LY::QB + r32 * LY::RS + (32 * mb + 16 * s + 4 * hi) * 2), pack8(S[mb], 8 * s), o, 0, 0, 0);
            if (LAYER == 0 || c0 + n >= CTXL / 32) {
                const int row0 = scan_row(b, d, 32 * (c0 + n)), sg = d ? -1 : 1;
                bf16* ob = OB + (size_t)row0 * 512 + h * 128 + 32 * w + r32;
#pragma unroll
                for (int r = 0; r < 16; ++r) ob[(ptrdiff_t)(sg * crow(r, hi)) * 512] = (bf16)(cvtpk(o[r], 0.f) & 0xffffu);
            }
            }
#pragma unroll
            for (int mb = 0; mb < NMB; ++mb) {
                const LAS float* dc = (const LAS float*)(buf + LY::DEC) + 32 * mb + 4 * hi;
#pragma unroll
                for (int g = 0; g < 4; ++g) { const f32x4 dv = *(const LAS f32x4*)(dc + 8 * g);
                    S[mb][4 * g + 0] *= dv.x; S[mb][4 * g + 1] *= dv.y; S[mb][4 * g + 2] *= dv.z; S[mb][4 * g + 3] *= dv.w; }
#pragma unroll
                for (int s = 0; s < 2; ++s)
                    S[mb] = __builtin_amdgcn_mfma_f32_32x32x16_bf16(*(const LAS bf16x8*)(buf + LY::KDT + (32 * mb + r32) * LY::TS + (16 * s + 8 * hi) * 2),
                                                                   *(const LAS bf16x8*)(vtr + (16 * s + 8 * hi) * 2), S[mb], 0, 0, 0);
            }
            SCN_BAR();
        }
        if (!OUT) {
#pragma unroll
            for (int mb = 0; mb < NMB; ++mb) { float* e = EST + (size_t)u * (DK * 128) + (size_t)((w * NMB + mb) * 16) * 64 + lane;
#pragma unroll
                for (int r = 0; r < 16; ++r) e[r * 64] = S[mb][r]; }
        }
    }
}
}

__device__ __forceinline__ int scan_unit(int p) { return ((p & 63) << 2) | (3 - (p >> 6)); }
template <int LAYER> __device__ __forceinline__ void p_scan_pass1(Frame& F) { for (int p = blockIdx.x; p < 64 * scn::NSEG; p += F.G) { const int u = scan_unit(p); if (u % scn::NSEG == scn::NSEG - 1) continue; scn::scan_seg<LAYER, false>(F, u, F.lds); __syncthreads(); } }
template <int LAYER> __device__ __forceinline__ void p_scan_pass2(Frame& F) { for (int p = blockIdx.x; p < 64 * scn::NSEG; p += F.G) { scn::scan_seg<LAYER, true>(F, scan_unit(p), F.lds); __syncthreads(); } }
__device__ __forceinline__ void p_merge0(Frame& F) {
    const bf16* P = (const bf16*)(F.ws + WS_P); const float* OA = (const float*)(F.ws + WS_OA); const bf16* OBF = (const bf16*)(F.ws + WS_OBF); const bf16* OBB = (const bf16*)(F.ws + WS_OBB);
    bf16* A = (bf16*)(F.ws + WS_H);
    const int c = 2 * F.lane;
    for (int it = F.gw; it < MT * 8; it += F.NGW) {
        const int m = it >> 3, seg = it & 7; float o0, o1;
        if (seg < 4) { const float2 v = *(const float2*)(OA + (size_t)m * 512 + seg * 128 + c);
            const float r = rsqrtf(wave_sum(v.x * v.x + v.y * v.y) * (1.0f / 128.0f) + RMS_EPS) * (1.0f - LAM_INIT0);
            o0 = v.x * r * F.in[I_EV_SUBLN][c]; o1 = v.y * r * F.in[I_EV_SUBLN][c + 1]; }
        else { const int h = seg - 4; const unsigned a = *(const GAS unsigned*)(OBF + (size_t)m * 512 + h * 128 + c), bq = *(const GAS unsigned*)(OBB + (size_t)m * 512 + h * 128 + c);
            const float v0 = bflo(a) + bflo(bq), v1 = bfhi(a) + bfhi(bq); const float r = rsqrtf(wave_sum(v0 * v0 + v1 * v1) * (1.0f / 128.0f) + RMS_EPS);
            const unsigned gw_ = *(const GAS unsigned*)(P + (size_t)m * EV_INP + EV_GB + h * 128 + c);
            o0 = v0 * r * F.in[I_EV_GLAG][c] * siluf_(bflo(gw_)); o1 = v1 * r * F.in[I_EV_GLAG][c + 1] * siluf_(bfhi(gw_)); }
        *(GAS unsigned*)(A + (size_t)m * DM + seg * 128 + c) = pk2(o0, o1);
    }
}
__device__ __forceinline__ void p_merge1(Frame& F) {
    const bf16* P = (const bf16*)(F.ws + WS_P); const bf16* OHF = (const bf16*)(F.ws + WS_OHF); const bf16* OHB = (const bf16*)(F.ws + WS_OHB);
    bf16* A = (bf16*)(F.ws + WS_H);
    const int c = 2 * F.lane;
    for (int it = F.gw; it < ML * 4; it += F.NGW) {
        const int m = it >> 2, h = it & 3;
        const unsigned a = *(const GAS unsigned*)(OHF + (size_t)m * 512 + h * 128 + c), bq = *(const GAS unsigned*)(OHB + (size_t)m * 512 + h * 128 + c);
        const float v0 = bflo(a) + bflo(bq), v1 = bfhi(a) + bfhi(bq); const float r = rsqrtf(wave_sum(v0 * v0 + v1 * v1) * (1.0f / 128.0f) + RMS_EPS);
        const unsigned gw_ = *(const GAS unsigned*)(P + (size_t)m * OD_INP + OD_HG + h * 128 + c);
        *(GAS unsigned*)(A + (size_t)m * DM + 512 + h * 128 + c) = pk2(v0 * r * F.in[I_OD_HGG][c] * siluf_(bflo(gw_)), v1 * r * F.in[I_OD_HGG][c + 1] * siluf_(bfhi(gw_)));
    }
}

template <bool BASE_SRC, bool DO_H, bool ROUTER>
__device__ __forceinline__ void p_ln(Frame& F, int nrows, const float* base, const bf16* y, int l, int gate_chunk, int ln_slot, float* xout, int hl, int hsc, int hsh, const float* ypart = nullptr, int nsp = 0) {
    const float* MOD = (const float*)(F.ws + WS_MOD); bf16* H = (bf16*)(F.ws + WS_H);
    const float* G = F.in[I_LNG] + (size_t)(l * 2 + ln_slot) * DM; const float* Bb = F.in[I_LNB] + (size_t)(l * 2 + ln_slot) * DM;
    for (int m = F.gw; m < nrows; m += F.NGW) {
        const float* br = BASE_SRC ? src_row(F, m) : base + (size_t)m * DM; const bf16* yr = y + (size_t)m * DM;
        const float* mr = MOD + (size_t)(l * 9 + mod_row(m)) * 6144 + gate_chunk * 1024;
        f32x4 t[4]; float s = 0.f;
#pragma unroll
        for (int j = 0; j < 4; ++j) { const int c = 4 * F.lane + 256 * j; f32x4 yv;
            if (nsp && m >= ML) { yv = (f32x4){0.f, 0.f, 0.f, 0.f}; for (int sp = 0; sp < nsp; ++sp) yv = yv + *(const f32x4*)(ypart + ((size_t)sp * MC + (m - ML)) * DM + c); }
            else yv = ld_bf16x4(yr + c);
            t[j] = *(const f32x4*)(br + c) * DN_ALPHA + *(const f32x4*)(mr + c) * yv; s += (t[j].x + t[j].y) + (t[j].z + t[j].w); }
        const float mean = wave_sum(s) * (1.0f / DM); float s2 = 0.f;
#pragma unroll
        for (int j = 0; j < 4; ++j) { t[j] = t[j] - mean; s2 += (t[j].x * t[j].x + t[j].y * t[j].y) + (t[j].z * t[j].z + t[j].w * t[j].w); }
        const float rstd = rsqrtf(wave_sum(s2) * (1.0f / DM) + LN_EPS);
        float lg[8];
#pragma unroll
        for (int e = 0; e < 8; ++e) lg[e] = 0.f;
#pragma unroll
        for (int j = 0; j < 4; ++j) { const int c = 4 * F.lane + 256 * j; const f32x4 xo = t[j] * rstd * *(const f32x4*)(G + c) + *(const f32x4*)(Bb + c);
            if (xout) *(f32x4*)(xout + (size_t)m * DM + c) = xo;
            if (DO_H) { const float* hr = MOD + (size_t)(hl * 9 + mod_row(m)) * 6144; const f32x4 hv = xo * (1.0f + *(const f32x4*)(hr + hsc * 1024 + c)) + *(const f32x4*)(hr + hsh * 1024 + c);
                store_bf16x4(H + (size_t)m * DM + c, hv);
                if (ROUTER) { const float* wr = F.in[I_OD_ROUTER] + (size_t)c * 8;
#pragma unroll
                    for (int q = 0; q < 4; ++q) { const f32x4 wa = *(const f32x4*)(wr + q * 8), wb = *(const f32x4*)(wr + q * 8 + 4); const float hq = hv[q];
                        lg[0] += hq * wa.x; lg[1] += hq * wa.y; lg[2] += hq * wa.z; lg[3] += hq * wa.w; lg[4] += hq * wb.x; lg[5] += hq * wb.y; lg[6] += hq * wb.z; lg[7] += hq * wb.w; } } }
        }
        if (ROUTER) {
#pragma unroll
            for (int e = 0; e < 8; ++e) lg[e] = wave_sum(lg[e]);
            int i0 = 0; float v0 = lg[0];
#pragma unroll
            for (int e = 1; e < 8; ++e) if (lg[e] > v0) { v0 = lg[e]; i0 = e; }
            int i1 = -1; float v1 = -3.0e38f;
#pragma unroll
            for (int e = 0; e < 8; ++e) if (e != i0 && lg[e] > v1) { v1 = lg[e]; i1 = e; }
            const float g0 = 1.0f / (1.0f + __expf(v1 - v0)), g1 = 1.0f - g0;
            if (F.lane == 0) { v4u o; o.x = (unsigned)i0; o.y = (unsigned)i1; o.z = __float_as_uint(g0); o.w = __float_as_uint(g1); *(GAS v4u*)(F.ws + WS_ROUTE + (size_t)m * 16) = o; }
        }
    }
}

__device__ __forceinline__ void p_post1(Frame& F) {
    bf16* P = (bf16*)(F.ws + WS_P); bf16* NQ = (bf16*)(F.ws + WS_NQ); bf16* NKV = (bf16*)(F.ws + WS_NKV);
    const float* COS = (const float*)(F.ws + WS_COS); const float* SIN = (const float*)(F.ws + WS_SIN);
    for (int m = F.gw; m < MT; m += F.NGW) {
        bf16* pr = P + (size_t)m * OD_INP;
        if (m < ML) {
            const int c = 4 * F.lane; const unsigned long long w = *(const GAS unsigned long long*)(pr + OD_CQ + c);
            const float v0 = bflo((unsigned)w), v1 = bfhi((unsigned)w), v2 = bflo((unsigned)(w >> 32)), v3 = bfhi((unsigned)(w >> 32));
            const float r = rsqrtf(wave_sum((v0 * v0 + v1 * v1) + (v2 * v2 + v3 * v3)) * (1.0f / 256.0f) + RMS_EPS);
            const f32x4 g = *(const f32x4*)(F.in[I_OD_QNG] + c);
            store_bf16x4(NQ + (size_t)m * 256 + c, (f32x4){v0 * r * g.x, v1 * r * g.y, v2 * r * g.z, v3 * r * g.w});
        }
        { const int c = 2 * F.lane; const unsigned w = *(const GAS unsigned*)(pr + OD_CKV + c); const float v0 = bflo(w), v1 = bfhi(w);
          const float r = rsqrtf(wave_sum(v0 * v0 + v1 * v1) * (1.0f / 128.0f) + RMS_EPS);
          *(GAS unsigned*)(NKV + (size_t)m * 256 + c) = pk2(v0 * r * F.in[I_OD_KVNG][c], v1 * r * F.in[I_OD_KVNG][c + 1]);
          *(GAS unsigned*)(NKV + (size_t)m * 256 + 128 + c) = 0u; }
        {
          const float* LB = (const float*)(F.ws + WS_SCAL) + 256; float* GH = (float*)(F.ws + WS_GH);
#pragma unroll
          for (int d = 0; d < 2; ++d) { const int c = 8 * F.lane; const v4u w = *(const GAS v4u*)(pr + (d ? OD_HFB : OD_HFF) + c);
              const f32x4 l0 = *(const f32x4*)(LB + c), l1 = *(const f32x4*)(LB + c + 4); f32x4 o0, o1;
              o0.x = __logf(l0.x + (1.0f - l0.x) * sigmoidf_(bflo(w.x))); o0.y = __logf(l0.y + (1.0f - l0.y) * sigmoidf_(bfhi(w.x))); o0.z = __logf(l0.z + (1.0f - l0.z) * sigmoidf_(bflo(w.y))); o0.w = __logf(l0.w + (1.0f - l0.w) * sigmoidf_(bfhi(w.y)));
              o1.x = __logf(l1.x + (1.0f - l1.x) * sigmoidf_(bflo(w.z))); o1.y = __logf(l1.y + (1.0f - l1.y) * sigmoidf_(bfhi(w.z))); o1.z = __logf(l1.z + (1.0f - l1.z) * sigmoidf_(bflo(w.w))); o1.w = __logf(l1.w + (1.0f - l1.w) * sigmoidf_(bfhi(w.w)));
              float* go = GH + ((size_t)d * MT + m) * 512 + c; *(f32x4*)go = o0; *(f32x4*)(go + 4) = o1; } }
        if (m < ML && F.lane < 32) { const int t = m & (SEQ - 1); const float cs = COS[t * 32 + F.lane], sn = SIN[t * 32 + F.lane];
            const unsigned w = *(const GAS unsigned*)(pr + OD_KR + 2 * F.lane); const float t0 = bflo(w), t1 = bfhi(w);
            *(GAS unsigned*)(pr + OD_KR + 2 * F.lane) = pk2(t0 * cs - t1 * sn, t0 * sn + t1 * cs); }
    }
}

__device__ __forceinline__ void p_act(Frame& F, int nrows) {
    const bf16* U = (const bf16*)(F.ws + WS_U); bf16* ACT = (bf16*)(F.ws + WS_ACT);
    const size_t n8 = (size_t)nrows * (DFF / 8);
    for (size_t i = (size_t)blockIdx.x * NTHR + F.tid; i < n8; i += (size_t)F.G * NTHR) {
        const size_t m = i / (DFF / 8); const int j = (int)(i % (DFF / 8)) * 8;
        const v4u g = *(const GAS v4u*)(U + m * (2 * DFF) + j), u = *(const GAS v4u*)(U + m * (2 * DFF) + DFF + j);
        v4u o; o.x = pk2(siluf_(bflo(g.x)) * bflo(u.x), siluf_(bfhi(g.x)) * bfhi(u.x)); o.y = pk2(siluf_(bflo(g.y)) * bflo(u.y), siluf_(bfhi(g.y)) * bfhi(u.y));
        o.z = pk2(siluf_(bflo(g.z)) * bflo(u.z), siluf_(bfhi(g.z)) * bfhi(u.z)); o.w = pk2(siluf_(bflo(g.w)) * bflo(u.w), siluf_(bfhi(g.w)) * bfhi(u.w));
        *(GAS v4u*)(ACT + m * DFF + j) = o;
    }
}

struct MoeOff { int t1, t2, t3, t4, t5, t6, t7, t8; };
__device__ __forceinline__ MoeOff moe_offsets(const Frame& F) {
    const unsigned* cnt = (const unsigned*)(F.ctl + CW_CNT);
    int n[8];
#pragma unroll
    for (int e = 0; e < 8; ++e) n[e] = (int)((__builtin_amdgcn_readfirstlane((int)cnt[16 * e]) + 255) >> 8);
    MoeOff o; o.t1 = n[0]; o.t2 = o.t1 + n[1]; o.t3 = o.t2 + n[2]; o.t4 = o.t3 + n[3]; o.t5 = o.t4 + n[4]; o.t6 = o.t5 + n[5]; o.t7 = o.t6 + n[6]; o.t8 = o.t7 + n[7];
    return o;
}
__device__ __forceinline__ int moe_tile0(const MoeOff& o, int e) { return e == 0 ? 0 : e == 1 ? o.t1 : e == 2 ? o.t2 : e == 3 ? o.t3 : e == 4 ? o.t4 : e == 5 ? o.t5 : e == 6 ? o.t6 : o.t7; }

__device__ __forceinline__ void p_ln1_router(Frame& F) {
    const float* MOD = (const float*)(F.ws + WS_MOD); bf16* H = (bf16*)(F.ws + WS_H);
    const float* X2 = (const float*)(F.ws + WS_X2); const bf16* Y = (const bf16*)(F.ws + WS_YF); float* X1 = (float*)(F.ws + WS_X1);
    const float* G = F.in[I_LNG] + (size_t)(1 * 2 + 0) * DM; const float* Bb = F.in[I_LNB] + (size_t)(1 * 2 + 0) * DM;
    LAS int* sel = (LAS int*)F.lds; LAS int* base = sel + 128;
    unsigned* POS = (unsigned*)(F.ws + WS_POS);
    for (int mb = blockIdx.x * 64; mb < ML; mb += F.G * 64) {
        for (int rl = F.wave; rl < 64; rl += NWAVES) {
            const int m = mb + rl;
            const float* br = X2 + (size_t)m * DM; const bf16* yr = Y + (size_t)m * DM; const float* mr = MOD + (size_t)(1 * 9 + mod_row(m)) * 6144;
            f32x4 t[4]; float s = 0.f;
#pragma unroll
            for (int j = 0; j < 4; ++j) { const int c = 4 * F.lane + 256 * j; t[j] = *(const f32x4*)(br + c) * DN_ALPHA + *(const f32x4*)(mr + 2 * 1024 + c) * ld_bf16x4(yr + c); s += (t[j].x + t[j].y) + (t[j].z + t[j].w); }
            const float mean = wave_sum(s) * (1.0f / DM); float s2 = 0.f;
#pragma unroll
            for (int j = 0; j < 4; ++j) { t[j] = t[j] - mean; s2 += (t[j].x * t[j].x + t[j].y * t[j].y) + (t[j].z * t[j].z + t[j].w * t[j].w); }
            const float rstd = rsqrtf(wave_sum(s2) * (1.0f / DM) + LN_EPS);
            float lg[8];
#pragma unroll
            for (int e = 0; e < 8; ++e) lg[e] = 0.f;
#pragma unroll
            for (int j = 0; j < 4; ++j) { const int c = 4 * F.lane + 256 * j; const f32x4 xo = t[j] * rstd * *(const f32x4*)(G + c) + *(const f32x4*)(Bb + c);
                *(f32x4*)(X1 + (size_t)m * DM + c) = xo;
                const f32x4 hv = xo * (1.0f + *(const f32x4*)(mr + 4 * 1024 + c)) + *(const f32x4*)(mr + 3 * 1024 + c);
                store_bf16x4(H + (size_t)m * DM + c, hv);
                const float* wr = F.in[I_OD_ROUTER] + (size_t)c * 8;
#pragma unroll
                for (int q = 0; q < 4; ++q) { const f32x4 wa = *(const f32x4*)(wr + q * 8), wb = *(const f32x4*)(wr + q * 8 + 4); const float hq = hv[q];
                    lg[0] += hq * wa.x; lg[1] += hq * wa.y; lg[2] += hq * wa.z; lg[3] += hq * wa.w; lg[4] += hq * wb.x; lg[5] += hq * wb.y; lg[6] += hq * wb.z; lg[7] += hq * wb.w; } }
#pragma unroll
            for (int e = 0; e < 8; ++e) lg[e] = wave_sum(lg[e]);
            int i0 = 0; float v0 = lg[0];
#pragma unroll
            for (int e = 1; e < 8; ++e) if (lg[e] > v0) { v0 = lg[e]; i0 = e; }
            int i1 = -1; float v1 = -3.0e38f;
#pragma unroll
            for (int e = 0; e < 8; ++e) if (e != i0 && lg[e] > v1) { v1 = lg[e]; i1 = e; }
            const float g0 = 1.0f / (1.0f + __expf(v1 - v0)), g1 = 1.0f - g0;
            if (F.lane == 0) { v4u o; o.x = (unsigned)i0; o.y = (unsigned)i1; o.z = __float_as_uint(g0); o.w = __float_as_uint(g1); *(GAS v4u*)(F.ws + WS_ROUTE + (size_t)m * 16) = o;
                sel[rl * 2] = i0; sel[rl * 2 + 1] = i1; }
        }
        __syncthreads();
        if (F.tid < 8) { int c = 0; for (int i = 0; i < 128; ++i) c += (sel[i] == F.tid) ? 1 : 0;
            base[F.tid] = (int)__hip_atomic_fetch_add((unsigned*)(F.ctl + CW_CNT) + 16 * F.tid, (unsigned)c, __ATOMIC_RELAXED, __HIP_MEMORY_SCOPE_AGENT); }
        __syncthreads();
        if (F.tid < 128) { const int e = sel[F.tid]; int rank = 0; for (int i = 0; i < F.tid; ++i) rank += (sel[i] == e) ? 1 : 0; POS[(size_t)mb * 2 + F.tid] = (unsigned)(base[e] + rank); }
        __syncthreads();
    }
}
__device__ __forceinline__ void p_moe_dispatch(Frame& F) {
    const MoeOff o = moe_offsets(F);
    const bf16* H = (const bf16*)(F.ws + WS_H); bf16* HG = (bf16*)(F.ws + WS_HG); const unsigned* POS = (const unsigned*)(F.ws + WS_POS);
    for (int m = F.gw; m < ML; m += F.NGW) {
        const v4u r = *(const GAS v4u*)(F.ws + WS_ROUTE + (size_t)m * 16);
        const int s0 = moe_tile0(o, (int)r.x) * 256 + (int)POS[(size_t)m * 2], s1 = moe_tile0(o, (int)r.y) * 256 + (int)POS[(size_t)m * 2 + 1];
        const v4u a = *(const GAS v4u*)(H + (size_t)m * DM + 8 * F.lane), c = *(const GAS v4u*)(H + (size_t)m * DM + 512 + 8 * F.lane);
        *(GAS v4u*)(HG + (size_t)s0 * DM + 8 * F.lane) = a; *(GAS v4u*)(HG + (size_t)s0 * DM + 512 + 8 * F.lane) = c;
        *(GAS v4u*)(HG + (size_t)s1 * DM + 8 * F.lane) = a; *(GAS v4u*)(HG + (size_t)s1 * DM + 512 + 8 * F.lane) = c;
    }
}
template <class Epi> __device__ __forceinline__ void run_gemm_moe(Frame& F, const bf16* A, const bf16* Bt, int N, int K, size_t estride_bytes, int nsplit, const Epi& E) {
    const MoeOff o = moe_offsets(F);
    pg8::Gemm g{A, Bt, nsplit * o.t8 * 256, N, K, nsplit > 1 ? K / nsplit / 64 : 0}; pg8::GroupedOrder S; S.init(nsplit * o.t8 * 256, N, F.G, (int)blockIdx.x);
    S.t1 = o.t1; S.t2 = o.t2; S.t3 = o.t3; S.t4 = o.t4; S.t5 = o.t5; S.t6 = o.t6; S.t7 = o.t7; S.estride = estride_bytes;
    S.mt = nsplit > 1 ? o.t8 : 0; S.kbytes = (size_t)(K / nsplit) * 2;
    pg8::gemm_phase<Epi, pg8::GroupedOrder, true, true>(F.lds, g, S, E);
}
__device__ __forceinline__ void p_ln_final(Frame& F) {
    const MoeOff o = moe_offsets(F);
    const float* MOD = (const float*)(F.ws + WS_MOD); const float* X1 = (const float*)(F.ws + WS_X1); const bf16* F2 = (const bf16*)(F.ws + WS_F2); const unsigned* POS = (const unsigned*)(F.ws + WS_POS);
    const float* G = F.in[I_LNG] + (size_t)(1 * 2 + 1) * DM; const float* Bb = F.in[I_LNB] + (size_t)(1 * 2 + 1) * DM;
    const size_t half = (size_t)o.t8 * 256 * DM;
    for (int m = F.gw; m < ML; m += F.NGW) {
        const v4u r = *(const GAS v4u*)(F.ws + WS_ROUTE + (size_t)m * 16);
        const int s0 = moe_tile0(o, (int)r.x) * 256 + (int)POS[(size_t)m * 2], s1 = moe_tile0(o, (int)r.y) * 256 + (int)POS[(size_t)m * 2 + 1];
        const float g0 = __uint_as_float(r.z), g1 = __uint_as_float(r.w);
        const float* br = X1 + (size_t)m * DM; const bf16* f0 = F2 + (size_t)s0 * DM; const bf16* f1 = F2 + (size_t)s1 * DM; const float* mr = MOD + (size_t)(1 * 9 + mod_row(m)) * 6144 + 5 * 1024;
        f32x4 t[4]; float s = 0.f;
#pragma unroll
        for (int j = 0; j < 4; ++j) { const int c = 4 * F.lane + 256 * j;
            const f32x4 fv = (ld_bf16x4(f0 + c) + ld_bf16x4(f0 + half + c)) * g0 + (ld_bf16x4(f1 + c) + ld_bf16x4(f1 + half + c)) * g1;
            t[j] = *(const f32x4*)(br + c) * DN_ALPHA + *(const f32x4*)(mr + c) * fv; s += (t[j].x + t[j].y) + (t[j].z + t[j].w); }
        const float mean = wave_sum(s) * (1.0f / DM); float s2 = 0.f;
#pragma unroll
        for (int j = 0; j < 4; ++j) { t[j] = t[j] - mean; s2 += (t[j].x * t[j].x + t[j].y * t[j].y) + (t[j].z * t[j].z + t[j].w * t[j].w); }
        const float rstd = rsqrtf(wave_sum(s2) * (1.0f / DM) + LN_EPS);
#pragma unroll
        for (int j = 0; j < 4; ++j) { const int c = 4 * F.lane + 256 * j; *(f32x4*)(F.out + (size_t)m * DM + c) = t[j] * rstd * *(const f32x4*)(G + c) + *(const f32x4*)(Bb + c); }
    }
}

template <class Epi> __device__ __forceinline__ void run_gemm(Frame& F, const bf16* A, const bf16* Bt, int M, int N, int K, const Epi& E) {
    pg8::Gemm g{A, Bt, M, N, K, 0}; pg8::StaticOrder S; S.init(M, N, F.G, (int)blockIdx.x);
    pg8::gemm_phase<Epi, pg8::StaticOrder, true, true>(F.lds, g, S, E);
}
template <class Epi> __device__ __forceinline__ void run_gemm_split(Frame& F, const bf16* A, const bf16* Bt, int mt, int N, int Kpitch, int nsplit, int ksplit, const Epi& E) {
    pg8::Gemm g{A, Bt, nsplit * mt * 256, N, Kpitch, ksplit / 64}; pg8::SplitOrder S; S.init(nsplit * mt * 256, N, F.G, (int)blockIdx.x); S.mt = mt; S.kbytes = (size_t)ksplit * 2;
    pg8::gemm_phase<Epi, pg8::SplitOrder, true, true>(F.lds, g, S, E);
}

constexpr int NPHASE = 24;
struct Args { const float* in[28]; float* out; unsigned char* ws; int ph_lo, ph_hi, li, pad; };
__global__ void __launch_bounds__(NTHR, 2) fwd(Args args) {
    extern __shared__ __attribute__((aligned(16))) unsigned char lds[];
    Frame F;
    F.lds = (LAS unsigned char*)lds; F.MISC = (volatile LAS unsigned*)(F.lds + MISC_OFF);
    F.tid = threadIdx.x; F.lane = F.tid & 63; F.wave = __builtin_amdgcn_readfirstlane(F.tid >> 6);
    F.G = gridDim.x; F.gw = blockIdx.x * NWAVES + F.wave; F.NGW = F.G * NWAVES;
    F.ws = args.ws; F.ctl = (gu32*)(args.ws + WS_CTL); F.out = args.out;
#pragma unroll
    for (int i = 0; i < 28; ++i) F.in[i] = args.in[i];
    for (int u = F.tid; u < (LDS_BYTES - MISC_OFF) / 4; u += NTHR) ((LAS unsigned*)(F.lds + MISC_OFF))[u] = 0u;
    __syncthreads();
    XcdBarrier bar = xcd_barrier_post((unsigned*)(F.ctl + CW_BAR) + args.li * XCD_BAR_WORDS, F.MISC + 8);
    const int lo = args.ph_lo, hi = args.ph_hi;
#define IN(k) (lo <= (k) && (k) < hi && (frame_refresh(F), true))
#define SEAM(k) do { if (IN(k) && IN((k) + 1)) xcd_barrier(bar); } while (0)
#ifndef DUPK
#define DUPK (-1)
#endif
#define PHB(k, ...) if (IN(k)) { __VA_ARGS__; if ((k) == DUPK) { xcd_barrier(bar); __VA_ARGS__; } } SEAM(k);
    bf16* const Hb = (bf16*)(F.ws + WS_H); bf16* const Pb = (bf16*)(F.ws + WS_P); bf16* const ACTb = (bf16*)(F.ws + WS_ACT);
    float* const YF = (float*)(F.ws + WS_YF); bf16* const YB = (bf16*)(F.ws + WS_YF); float* const YP = (float*)(F.ws + WS_YPART); float* const X1 = (float*)(F.ws + WS_X1); float* const X2 = (float*)(F.ws + WS_X2);

    PHB(0, { p0_prologue(F); })
    PHB(1, { p_modulate0(F); })
    PHB(2, { pg8::EpiRope E{Pb, EV_INP, (const float*)(F.ws + WS_COS), (const float*)(F.ws + WS_SIN), 4, ML}; run_gemm(F, Hb, (const bf16*)(F.ws + WS_W_IN0), MT, EV_INP, DM, E); })
    PHB(3, { p_post0(F); })
    PHB(4, { p_scan_pass1<0>(F); p_attn0(F); })
    PHB(5, { p_scan_pass2<0>(F); })
    PHB(6, { p_merge0(F); })
    PHB(7, { { pg8::EpiBf16<0> E{YB, DM, nullptr, 0, 0, 1.f}; run_gemm(F, Hb, (const bf16*)(F.ws + WS_W_OUT0), ML, DM, DM, E); }
             { pg8::EpiF32 E{YP, DM, nullptr}; run_gemm_split(F, Hb + (size_t)ML * DM, (const bf16*)(F.ws + WS_W_OUT0), MC / 256, DM, DM, 4, 256, E); } })
    PHB(8, { p_ln<true, true, false>(F, MT, nullptr, YB, 0, 2, 0, X1, 0, 4, 3, YP, 4); })
    PHB(9, { pg8::EpiSwiGLU E{ACTb, DFF}; run_gemm(F, Hb, (const bf16*)(F.ws + WS_W_FF1), MT, 2 * DFF, DM, E); })
    PHB(10, { { pg8::EpiBf16<0> E{YB, DM, nullptr, 0, 0, 1.f}; run_gemm(F, ACTb, (const bf16*)(F.ws + WS_W_FF2), ML, DM, DFF, E); }
              { pg8::EpiF32 E{YP, DM, nullptr}; run_gemm_split(F, ACTb + (size_t)ML * DFF, (const bf16*)(F.ws + WS_W_FF2), MC / 256, DM, DFF, 7, 512, E); } })
    PHB(11, { p_ln<false, true, false>(F, MT, X1, YB, 0, 5, 1, X2, 1, 1, 0, YP, 7); })
    PHB(12, { pg8::EpiBf16<0> E{Pb, OD_INP, nullptr, 0, 0, 1.f}; run_gemm(F, Hb, (const bf16*)(F.ws + WS_W_IN1), MT, OD_INP, DM, E); })
    PHB(13, { p_post1(F); })
    PHB(14, { { pg8::EpiBf16<0> E{(bf16*)(F.ws + WS_Q), 768, nullptr, 0, 0, 1.f}; run_gemm(F, (const bf16*)(F.ws + WS_NQ), (const bf16*)(F.ws + WS_W_UQ), ML, 768, 256, E); }
              { pg8::EpiBf16<0> E{(bf16*)(F.ws + WS_KV), 1024, nullptr, 0, 0, 1.f}; run_gemm(F, (const bf16*)(F.ws + WS_NKV), (const bf16*)(F.ws + WS_W_UKV), MT, 1024, 256, E); } })
    PHB(15, { p_scan_pass1<1>(F); p_attn1(F); })
    PHB(16, { p_scan_pass2<1>(F); })
    PHB(17, { p_merge1(F); })
    PHB(18, { pg8::EpiBf16<0> E{YB, DM, nullptr, 0, 0, 1.f}; run_gemm(F, Hb, (const bf16*)(F.ws + WS_W_OUT1), ML, DM, DM, E); })
    PHB(19, { p_ln1_router(F); })
    PHB(20, { p_moe_dispatch(F); })
    PHB(21, { pg8::EpiSwiGLU E{(bf16*)(F.ws + WS_ACT2), DFF}; run_gemm_moe(F, (const bf16*)(F.ws + WS_HG), (const bf16*)(F.ws + WS_EXP_W1), 2 * DFF, DM, (size_t)2 * DFF * DM * 2, 1, E); })
    PHB(22, { pg8::EpiBf16<0> E{(bf16*)(F.ws + WS_F2), DM, nullptr, 0, 0, 1.f}; run_gemm_moe(F, (const bf16*)(F.ws + WS_ACT2), (const bf16*)(F.ws + WS_EXP_W2), DM, DFF, (size_t)DM * DFF * 2, 2, E); })
    PHB(23, { p_ln_final(F); })
#undef IN
#undef SEAM
#undef PHB
}

#ifndef MK_ONE_LAUNCH
#define MK_ONE_LAUNCH 1
#endif
extern "C" void kernel_launch(void* const* d_in, const int* in_sizes, int n_in, void* d_out, int out_size, void* d_ws, size_t ws_size, hipStream_t stream) {
    static int grid = 0;
    if (grid == 0) {
        if (n_in != 28 || in_sizes[0] != ML * DM || out_size != ML * DM || ws_size < WS_END) { fprintf(stderr, "kernel_launch: unexpected shapes (n_in %d, in0 %d, out %d, ws %zu)\n", n_in, n_in > 0 ? in_sizes[0] : -1, out_size, ws_size); grid = -1; return; }
        int dev = 0, cus = 0;
        if (hipGetDevice(&dev) != hipSuccess || hipDeviceGetAttribute(&cus, hipDeviceAttributeMultiprocessorCount, dev) != hipSuccess) { grid = -1; return; }
        if (hipFuncSetAttribute((const void*)fwd, hipFuncAttributeMaxDynamicSharedMemorySize, LDS_BYTES) != hipSuccess) { fprintf(stderr, "kernel_launch: hipFuncSetAttribute failed\n"); grid = -1; return; }
        int per_cu = 0;
        if (hipOccupancyMaxActiveBlocksPerMultiprocessor(&per_cu, (const void*)fwd, NTHR, LDS_BYTES) != hipSuccess || per_cu < 1) fprintf(stderr, "kernel_launch: occupancy query reports %d\n", per_cu);
        (void)hipGetLastError();
        grid = cus;
    }
    if (grid < 0) return;
    if (hipMemsetAsync((char*)d_ws + WS_CTL, 0, CTL_ZERO_BYTES, stream) != hipSuccess) return;
    Args a{};
    for (int i = 0; i < 28; ++i) a.in[i] = (const float*)d_in[i];
    a.out = (float*)d_out; a.ws = (unsigned char*)d_ws; a.pad = 0;
#if MK_ONE_LAUNCH
    a.ph_lo = 0; a.ph_hi = NPHASE; a.li = 0;
    hipLaunchKernelGGL(fwd, dim3(grid), dim3(NTHR), LDS_BYTES, stream, a);
#else
    for (int p = 0; p < NPHASE; ++p) { a.ph_lo = p; a.ph_hi = p + 1; a.li = p; hipLaunchKernelGGL(fwd, dim3(grid), dim3(NTHR), LDS_BYTES, stream, a); }
#endif
    const hipError_t le = hipPeekAtLastError();
    if (le != hipSuccess) fprintf(stderr, "kernel_launch: launch failed: %s\n", hipGetErrorName(le));
}
```

```cpp
#include <hip/hip_runtime.h>
#include <cstdio>
#include <cstdint>
#define DUPK -1
namespace pg8 {
#define PG8_LAS __attribute__((address_space(3)))
typedef unsigned short bf16_t;
typedef short bf16x8 __attribute__((ext_vector_type(8)));
typedef float f32x4 __attribute__((ext_vector_type(4)));
typedef unsigned u32x4 __attribute__((ext_vector_type(4)));
constexpr int BM = 256, BK = 64, HALF = 128, HTB = HALF * BK * 2  , STAGE_BYTES = 8 * HTB, NXCD = 8, WGM = 4;

__host__ __device__ __forceinline__ int lds_byte(int r, int c) { const int st = (r >> 4) * 2 + (c >> 5), rr = r & 15, cc = c & 31, ob = rr * 64 + cc * 2; return st * 1024 + (ob ^ (((ob >> 9) & 1) << 5)); }
__host__ __device__ __forceinline__ void stage_rc(int b, int& R, int& C) { const int st = b / 1024, sb = b % 1024, swz = sb ^ (((sb >> 9) & 1) << 5); R = (st >> 1) * 16 + swz / 64; C = (st & 1) * 32 + (swz % 64) / 2; }
__host__ __device__ __forceinline__ int perm32(int rho) { const int n = rho >> 4, i = rho & 15; return 8 * (i >> 2) + 4 * n + (i & 3); }

struct Unit { int pm, pn; };
struct Gemm { const bf16_t* A; const bf16_t* Bt; int M, N, K; int kt; };

struct StaticOrder {
    int nM, nN, nwg, G, c;
    __host__ __device__ void init(int M, int N, int G_, int c_) { nM = M / BM; nN = N / BM; nwg = nM * nN; G = G_; c = c_; }
    __host__ __device__ bool next(int i, Unit& u) const {
        const long L = (long)i * G + c; if (L >= nwg) return false;
        int wgid = (int)L; { const int q = nwg / NXCD, r = nwg % NXCD, xcd = wgid % NXCD, off = wgid / NXCD; wgid = (xcd < r ? xcd * (q + 1) : r * (q + 1) + (xcd - r) * q) + off; }
        const int nig = WGM * nN, gid = wgid / nig, fm = gid * WGM, gsz = (nM - fm) < WGM ? (nM - fm) : WGM;
        u.pm = fm + ((wgid % nig) % gsz); u.pn = (wgid % nig) / gsz; return true;
    }
    __device__ __forceinline__ void a_ready(const Unit&) const {}
    __device__ __forceinline__ void done(const Unit&) const {}
    __device__ __forceinline__ const char* bptr(const char* Bt, const Unit& u, size_t tstep) const { return Bt + (size_t)u.pn * tstep; }
    __device__ __forceinline__ const char* aptr(const char* A, const Unit& u, size_t tstep) const { return A + (size_t)u.pm * tstep; }
};
struct SplitOrder : StaticOrder {
    int mt; size_t kbytes;
    __device__ __forceinline__ const char* aptr(const char* A, const Unit& u, size_t tstep) const { return A + (size_t)(u.pm % mt) * tstep + (size_t)(u.pm / mt) * kbytes; }
    __device__ __forceinline__ const char* bptr(const char* Bt, const Unit& u, size_t tstep) const { return Bt + (size_t)u.pn * tstep + (size_t)(u.pm / mt) * kbytes; }
};
struct GroupedOrder : StaticOrder {
    int t1, t2, t3, t4, t5, t6, t7; size_t estride;
    int mt; size_t kbytes;
    __device__ __forceinline__ const char* aptr(const char* A, const Unit& u, size_t tstep) const { return mt ? A + (size_t)(u.pm % mt) * tstep + (size_t)(u.pm / mt) * kbytes : A + (size_t)u.pm * tstep; }
    __device__ __forceinline__ const char* bptr(const char* Bt, const Unit& u, size_t tstep) const {
        const int pm = mt ? u.pm % mt : u.pm; const size_t ko = mt ? (size_t)(u.pm / mt) * kbytes : 0;
        const int e = (pm >= t1) + (pm >= t2) + (pm >= t3) + (pm >= t4) + (pm >= t5) + (pm >= t6) + (pm >= t7);
        return Bt + (size_t)e * estride + (size_t)u.pn * tstep + ko; }
};


__device__ __forceinline__ unsigned cvt_pk_bf16(float lo, float hi) { unsigned r; asm volatile("v_cvt_pk_bf16_f32 %0, %1, %2" : "=v"(r) : "v"(lo), "v"(hi)); return r; }
typedef float f32x2 __attribute__((ext_vector_type(2)));
__device__ __forceinline__ f32x2 gelu_pk(f32x2 v) {
    const f32x2 av = __builtin_elementwise_abs(v), d = av * 0.2316418882f + 1.0f;
    f32x2 t; t.x = __builtin_amdgcn_rcpf(d.x); t.y = __builtin_amdgcn_rcpf(d.y);
    f32x2 q = t * 0.5307027145f + (-0.7265760135f); q = q * t + 0.7107068705f; q = q * t + (-0.142248368f); q = q * t + 0.127414796f; q = q * t;
    const f32x2 s = (v * v) * (-0.72134752044f);
    f32x2 e; e.x = __builtin_amdgcn_exp2f(s.x); e.y = __builtin_amdgcn_exp2f(s.y);
    const f32x2 m = v * (q * e), r = v - m;
    f32x2 o; o.x = v.x < 0.f ? m.x : r.x; o.y = v.y < 0.f ? m.y : r.y; return o;
}

template <int ACT  > struct EpiBf16 {
    static constexpr bool PERM = true, AFTER_DRAIN = false; static_assert(ACT == 0 || ACT == 1, "EpiBf16: ACT is 0 (none) or 1 (gelu_pk)");
    bf16_t* O; int ldc; const float* bias; int split_cols; size_t split_stride; float scale0;
    __device__ __forceinline__ void operator()(const f32x4 (&acc)[2][2][4][2], const Unit& u, int wr, int wc, int fr, int fq) const {
        const int row0 = u.pm * BM + wr * 64 + fr; int colt = u.pn * BM; bf16_t* base = O;
        float sc = 1.f; if (split_cols) { const int t = colt / split_cols; base += (size_t)t * split_stride; colt -= t * split_cols; if (t == 0) sc = scale0; }
        const int col0 = colt + wc * 32 + 8 * fq, bcol0 = u.pn * BM + wc * 32 + 8 * fq;
        f32x4 bv[2][2];
#pragma unroll
        for (int bj = 0; bj < 2; ++bj)
#pragma unroll
            for (int n = 0; n < 2; ++n) bv[bj][n] = bias ? *(const f32x4*)(bias + bcol0 + bj * HALF + 4 * n) : (f32x4){0.f, 0.f, 0.f, 0.f};
#pragma unroll
        for (int ai = 0; ai < 2; ++ai)
#pragma unroll
            for (int m = 0; m < 4; ++m) { bf16_t* rowp = base + (size_t)(row0 + ai * HALF + m * 16) * ldc + col0;
#pragma unroll
                for (int bj = 0; bj < 2; ++bj) { f32x4 v0 = acc[ai][bj][m][0] + bv[bj][0], v1 = acc[ai][bj][m][1] + bv[bj][1];
                    if (ACT == 1) { f32x2 a = gelu_pk((f32x2){v0[0], v0[1]}), b = gelu_pk((f32x2){v0[2], v0[3]}), c = gelu_pk((f32x2){v1[0], v1[1]}), d = gelu_pk((f32x2){v1[2], v1[3]});
                        v0 = (f32x4){a.x, a.y, b.x, b.y}; v1 = (f32x4){c.x, c.y, d.x, d.y}; }
                    v0 = v0 * sc; v1 = v1 * sc; u32x4 w; w.x = cvt_pk_bf16(v0[0], v0[1]); w.y = cvt_pk_bf16(v0[2], v0[3]); w.z = cvt_pk_bf16(v1[0], v1[1]); w.w = cvt_pk_bf16(v1[2], v1[3]);
                    *(u32x4*)(rowp + bj * HALF) = w; } }
    }
};
struct EpiF32 {
    static constexpr bool PERM = false, AFTER_DRAIN = false;
    float* C; int ldc; const float* bias;
    __device__ __forceinline__ void operator()(const f32x4 (&acc)[2][2][4][2], const Unit& u, int wr, int wc, int fr, int fq) const {
        const int row0 = u.pm * BM + wr * 64 + fr, col0 = u.pn * BM + wc * 32 + 4 * fq;
        f32x4 bv[2][2];
#pragma unroll
        for (int bj = 0; bj < 2; ++bj)
#pragma unroll
            for (int n = 0; n < 2; ++n) bv[bj][n] = bias ? *(const f32x4*)(bias + col0 + bj * HALF + n * 16) : (f32x4){0.f, 0.f, 0.f, 0.f};
#pragma unroll
        for (int ai = 0; ai < 2; ++ai)
#pragma unroll
            for (int m = 0; m < 4; ++m) { float* rowp = C + (size_t)(row0 + ai * HALF + m * 16) * ldc + col0;
#pragma unroll
                for (int bj = 0; bj < 2; ++bj)
#pragma unroll
                    for (int n = 0; n < 2; ++n) *(f32x4*)(rowp + bj * HALF + n * 16) = acc[ai][bj][m][n] + bv[bj][n]; }
    }
};
struct EpiSwiGLU {
    static constexpr bool PERM = true, AFTER_DRAIN = false;
    bf16_t* O; int ldc;
    __device__ __forceinline__ void operator()(const f32x4 (&acc)[2][2][4][2], const Unit& u, int wr, int wc, int fr, int fq) const {
        const int row0 = u.pm * BM + wr * 64 + fr, col0 = u.pn * HALF + wc * 32 + 8 * fq;
#pragma unroll
        for (int ai = 0; ai < 2; ++ai)
#pragma unroll
            for (int m = 0; m < 4; ++m) { bf16_t* rowp = O + (size_t)(row0 + ai * HALF + m * 16) * ldc + col0;
                f32x4 v0, v1;
#pragma unroll
                for (int i = 0; i < 4; ++i) { const float g0 = acc[ai][0][m][0][i], g1 = acc[ai][0][m][1][i];
                    v0[i] = g0 * __builtin_amdgcn_rcpf(1.0f + __builtin_amdgcn_exp2f(-1.4426950408889634f * g0)) * acc[ai][1][m][0][i]; v1[i] = g1 * __builtin_amdgcn_rcpf(1.0f + __builtin_amdgcn_exp2f(-1.4426950408889634f * g1)) * acc[ai][1][m][1][i]; }
                u32x4 w; w.x = cvt_pk_bf16(v0[0], v0[1]); w.y = cvt_pk_bf16(v0[2], v0[3]); w.z = cvt_pk_bf16(v1[0], v1[1]); w.w = cvt_pk_bf16(v1[2], v1[3]);
                *(u32x4*)rowp = w; }
    }
};

struct EpiRope {
    static constexpr bool PERM = true, AFTER_DRAIN = false;
    bf16_t* O; int ldc; const float* cs; const float* sn; int rope_tiles, rope_rows;
    __device__ __forceinline__ void operator()(const f32x4 (&acc)[2][2][4][2], const Unit& u, int wr, int wc, int fr, int fq) const {
        const int row0 = u.pm * BM + wr * 64 + fr, col0 = u.pn * BM + wc * 32 + 8 * fq;
        const bool rot = u.pn < rope_tiles && u.pm * BM < rope_rows;
        const int i0 = 16 * (wc & 1) + 4 * fq;
#pragma unroll
        for (int ai = 0; ai < 2; ++ai)
#pragma unroll
            for (int m = 0; m < 4; ++m) { const int row = row0 + ai * HALF + m * 16; bf16_t* rowp = O + (size_t)row * ldc + col0;
                f32x4 c4 = {1.f, 1.f, 1.f, 1.f}, s4 = {0.f, 0.f, 0.f, 0.f};
                if (rot) { const int t = row & 2047; c4 = *(const f32x4*)(cs + t * 32 + i0); s4 = *(const f32x4*)(sn + t * 32 + i0); }
#pragma unroll
                for (int bj = 0; bj < 2; ++bj) { const f32x4 v0 = acc[ai][bj][m][0], v1 = acc[ai][bj][m][1];
                    u32x4 w; w.x = cvt_pk_bf16(v0[0] * c4[0] - v0[1] * s4[0], v0[0] * s4[0] + v0[1] * c4[0]); w.y = cvt_pk_bf16(v0[2] * c4[1] - v0[3] * s4[1], v0[2] * s4[1] + v0[3] * c4[1]);
                    w.z = cvt_pk_bf16(v1[0] * c4[2] - v1[1] * s4[2], v1[0] * s4[2] + v1[1] * c4[2]); w.w = cvt_pk_bf16(v1[2] * c4[3] - v1[3] * s4[3], v1[2] * s4[3] + v1[3] * c4[3]);
                    *(u32x4*)(rowp + bj * HALF) = w; } }
    }
};
template <class Epi, class Sched, bool ALIGN_EPI = false, bool SP2 = false>
__device__ __forceinline__ void gemm_phase(PG8_LAS unsigned char* lds, const Gemm g, const Sched& S, const Epi& E) {
    int tid_ = threadIdx.x; asm volatile("" : "+v"(tid_));
    const int tid = tid_, wid = __builtin_amdgcn_readfirstlane(tid >> 6), lane = tid & 63, wr = wid >> 2, wc = wid & 3, fr = lane & 15, fq = lane >> 4;
    const int K = g.K, nt = g.kt ? g.kt : K / BK;
    unsigned voffA[2], voffB[2];
#pragma unroll
    for (int i = 0; i < 2; ++i) { int R, C; stage_rc(tid * 16 + i * 8192, R, C); const int Rb = Epi::PERM ? ((R & ~31) + perm32(R & 31)) : R;
        voffA[i] = (unsigned)(R * K + C) * 2u; voffB[i] = (unsigned)(Rb * K + C) * 2u; }
    const size_t kstep = (size_t)(BK * 2);
    const size_t hstep = (size_t)HALF * K * 2;
    const size_t tstep = 2 * hstep;
    const unsigned ldsw = (unsigned)wid * 1024u;
    const int aoff = lds_byte(wr * 64 + fr, fq * 8), boff = lds_byte(wc * 32 + fr, fq * 8);
#define PG8_SA(b, h) (((b) * 2 + (h)) * HTB)
#define PG8_SB(b, h) ((4 + (b) * 2 + (h)) * HTB)
#define PG8_STAGE(bufoff, gbase, voff) do { _Pragma("unroll") for (int _i = 0; _i < 2; ++_i) \
        __builtin_amdgcn_global_load_lds((const unsigned*)((const char*)(gbase) + (voff)[_i]), (PG8_LAS unsigned*)(lds + (bufoff) + ldsw + _i * 8192), 16, 0, 0); } while (0)
#define PG8_LDA(dst, b, h) do { _Pragma("unroll") for (int m = 0; m < 4; ++m) _Pragma("unroll") for (int k = 0; k < 2; ++k) dst[m][k] = *(const PG8_LAS bf16x8*)(lds + PG8_SA(b, h) + aoff + m * 2048 + k * 1024); } while (0)
#define PG8_LDB(dst, b, h) do { _Pragma("unroll") for (int n = 0; n < 2; ++n) _Pragma("unroll") for (int k = 0; k < 2; ++k) dst[n][k] = *(const PG8_LAS bf16x8*)(lds + PG8_SB(b, h) + boff + n * 2048 + k * 1024); } while (0)
#define PG8_MMA(ai, bj, At, Bt) do { __builtin_amdgcn_s_setprio(1); _Pragma("unroll") for (int m = 0; m < 4; ++m) _Pragma("unroll") for (int n = 0; n < 2; ++n) _Pragma("unroll") for (int k = 0; k < 2; ++k) \
        acc[ai][bj][m][n] = __builtin_amdgcn_mfma_f32_16x16x32_bf16(Bt[n][k], At[m][k], acc[ai][bj][m][n], 0, 0, 0); __builtin_amdgcn_s_setprio(0); } while (0)
#define PG8_WAIT_V(n) asm volatile("s_waitcnt vmcnt(" #n ")" ::: "memory")
#define PG8_WAIT_L(n) asm volatile("s_waitcnt lgkmcnt(" #n ")" ::: "memory")
#define PG8_BAR __builtin_amdgcn_s_barrier()
#define PG8_SCHED __builtin_amdgcn_sched_barrier(0)
    Unit cur, nxt; int ui = 0;
    if (!S.next(0, cur)) return;
    f32x4 acc[2][2][4][2];
#pragma unroll
    for (int a = 0; a < 2; ++a)
#pragma unroll
        for (int b = 0; b < 2; ++b)
#pragma unroll
            for (int m = 0; m < 4; ++m)
#pragma unroll
                for (int n = 0; n < 2; ++n) acc[a][b][m][n] = (f32x4){0.f, 0.f, 0.f, 0.f};
    bf16x8 At[4][2], B0[2][2], B1[2][2];
    const char* cA = S.aptr((const char*)g.A, cur, tstep); const char* cB = S.bptr((const char*)g.Bt, cur, tstep);
    S.a_ready(cur);
    if constexpr (SP2) {
        PG8_STAGE(PG8_SB(0, 0), cB, voffB); PG8_STAGE(PG8_SB(0, 1), cB + hstep, voffB); PG8_STAGE(PG8_SA(0, 0), cA, voffA); PG8_STAGE(PG8_SA(0, 1), cA + hstep, voffA);
        if (wr == 1) PG8_BAR;
        PG8_WAIT_V(2); PG8_BAR;
        PG8_STAGE(PG8_SB(1, 0), cB + kstep, voffB); PG8_STAGE(PG8_SA(1, 0), cA + kstep, voffA); PG8_STAGE(PG8_SB(1, 1), cB + hstep + kstep, voffB);
        PG8_WAIT_V(6); PG8_BAR;
    } else {
        PG8_STAGE(PG8_SB(0, 0), cB, voffB); PG8_STAGE(PG8_SA(0, 0), cA, voffA); PG8_STAGE(PG8_SB(0, 1), cB + hstep, voffB); PG8_STAGE(PG8_SA(0, 1), cA + hstep, voffA);
        if (wr == 1) PG8_BAR;
        PG8_WAIT_V(4); PG8_BAR;
        PG8_STAGE(PG8_SB(1, 0), cB + kstep, voffB); PG8_STAGE(PG8_SA(1, 0), cA + kstep, voffA); PG8_STAGE(PG8_SB(1, 1), cB + hstep + kstep, voffB);
        PG8_WAIT_V(6); PG8_BAR;
    }
    for (;;) {
        const bool has_next = S.next(ui + 1, nxt);
        const char* nA = has_next ? S.aptr((const char*)g.A, nxt, tstep) : cA; const char* nB = has_next ? S.bptr((const char*)g.Bt, nxt, tstep) : cB;
        for (int t = 0; t < nt; t += 2) {
            const bool last = (t == nt - 2);
            const char* a1 = cA + (size_t)(t + 1) * kstep;
            const char* a2 = last ? nA : cA + (size_t)(t + 2) * kstep; const char* b2 = last ? nB : cB + (size_t)(t + 2) * kstep;
            const char* a3 = a2 + kstep; const char* b3 = b2 + kstep;
            if (last && has_next) S.a_ready(nxt);
            if constexpr (SP2) {
            PG8_LDB(B0, 0, 0); PG8_LDB(B1, 0, 1); PG8_SCHED; PG8_LDA(At, 0, 0); PG8_STAGE(PG8_SA(1, 1), a1 + hstep, voffA);
            PG8_WAIT_V(8); PG8_WAIT_L(0); PG8_BAR; PG8_MMA(0, 0, At, B0); PG8_MMA(0, 1, At, B1); PG8_BAR; PG8_SCHED;
            PG8_LDA(At, 0, 1); PG8_STAGE(PG8_SB(0, 0), b2, voffB); PG8_STAGE(PG8_SB(0, 1), b2 + hstep, voffB); PG8_STAGE(PG8_SA(0, 0), a2, voffA);
            PG8_WAIT_V(8); PG8_WAIT_L(0); PG8_BAR; PG8_MMA(1, 0, At, B0); PG8_MMA(1, 1, At, B1); PG8_BAR; PG8_SCHED;
            PG8_LDB(B0, 1, 0); PG8_LDB(B1, 1, 1); PG8_SCHED; PG8_LDA(At, 1, 0); PG8_STAGE(PG8_SA(0, 1), a2 + hstep, voffA);
            PG8_WAIT_V(8); PG8_WAIT_L(0); PG8_BAR; PG8_MMA(0, 0, At, B0); PG8_MMA(0, 1, At, B1); PG8_BAR; PG8_SCHED;
            PG8_LDA(At, 1, 1); PG8_STAGE(PG8_SB(1, 0), b3, voffB); PG8_STAGE(PG8_SB(1, 1), b3 + hstep, voffB); PG8_STAGE(PG8_SA(1, 0), a3, voffA);
            PG8_WAIT_V(8); PG8_WAIT_L(0); PG8_BAR; PG8_MMA(1, 0, At, B0); PG8_MMA(1, 1, At, B1); PG8_BAR; PG8_SCHED;
            } else {
            PG8_LDB(B0, 0, 0); PG8_SCHED; PG8_LDA(At, 0, 0); PG8_STAGE(PG8_SA(1, 1), a1 + hstep, voffA);
            PG8_WAIT_L(8); PG8_BAR; PG8_WAIT_L(0); PG8_MMA(0, 0, At, B0); PG8_BAR; PG8_SCHED;
            PG8_LDB(B1, 0, 1); PG8_STAGE(PG8_SB(0, 0), b2, voffB);
            PG8_BAR; PG8_WAIT_L(0); PG8_MMA(0, 1, At, B1); PG8_BAR;
            PG8_LDA(At, 0, 1); PG8_STAGE(PG8_SA(0, 0), a2, voffA);
            PG8_BAR; PG8_WAIT_L(0); PG8_MMA(1, 0, At, B0); PG8_BAR; PG8_SCHED;
            PG8_STAGE(PG8_SB(0, 1), b2 + hstep, voffB);
            PG8_WAIT_V(6); PG8_BAR; PG8_MMA(1, 1, At, B1); PG8_BAR;
            PG8_LDB(B0, 1, 0); PG8_SCHED; PG8_LDA(At, 1, 0); PG8_STAGE(PG8_SA(0, 1), a2 + hstep, voffA);
            PG8_WAIT_L(8); PG8_BAR; PG8_WAIT_L(0); PG8_MMA(0, 0, At, B0); PG8_BAR; PG8_SCHED;
            PG8_LDB(B1, 1, 1); PG8_STAGE(PG8_SB(1, 0), b3, voffB);
            PG8_BAR; PG8_WAIT_L(0); PG8_MMA(0, 1, At, B1); PG8_BAR;
            PG8_LDA(At, 1, 1); PG8_STAGE(PG8_SA(1, 0), a3, voffA);
            PG8_BAR; PG8_WAIT_L(0); PG8_MMA(1, 0, At, B0); PG8_BAR; PG8_SCHED;
            PG8_STAGE(PG8_SB(1, 1), b3 + hstep, voffB);
            PG8_WAIT_V(6); PG8_BAR; PG8_MMA(1, 1, At, B1); PG8_BAR;
            }
        }
        if constexpr (ALIGN_EPI) { if (wr == 0) PG8_BAR; }
        if constexpr (!Epi::AFTER_DRAIN) { E(acc, cur, wr, wc, fr, fq); S.done(cur); }
        if (!has_next) break;
#pragma unroll
        for (int a = 0; a < 2; ++a)
#pragma unroll
            for (int b = 0; b < 2; ++b)
#pragma unroll
                for (int m = 0; m < 4; ++m)
#pragma unroll
                    for (int n = 0; n < 2; ++n) acc[a][b][m][n] = (f32x4){0.f, 0.f, 0.f, 0.f};
        cur = nxt; cA = nA; cB = nB; ++ui;
        if constexpr (ALIGN_EPI) { if (wr == 1) PG8_BAR; }
    }
    PG8_WAIT_V(0);
    if constexpr (!ALIGN_EPI) { if (wr == 0) PG8_BAR; }
    PG8_BAR;
    if constexpr (Epi::AFTER_DRAIN) { E.fused(acc, cur, wr, wc, fr, fq, lds, wid, lane); S.done(cur); }
#undef PG8_SA
#undef PG8_SB
#undef PG8_STAGE
#undef PG8_LDA
#undef PG8_LDB
#undef PG8_MMA
#undef PG8_WAIT_V
#undef PG8_WAIT_L
#undef PG8_BAR
#undef PG8_SCHED
}
}
#define GAS __attribute__((address_space(1)))
#define LAS __attribute__((address_space(3)))
typedef unsigned short bf16;
typedef unsigned v4u __attribute__((ext_vector_type(4)));
typedef float f32x4 __attribute__((ext_vector_type(4)));
typedef short bf16x8 __attribute__((ext_vector_type(8)));
typedef GAS unsigned gu32;
typedef GAS unsigned long long gu64;
#define RLX_AGENT __ATOMIC_RELAXED, __HIP_MEMORY_SCOPE_AGENT
#define LDS_WAIT() asm volatile("s_waitcnt lgkmcnt(0)" ::: "memory")
#define VM_WAIT() asm volatile("s_waitcnt vmcnt(0)" ::: "memory")
__device__ __forceinline__ unsigned long long rt() { return __builtin_amdgcn_s_memrealtime(); }
__device__ __forceinline__ unsigned f2bf(float f) { unsigned u = __builtin_bit_cast(unsigned, f); return (u + 0x7fffu + ((u >> 16) & 1u)) >> 16; }
__device__ __forceinline__ unsigned pk2(float lo, float hi) { return f2bf(lo) | (f2bf(hi) << 16); }

#define XB_TMO      128
#define XB_XCNT(j)  (256  + 64 * (j))
#define XB_XSUB(j)  (1280 + 64 * (j))
#define XB_XGEN(j)  (2304 + 64 * (j))
#define XB_TOP      3328
#define XB_TOPGEN   3392
#define XCD_BAR_WORDS 3456
#define XB_SPIN_CAP (1u << 22)

__device__ __forceinline__ unsigned xb_ld(unsigned* p)              { return __hip_atomic_load(p, __ATOMIC_RELAXED, __HIP_MEMORY_SCOPE_AGENT); }
__device__ __forceinline__ unsigned xb_add(unsigned* p, unsigned v) { return __hip_atomic_fetch_add(p, v, __ATOMIC_RELAXED, __HIP_MEMORY_SCOPE_AGENT); }
__device__ __forceinline__ unsigned xb_xcc_id() { return (unsigned)__builtin_amdgcn_s_getreg((3 << 11) | 20) & 0xFu; }
#define XB_SPIN(cond, bar) do { unsigned _sp = 0; while (cond) { __builtin_amdgcn_s_sleep(1); \
    if ((++_sp & 255u) == 0u) { if (xb_ld(&(bar)[XB_TMO])) break; if (_sp > XB_SPIN_CAP) { atomicAdd(&(bar)[XB_TMO], 1u); break; } } } } while (0)

struct XcdBarrier {
    unsigned* bar; unsigned x;
    volatile LAS unsigned* st;
};

__device__ __forceinline__ XcdBarrier xcd_barrier_post(unsigned* bar, volatile LAS unsigned* st) {
    XcdBarrier b; b.bar = bar; b.x = xb_xcc_id(); b.st = st;
    if (threadIdx.x == 0) (void)xb_add(&bar[XB_XCNT(b.x)], 1u);
    return b;
}
__device__ __forceinline__ void xcd_barrier_complete(unsigned* bar, unsigned x, unsigned& nloc, unsigned& nx) {
    const unsigned G = gridDim.x * gridDim.y * gridDim.z;
    unsigned sum, cnt, mine, sp = 0u;
    for (;;) {
        sum = 0u; cnt = 0u; mine = 0u;
#pragma unroll
        for (unsigned j = 0; j < 16; ++j) { const unsigned c = xb_ld(&bar[XB_XCNT(j)]); sum += c; cnt += (c > 0u) ? 1u : 0u; mine = (j == x) ? c : mine; }
        if (sum == G) break;
        __builtin_amdgcn_s_sleep(1);
        if ((++sp & 255u) == 0u) { if (xb_ld(&bar[XB_TMO])) break; if (sp > XB_SPIN_CAP) { atomicAdd(&bar[XB_TMO], 1u); break; } }
    }
    nloc = mine > 0u ? mine : 1u; nx = cnt > 0u ? cnt : 1u;
}

__device__ __forceinline__ void xcd_barrier(const XcdBarrier& b) {
    asm volatile("s_waitcnt vmcnt(0)" ::: "memory");
    __syncthreads();
    if (threadIdx.x == 0) {
        unsigned* bar = b.bar;
        __builtin_amdgcn_s_waitcnt(0);
        unsigned nloc = b.st[0], nx = b.st[1];
        if (nloc == 0u) { xcd_barrier_complete(bar, b.x, nloc, nx); b.st[0] = nloc; b.st[1] = nx; }
        const unsigned old = xb_add(&bar[XB_XSUB(b.x)], 1u);
        const unsigned gen = old / nloc;
        if (old + 1u == (gen + 1u) * nloc) {
            __builtin_amdgcn_fence(__ATOMIC_RELEASE, "agent");
            asm volatile("s_waitcnt vmcnt(0)" ::: "memory");
            const unsigned og = xb_add(&bar[XB_TOP], 1u);
            const unsigned tg = og / nx;
            if (og + 1u == (tg + 1u) * nx) xb_add(&bar[XB_TOPGEN], 1u);
            else XB_SPIN(xb_ld(&bar[XB_TOPGEN]) == tg, bar);
            __builtin_amdgcn_fence(__ATOMIC_ACQUIRE, "agent");
            xb_add(&bar[XB_XGEN(b.x)], 1u);
            asm volatile("s_waitcnt vmcnt(0)" ::: "memory");
        } else {
            XB_SPIN(xb_ld(&bar[XB_XGEN(b.x)]) == gen, bar);
            __builtin_amdgcn_fence(__ATOMIC_ACQUIRE, "agent");
            asm volatile("s_waitcnt vmcnt(0)" ::: "memory");
        }
    }
    __syncthreads();
}

constexpr int NWAVES = 8, NTHR = 512;
constexpr int NB = 8, SEQ = 2048, DM = 1024, CTXL = 256;
constexpr int ML = NB * SEQ, MC = NB * CTXL, MT = ML + MC;
constexpr int EV_IN = 3104, EV_INP = 3328, OD_IN = 3008, OD_INP = 3072, DFF = 3584, NEXP = 8;
constexpr int EV_QA = 0, EV_KA = 512, EV_VA = 1024, EV_QB = 1536, EV_KB = 1792, EV_VB = 2048, EV_GB = 2560, EV_LRF = 3072, EV_LRB = 3088;
constexpr int OD_CQ = 0, OD_CKV = 256, OD_KR = 384, OD_HQ = 448, OD_HFF = 960, OD_HFB = 1472, OD_HI = 1984, OD_HG = 2496;
constexpr float LN_EPS = 1e-5f, RMS_EPS = 1e-6f, DN_ALPHA = 1.41421356237f, LAM_INIT0 = 0.2f;
constexpr float DA_SCALE = 0.125f, GLA_QSCALE = 0.125f, MLA_SCALE = 0.07216878364870322f;

constexpr size_t MiB = 1u << 20;
constexpr size_t WS_CTL = 0, CTL_ZERO_BYTES = 1 * MiB;
constexpr size_t WS_MOD = 1 * MiB;
constexpr size_t WS_COS = 2 * MiB, WS_SIN = 2 * MiB + 262144;
constexpr size_t WS_SCAL = 2 * MiB + 524288;
constexpr size_t WS_ROUTE = 3 * MiB;
constexpr size_t WS_W_IN0 = 8 * MiB, WS_W_OUT0 = 15 * MiB, WS_W_FF1 = 17 * MiB, WS_W_FF2 = 31 * MiB, WS_W_IN1 = 38 * MiB, WS_W_UQ = 44 * MiB, WS_W_UKV = 45 * MiB, WS_W_OUT1 = 46 * MiB;
constexpr size_t WS_EXP_W1 = 48 * MiB, WS_EXP_W2 = 160 * MiB;
constexpr size_t WS_H = 216 * MiB, WS_X1 = 252 * MiB, WS_X2 = 324 * MiB, WS_BIG = 396 * MiB, WS_ACT = 648 * MiB, WS_YF = 774 * MiB, WS_SPARE = 846 * MiB, WS_END = 864 * MiB;
constexpr size_t WS_P = WS_BIG, WS_U = WS_BIG;
constexpr size_t WS_GK = WS_ACT, WS_OA = WS_ACT + 36 * MiB, WS_OBF = WS_ACT + 72 * MiB, WS_OBB = WS_YF;
constexpr size_t WS_Q = WS_ACT, WS_KV = WS_ACT + 24 * MiB, WS_OM = WS_ACT + 60 * MiB, WS_OHF = WS_ACT + 92 * MiB, WS_OHB = WS_YF, WS_NQ = WS_SPARE, WS_NKV = WS_SPARE + 8 * MiB;
constexpr size_t WS_FSUM = WS_X2;
constexpr size_t WS_YPART = WS_BIG;
constexpr size_t WS_SCAN_E = WS_YF + 40 * MiB, WS_SCAN_D = WS_YF + 60 * MiB;
constexpr size_t WS_GH = WS_BIG + 112 * MiB;
constexpr size_t WS_POS = WS_ROUTE + 262144;
constexpr int MOE_MAXROWS = 2 * ML + NEXP * 256;
constexpr size_t WS_HG = WS_ACT;
constexpr size_t WS_ACT2 = WS_BIG;
constexpr size_t WS_F2 = WS_ACT;
static_assert(WS_ACT2 + (size_t)MOE_MAXROWS * DFF * 2 <= WS_ACT && WS_F2 + (size_t)MOE_MAXROWS * DM * 4 <= WS_SPARE, "moe ws map");
constexpr int CW_CNT = 1024;
static_assert(WS_OHF + 32 * MiB <= WS_YF && WS_NKV + 9 * MiB <= WS_END, "ws map");
constexpr int CW_BAR = 4096;
constexpr int MAX_LAUNCHES = 64;
static_assert((CW_BAR + MAX_LAUNCHES * XCD_BAR_WORDS) * 4 <= (int)CTL_ZERO_BYTES, "CTL words inside the memset region");

constexpr int SCR_BYTES = 151552;
constexpr int MISC_OFF = SCR_BYTES;
constexpr int LDS_BYTES = 155648;

struct Frame {
    LAS unsigned char* lds;
    volatile LAS unsigned* MISC;
    gu32* ctl;
    int tid, lane, wave, G, gw, NGW;
    unsigned char* ws;
    const float* in[28];
    float* out;
};
enum InIdx { I_X = 0, I_C, I_CTX, I_CCTX, I_ADAW, I_ADAB, I_LNG, I_LNB, I_LBT, I_EV_WIN, I_EV_LAM, I_EV_SUBLN, I_EV_GKW2, I_EV_GKB, I_EV_GLAG, I_EV_WOUT, I_EV_W1, I_EV_W2,
             I_OD_WIN, I_OD_QNG, I_OD_KVNG, I_OD_WUQ, I_OD_WUKV, I_OD_HGG, I_OD_WOUT, I_OD_ROUTER, I_OD_EW1, I_OD_EW2 };

__device__ __forceinline__ float bf2f(unsigned short b) { return __uint_as_float(((unsigned)b) << 16); }
__device__ __forceinline__ float bflo(unsigned w) { return __uint_as_float(w << 16); }
__device__ __forceinline__ float bfhi(unsigned w) { return __uint_as_float(w & 0xffff0000u); }
__device__ __forceinline__ float wave_sum(float v) {
#pragma unroll
    for (int o = 1; o < 64; o <<= 1) v += __shfl_xor(v, o);
    return v;
}
__device__ __forceinline__ float wave_max(float v) {
#pragma unroll
    for (int o = 1; o < 64; o <<= 1) v = fmaxf(v, __shfl_xor(v, o));
    return v;
}
__device__ __forceinline__ float sigmoidf_(float x) { return 1.0f / (1.0f + __expf(-x)); }
__device__ __forceinline__ float siluf_(float x) { return x / (1.0f + __expf(-x)); }
__device__ __forceinline__ float logsigmoidf_(float x) { return fminf(x, 0.0f) - log1pf(__expf(-fabsf(x))); }
__device__ __forceinline__ int mod_row(int m) { return m < ML ? (m >> 11) : NB; }
__device__ __forceinline__ void frame_refresh(Frame& F) {
    int t = threadIdx.x; asm volatile("" : "+v"(t));
    F.tid = t; F.lane = t & 63; F.wave = __builtin_amdgcn_readfirstlane(t >> 6); F.gw = blockIdx.x * NWAVES + F.wave;
}
__device__ __forceinline__ const float* src_row(const Frame& F, int m) { return m < ML ? F.in[I_X] + (size_t)m * DM : F.in[I_CTX] + (size_t)(m - ML) * DM; }

__device__ __forceinline__ void transpose_tile(const float* W, int N, bf16* WT, int ldt, LAS float* scr, int k0, int n0, int lane) {
    float tv[32];
#pragma unroll
    for (int i = 0; i < 32; ++i) { const int kk = 2 * i + (lane >> 5); tv[i] = W[(size_t)(k0 + kk) * N + n0 + (lane & 31)]; }
#pragma unroll
    for (int i = 0; i < 32; ++i) { const int kk = 2 * i + (lane >> 5); scr[kk * 33 + (lane & 31)] = tv[i]; }
    LDS_WAIT(); asm volatile("" ::: "memory");
    const int c = lane & 7;
#pragma unroll
    for (int j = 0; j < 4; ++j) { const int n = (lane >> 3) + 8 * j; const LAS float* s = scr + (8 * c) * 33 + n;
        v4u o; o.x = pk2(s[0 * 33], s[1 * 33]); o.y = pk2(s[2 * 33], s[3 * 33]); o.z = pk2(s[4 * 33], s[5 * 33]); o.w = pk2(s[6 * 33], s[7 * 33]);
        *(GAS v4u*)(WT + (size_t)(n0 + n) * ldt + k0 + 8 * c) = o; }
    LDS_WAIT(); asm volatile("" ::: "memory");
}
template <bool SWI>
__device__ __forceinline__ void transpose_weight(Frame& F, const float* W, int K, int N, bf16* WT, int ldt, LAS float* scr) {
    const int nblk = N / 32, items = (K / 64) * nblk;
    for (int it = F.gw; it < items; it += F.NGW) { const int n0 = 32 * (it % nblk);
        const int r0 = !SWI ? n0 : (n0 < DFF ? (n0 >> 7) * 256 + (n0 & 127) : ((n0 - DFF) >> 7) * 256 + 128 + ((n0 - DFF) & 127));
        transpose_tile(W + n0, N, WT + (size_t)r0 * ldt, ldt, scr, 64 * (it / nblk), 0, F.lane); }
}
__device__ __forceinline__ void zero_bytes16(Frame& F, unsigned char* p, size_t nbytes) {
    const v4u z = {0u, 0u, 0u, 0u};
    for (size_t i = (size_t)blockIdx.x * NTHR + F.tid; i < nbytes / 16; i += (size_t)F.G * NTHR) ((GAS v4u*)p)[i] = z;
}

__device__ __forceinline__ void p0_prologue(Frame& F) {
    {
        LAS float* sS = (LAS float*)F.lds;
        LAS float* part = (LAS float*)(F.lds + 40960);
        float* MOD = (float*)(F.ws + WS_MOD);
        if ((int)blockIdx.x < 192) {
            for (int i = F.tid; i < 9 * 1024; i += NTHR) { const int r = i >> 10, k = i & 1023; const float v = r < 8 ? F.in[I_C][r * 1024 + k] : F.in[I_CCTX][k]; sS[i] = siluf_(v); }
            __syncthreads();
            for (int it = blockIdx.x; it < 192; it += F.G) {
                const int l = it / 96, n0 = (it % 96) * 64;
                const float* Wp = F.in[I_ADAW] + ((size_t)l * 1024 + 128 * F.wave) * 6144 + n0 + F.lane;
                float acc[9];
#pragma unroll
                for (int r = 0; r < 9; ++r) acc[r] = 0.f;
                for (int kk = 0; kk < 128; kk += 32) {
                    float wv[32];
#pragma unroll
                    for (int j = 0; j < 32; ++j) wv[j] = Wp[(size_t)(kk + j) * 6144];
#pragma unroll
                    for (int j = 0; j < 32; ++j)
#pragma unroll
                        for (int r = 0; r < 9; ++r) acc[r] += sS[r * 1024 + 128 * F.wave + kk + j] * wv[j];
                }
#pragma unroll
                for (int r = 0; r < 9; ++r) part[(F.wave * 9 + r) * 64 + F.lane] = acc[r];
                __syncthreads();
                for (int i = F.tid; i < 576; i += NTHR) { const int r = i >> 6, c = i & 63; float s = 0.f;
#pragma unroll
                    for (int w = 0; w < 8; ++w) s += part[(w * 9 + r) * 64 + c];
                    MOD[((size_t)l * 9 + r) * 6144 + n0 + c] = s + F.in[I_ADAB][l * 6144 + n0 + c]; }
                __syncthreads();
            }
        }
        __syncthreads();
    }
    {
        float* COS = (float*)(F.ws + WS_COS); float* SIN = (float*)(F.ws + WS_SIN);
        for (int i = blockIdx.x * NTHR + F.tid; i < 2048 * 32; i += F.G * NTHR) {
            const int pos = i >> 5, pi = i & 31; const int j = pi & 15;
            const float inv = (float)pow(10000.0, -(double)j / 16.0);
            const float p = (float)(pi < 16 ? (pos >> 6) : (pos & 63));
            const float ang = p * inv;
            COS[i] = (float)cos((double)ang); SIN[i] = (float)sin((double)ang);
        }
        if (blockIdx.x == 0) {
            float* SC = (float*)(F.ws + WS_SCAL);
            if (F.wave == 0) { const float* lv = F.in[I_EV_LAM]; const float a = wave_sum(lv[F.lane] * lv[64 + F.lane]), b = wave_sum(lv[128 + F.lane] * lv[192 + F.lane]);
                if (F.lane == 0) SC[0] = expf(a) - expf(b) + LAM_INIT0; }
            { const float t0 = F.in[I_LBT][F.tid], t1 = F.in[I_LBT][512 + F.tid]; SC[256 + F.tid] = 1.0f / (1.0f + expf(t0 - t1)); }
        }
    }
    {
        LAS float* scr = (LAS float*)(F.lds + F.wave * 16384);
        transpose_weight<false>(F, F.in[I_EV_WIN], 1024, EV_IN, (bf16*)(F.ws + WS_W_IN0), 1024, scr);
        transpose_weight<false>(F, F.in[I_EV_WOUT], 1024, 1024, (bf16*)(F.ws + WS_W_OUT0), 1024, scr);
        transpose_weight<true>(F, F.in[I_EV_W1], 1024, 2 * DFF, (bf16*)(F.ws + WS_W_FF1), 1024, scr);
        transpose_weight<false>(F, F.in[I_EV_W2], DFF, 1024, (bf16*)(F.ws + WS_W_FF2), DFF, scr);
        transpose_weight<false>(F, F.in[I_OD_WIN], 1024, OD_IN, (bf16*)(F.ws + WS_W_IN1), 1024, scr);
        transpose_weight<false>(F, F.in[I_OD_WUQ], 256, 768, (bf16*)(F.ws + WS_W_UQ), 256, scr);
        transpose_weight<false>(F, F.in[I_OD_WUKV], 128, 1024, (bf16*)(F.ws + WS_W_UKV), 256, scr);
        transpose_weight<false>(F, F.in[I_OD_WOUT], 1024, 1024, (bf16*)(F.ws + WS_W_OUT1), 1024, scr);
        for (int e = 0; e < NEXP; ++e) {
            transpose_weight<true>(F, F.in[I_OD_EW1] + (size_t)e * 1024 * 2 * DFF, 1024, 2 * DFF, (bf16*)(F.ws + WS_EXP_W1) + (size_t)e * 2 * DFF * 1024, 1024, scr);
            transpose_weight<false>(F, F.in[I_OD_EW2] + (size_t)e * DFF * 1024, DFF, 1024, (bf16*)(F.ws + WS_EXP_W2) + (size_t)e * 1024 * DFF, DFF, scr);
        }
        zero_bytes16(F, F.ws + WS_W_IN0 + (size_t)EV_IN * 1024 * 2, (size_t)(EV_INP - EV_IN) * 1024 * 2);
        zero_bytes16(F, F.ws + WS_W_IN1 + (size_t)OD_IN * 1024 * 2, (size_t)(OD_INP - OD_IN) * 1024 * 2);
        { const v4u z = {0u, 0u, 0u, 0u};
          for (int i = blockIdx.x * NTHR + F.tid; i < 1024 * 16; i += F.G * NTHR) *(GAS v4u*)(F.ws + WS_W_UKV + (size_t)(i >> 4) * 512 + 256 + (i & 15) * 16) = z; }
    }
}

__device__ __forceinline__ void store_bf16x4(bf16* p, f32x4 v) { *(GAS unsigned long long*)p = (unsigned long long)pk2(v.x, v.y) | ((unsigned long long)pk2(v.z, v.w) << 32); }
__device__ __forceinline__ void p_modulate0(Frame& F) {
    const float* MOD = (const float*)(F.ws + WS_MOD); bf16* H = (bf16*)(F.ws + WS_H);
    for (int m = F.gw; m < MT; m += F.NGW) {
        const float* xr = src_row(F, m); const float* mr = MOD + (size_t)(0 * 9 + mod_row(m)) * 6144;
#pragma unroll
        for (int j = 0; j < 4; ++j) { const int c = 4 * F.lane + 256 * j; const f32x4 v = *(const f32x4*)(xr + c), sh = *(const f32x4*)(mr + c), sc = *(const f32x4*)(mr + 1024 + c);
            store_bf16x4(H + (size_t)m * DM + c, v * (1.0f + sc) + sh); }
    }
}

__device__ __forceinline__ void p_post0(Frame& F) {
    const bf16* P = (const bf16*)(F.ws + WS_P); float* GK = (float*)(F.ws + WS_GK);
    const int d = F.lane >> 5, k0 = (F.lane & 31) * 8;
    for (int m = F.gw; m < MT; m += F.NGW) {
        const bf16* pr = P + (size_t)m * EV_INP + EV_LRF + d * 16;
        const v4u l0 = *(const GAS v4u*)pr, l1 = *(const GAS v4u*)(pr + 8);
        float lr[16]; lr[0] = bflo(l0.x); lr[1] = bfhi(l0.x); lr[2] = bflo(l0.y); lr[3] = bfhi(l0.y); lr[4] = bflo(l0.z); lr[5] = bfhi(l0.z); lr[6] = bflo(l0.w); lr[7] = bfhi(l0.w);
        lr[8] = bflo(l1.x); lr[9] = bfhi(l1.x); lr[10] = bflo(l1.y); lr[11] = bfhi(l1.y); lr[12] = bflo(l1.z); lr[13] = bfhi(l1.z); lr[14] = bflo(l1.w); lr[15] = bfhi(l1.w);
        const float* wb = F.in[I_EV_GKW2] + (size_t)d * 16 * 256 + k0;
        f32x4 a0 = *(const f32x4*)(F.in[I_EV_GKB] + d * 256 + k0), a1 = *(const f32x4*)(F.in[I_EV_GKB] + d * 256 + k0 + 4);
#pragma unroll
        for (int r = 0; r < 16; ++r) { a0 = a0 + *(const f32x4*)(wb + r * 256) * lr[r]; a1 = a1 + *(const f32x4*)(wb + r * 256 + 4) * lr[r]; }
        f32x4 o0, o1;
#pragma unroll
        for (int q = 0; q < 4; ++q) { o0[q] = logsigmoidf_(a0[q]) * (1.0f / 16.0f); o1[q] = logsigmoidf_(a1[q]) * (1.0f / 16.0f); }
        float* go = GK + ((size_t)d * MT + m) * 256 + k0; *(f32x4*)go = o0; *(f32x4*)(go + 4) = o1;
    }
}
namespace att {
typedef short bf16x8 __attribute__((ext_vector_type(8)));
typedef short s16x4 __attribute__((ext_vector_type(4)));
typedef float f32x16 __attribute__((ext_vector_type(16)));
typedef unsigned u32x4 __attribute__((ext_vector_type(4)));
constexpr int KVBLK = 64, SHM_V = KVBLK * 128 * 2;
constexpr float THR = 8.f;
#define ATT_SBAR() __builtin_amdgcn_sched_barrier(0)
__device__ __forceinline__ int crow(int r, int hi) { return (r & 3) + 8 * (r >> 2) + 4 * hi; }
__device__ __forceinline__ unsigned cvtpk(float lo, float hi) { unsigned r; asm volatile("v_cvt_pk_bf16_f32 %0, %1, %2" : "=v"(r) : "v"(lo), "v"(hi)); return r; }

__device__ __forceinline__ void partialSM(f32x16& p0, f32x16& p1, float& m_reg, float& mn, float& alpha, const float C, const float THRS) {
    float pmax = p0[0];
#pragma unroll
    for (int r = 1; r < 16; ++r) pmax = fmaxf(pmax, p0[r]);
#pragma unroll
    for (int r = 0; r < 16; ++r) pmax = fmaxf(pmax, p1[r]);
    { auto rr = __builtin_amdgcn_permlane32_swap(__float_as_uint(pmax), __float_as_uint(pmax), false, false);
      pmax = fmaxf(__uint_as_float(rr[0]), __uint_as_float(rr[1])); }
    if (__builtin_expect(__all(pmax - m_reg <= THRS), 1)) { mn = m_reg; alpha = 1.f; }
    else { mn = fmaxf(m_reg, pmax); alpha = __builtin_amdgcn_exp2f((m_reg - mn) * C); m_reg = mn; }
    const float mnC = -mn * C;
#pragma unroll
    for (int r = 0; r < 16; ++r) p0[r] = fmaf(p0[r], C, mnC);
#pragma unroll
    for (int r = 0; r < 16; ++r) p1[r] = fmaf(p1[r], C, mnC);
#pragma unroll
    for (int r = 0; r < 16; ++r) p0[r] = __builtin_amdgcn_exp2f(p0[r]);
}
__device__ __forceinline__ void finishSM(f32x16& p0, f32x16& p1, float alpha, float& l_reg, bf16x8& pa0, bf16x8& pa1, bf16x8& pa2, bf16x8& pa3) {
#pragma unroll
    for (int r = 0; r < 16; ++r) p1[r] = __builtin_amdgcn_exp2f(p1[r]);
    float ps = 0;
#pragma unroll
    for (int r = 0; r < 16; ++r) ps += p0[r];
#pragma unroll
    for (int r = 0; r < 16; ++r) ps += p1[r];
    { auto rr = __builtin_amdgcn_permlane32_swap(__float_as_uint(ps), __float_as_uint(ps), false, false);
      ps = __uint_as_float(rr[0]) + __uint_as_float(rr[1]); }
    l_reg = l_reg * alpha + ps;
#define ATT_PK4(P, BASE, OUT) do { unsigned a0 = cvtpk(P[BASE + 0], P[BASE + 1]), a1 = cvtpk(P[BASE + 2], P[BASE + 3]);   \
    unsigned b0 = cvtpk(P[BASE + 4], P[BASE + 5]), b1 = cvtpk(P[BASE + 6], P[BASE + 7]);                              \
    auto r0 = __builtin_amdgcn_permlane32_swap(a0, b0, false, false); auto r1 = __builtin_amdgcn_permlane32_swap(a1, b1, false, false); \
    u32x4 w = {r0[0], r1[0], r0[1], r1[1]}; OUT = __builtin_bit_cast(bf16x8, w); } while (0)
    ATT_PK4(p0, 0, pa0); ATT_PK4(p0, 8, pa1); ATT_PK4(p1, 0, pa2); ATT_PK4(p1, 8, pa3);
#undef ATT_PK4
}
__device__ __forceinline__ int v_st(int k, int c) { const int kk = (k & ~0xC) | ((k & 4) << 1) | ((k & 8) >> 1); return ((kk >> 3) * 4 + (c >> 5)) * 512 + ((kk & 7) * 32 + (c & 31)) * 2; }
__device__ __forceinline__ int v_rd_base(int lane) { return ((lane & 3) << 3) | (((lane >> 2) & 3) << 6) | (((lane >> 4) & 1) << 5) | (((lane >> 5) & 1) << 8); }
constexpr int v_rd_off(int d0, int ks, int half) { return d0 * 512 + ks * 4096 + half * 2048; }
template <int OFF> __device__ __forceinline__ s16x4 tr_read(int vb) { s16x4 r; asm volatile("ds_read_b64_tr_b16 %0, %1 offset:%2" : "=&v"(r) : "v"(vb), "i"(OFF) : "memory"); return r; }
template <int D0> __device__ __forceinline__ void pv_one(f32x16& od, int vb, bf16x8 pa0, bf16x8 pa1, bf16x8 pa2, bf16x8 pa3) {
    const s16x4 l0 = tr_read<v_rd_off(D0, 0, 0)>(vb), h0 = tr_read<v_rd_off(D0, 0, 1)>(vb), l1 = tr_read<v_rd_off(D0, 1, 0)>(vb), h1 = tr_read<v_rd_off(D0, 1, 1)>(vb);
    const s16x4 l2 = tr_read<v_rd_off(D0, 2, 0)>(vb), h2 = tr_read<v_rd_off(D0, 2, 1)>(vb), l3 = tr_read<v_rd_off(D0, 3, 0)>(vb), h3 = tr_read<v_rd_off(D0, 3, 1)>(vb);
    asm volatile("s_waitcnt lgkmcnt(0)" ::: "memory"); ATT_SBAR();
#define ATT_PK(L, H) (bf16x8){L[0], L[1], L[2], L[3], H[0], H[1], H[2], H[3]}
    od = __builtin_amdgcn_mfma_f32_32x32x16_bf16(pa0, ATT_PK(l0, h0), od, 0, 0, 0);
    od = __builtin_amdgcn_mfma_f32_32x32x16_bf16(pa1, ATT_PK(l1, h1), od, 0, 0, 0);
    od = __builtin_amdgcn_mfma_f32_32x32x16_bf16(pa2, ATT_PK(l2, h2), od, 0, 0, 0);
    od = __builtin_amdgcn_mfma_f32_32x32x16_bf16(pa3, ATT_PK(l3, h3), od, 0, 0, 0);
#undef ATT_PK
}
__device__ __forceinline__ void pv_d0(f32x16* o, int vb, bf16x8 pa0, bf16x8 pa1, bf16x8 pa2, bf16x8 pa3) {
    pv_one<0>(o[0], vb, pa0, pa1, pa2, pa3); pv_one<1>(o[1], vb, pa0, pa1, pa2, pa3); pv_one<2>(o[2], vb, pa0, pa1, pa2, pa3); pv_one<3>(o[3], vb, pa0, pa1, pa2, pa3);
}
__device__ __forceinline__ int k_st(int row, int c, int RB) { return row * RB + (((c & ~7) | ((c & 7) ^ ((row >> 1) & 7))) << 4); }
template <int NQ, int RB> __device__ __forceinline__ void qkt(f32x16& p0, f32x16& p1, const LAS unsigned char* kb  , const int (&kx)[4], const bf16x8* qr) {
    p0 = f32x16{}; p1 = f32x16{};
#pragma unroll
    for (int d0 = 0; d0 < NQ; ++d0) {
        const LAS unsigned char* a = kb + kx[d0 & 3] + (d0 >> 2) * 128;
        const bf16x8 b0 = *(const LAS bf16x8*)a, b1 = *(const LAS bf16x8*)(a + 32 * RB);
        p0 = __builtin_amdgcn_mfma_f32_32x32x16_bf16(b0, qr[d0], p0, 0, 0, 0);
        p1 = __builtin_amdgcn_mfma_f32_32x32x16_bf16(b1, qr[d0], p1, 0, 0, 0);
    }
}
struct Src { const bf16* kbase; int ldk; const bf16* k2base; int ldk2; const bf16* vbase; int ldv; int rowc, rowl, NT; };

template <int DQK, bool QROPE, bool PIPE>
__device__ __forceinline__ void attn_core(const bf16* Qw, const Src& S, LAS unsigned char* lds, const float C, const float THRS, f32x16 (&o)[4], float& l_out, int tid, const float* cs, const float* sn) {
    constexpr int NQ = DQK / 16, RB = DQK * 2, SHM_K = KVBLK * RB, KCH = DQK / 8, KPT = (KVBLK * KCH) / 512;
    static_assert(KPT * 512 == KVBLK * KCH, "K chunks divide over the threads");
    const int wid = tid >> 6, lane = tid & 63, r32 = lane & 31, hi = lane >> 5;
    LAS unsigned char* V_lds = lds; LAS unsigned char* K_lds = lds + 2 * SHM_V;
    LAS float* al_l = (LAS float*)(lds + 2 * SHM_V + 2 * SHM_K) + wid * 64 + 32;
    float m_reg = -1e30f, l_reg = 0;
#pragma unroll
    for (int d = 0; d < 4; ++d) o[d] = f32x16{};
    bf16x8 qr[NQ];
#pragma unroll
    for (int d0 = 0; d0 < NQ; ++d0) qr[d0] = *(const GAS bf16x8*)(Qw + d0 * 16);
    if constexpr (QROPE) {
#pragma unroll
        for (int d0 = NQ - 4; d0 < NQ; ++d0) { const int i0 = (d0 - (NQ - 4)) * 8 + hi * 4; const f32x4 c4 = *(const f32x4*)(cs + i0), s4 = *(const f32x4*)(sn + i0);
            const u32x4 w = __builtin_bit_cast(u32x4, qr[d0]); u32x4 ow;
#pragma unroll
            for (int p = 0; p < 4; ++p) { const float t0 = __uint_as_float(w[p] << 16), t1 = __uint_as_float(w[p] & 0xffff0000u); ow[p] = cvtpk(t0 * c4[p] - t1 * s4[p], t0 * s4[p] + t1 * c4[p]); }
            qr[d0] = __builtin_bit_cast(bf16x8, ow); }
    }
#define ATT_MAPS(T) \
    const int sr = (T) >> 4, sc = ((T) & 15) * 8, vst0 = v_st(sr, sc), vst1 = v_st(32 + sr, sc); \
    int kst[KPT]; unsigned koff[KPT]; \
    _Pragma("unroll") for (int i = 0; i < KPT; ++i) { int row, c; \
        if (DQK == 64) { row = (T) >> 3; c = (T) & 7; koff[i] = (unsigned)row * (unsigned)S.ldk + c * 8; } \
        else if (i < 2) { row = ((T) >> 4) + 32 * i; c = (T) & 15; koff[i] = (unsigned)row * (unsigned)S.ldk + c * 8; } \
        else { row = (T) >> 3; c = 16 + ((T) & 7); koff[i] = (unsigned)row * (unsigned)S.ldk2 + (c - 16) * 8; } \
        kst[i] = k_st(row, c, RB); } \
    const unsigned voff0 = (unsigned)sr * (unsigned)S.ldv + sc, voff1 = voff0 + 32u * (unsigned)S.ldv;
    const int vb0 = (int)(unsigned)(size_t)(V_lds) + v_rd_base(lane);
    int kx[4]; { const int t = hi ^ ((r32 >> 1) & 7);
#pragma unroll
        for (int k = 0; k < 4; ++k) kx[k] = ((2 * k) ^ t) << 4; }
    const LAS unsigned char* kb0 = K_lds + r32 * RB; const LAS unsigned char* kb1 = kb0 + SHM_K;
    struct Slot { bf16x8 vs0, vs1; bf16x8 ks[KPT]; };
    Slot s0;
#define ATT_SLOAD(sl, j) do { const int _j = (j); const unsigned _r0 = (unsigned)(_j < 4 ? S.rowc + 64 * _j : S.rowl + 64 * (_j - 4)); \
        const bf16* _vb = S.vbase + (size_t)_r0 * S.ldv; sl.vs0 = *(const GAS bf16x8*)(_vb + voff0); sl.vs1 = *(const GAS bf16x8*)(_vb + voff1); \
        const bf16* _kb = S.kbase + (size_t)_r0 * S.ldk; \
        _Pragma("unroll") for (int _i = 0; _i < KPT; ++_i) { \
            if (DQK == 64 || _i < 2) sl.ks[_i] = *(const GAS bf16x8*)(_kb + koff[_i]); \
            else sl.ks[_i] = *(const GAS bf16x8*)(S.k2base + (size_t)_r0 * S.ldk2 + koff[_i]); } } while (0)
#define ATT_SWRITE(b, sl) do { *(LAS bf16x8*)(V_lds + (b) * SHM_V + vst0) = sl.vs0; *(LAS bf16x8*)(V_lds + (b) * SHM_V + vst1) = sl.vs1; \
        _Pragma("unroll") for (int _i = 0; _i < KPT; ++_i) *(LAS bf16x8*)(K_lds + (b) * SHM_K + kst[_i]) = sl.ks[_i]; } while (0)
#define ATT_SWAIT() asm volatile("s_waitcnt vmcnt(%0)" :: "n"(2 + KPT) : "memory")
#define ATT_RESC(a) do { if (__any((a) < 1.f)) { if (hi == 0) al_l[r32] = (a); asm volatile("s_waitcnt lgkmcnt(0)" ::: "memory"); \
        _Pragma("unroll") for (int d = 0; d < 4; ++d) _Pragma("unroll") for (int r = 0; r < 16; ++r) o[d][r] *= al_l[crow(r, hi)]; } } while (0)
    bf16x8 pa0, pa1, pa2, pa3; const int NT = S.NT;
    if constexpr (!PIPE) {
    f32x16 p0, p1; float mn, al;
    { ATT_MAPS(tid)
    ATT_SLOAD(s0, 0); asm volatile("s_waitcnt vmcnt(0)" ::: "memory"); ATT_SWRITE(0, s0); ATT_SLOAD(s0, 1); }
#define ATT_HALF(b, jj) do { \
        __syncthreads(); \
        if ((jj) + 1 < NT) { int tl_ = tid; asm volatile("" : "+v"(tl_)); ATT_MAPS(tl_) ATT_SWRITE((b) ^ 1, s0); if ((jj) + 2 < NT) ATT_SLOAD(s0, (jj) + 2); } \
        ATT_SBAR(); qkt<NQ, RB>(p0, p1, (b) ? kb1 : kb0, kx, qr); \
        partialSM(p0, p1, m_reg, mn, al, C, THRS); ATT_RESC(al); \
        finishSM(p0, p1, al, l_reg, pa0, pa1, pa2, pa3); ATT_SBAR(); \
        pv_d0(o, vb0 + (b) * SHM_V, pa0, pa1, pa2, pa3); } while (0)
    for (int j = 0; j < NT; j += 2) { ATT_HALF(0, j); ATT_HALF(1, j + 1); }
#undef ATT_HALF
    __syncthreads();
    } else {
    ATT_MAPS(tid)
    Slot s1; f32x16 pA0, pA1, pB0, pB1; float mnA, mnB, alA, alB;
    ATT_SLOAD(s0, 0); asm volatile("s_waitcnt vmcnt(0)" ::: "memory"); ATT_SWRITE(0, s0); __syncthreads();
    qkt<NQ, RB>(pA0, pA1, kb0, kx, qr); partialSM(pA0, pA1, m_reg, mnA, alA, C, THRS);
    ATT_SLOAD(s1, 1); if (2 < NT) ATT_SLOAD(s0, 2);
    ATT_SWAIT(); ATT_SWRITE(1, s1); __syncthreads();
    for (int j = 1; j + 1 < NT; j += 2) {
        ATT_SBAR(); qkt<NQ, RB>(pB0, pB1, kb1, kx, qr);
        finishSM(pA0, pA1, alA, l_reg, pa0, pa1, pa2, pa3); ATT_SBAR();
        ATT_SLOAD(s1, j + 2); ATT_SBAR();
        pv_d0(o, vb0, pa0, pa1, pa2, pa3); partialSM(pB0, pB1, m_reg, mnB, alB, C, THRS);
        __syncthreads(); ATT_SWAIT(); ATT_SWRITE(0, s0);
        ATT_RESC(alB); __syncthreads();
        ATT_SBAR(); qkt<NQ, RB>(pA0, pA1, kb0, kx, qr);
        finishSM(pB0, pB1, alB, l_reg, pa0, pa1, pa2, pa3); ATT_SBAR();
        if (j + 3 < NT) ATT_SLOAD(s0, j + 3); ATT_SBAR();
        pv_d0(o, vb0 + SHM_V, pa0, pa1, pa2, pa3); partialSM(pA0, pA1, m_reg, mnA, alA, C, THRS);
        __syncthreads(); ATT_SWAIT(); ATT_SWRITE(1, s1);
        ATT_RESC(alA); __syncthreads();
    }
    ATT_SBAR(); qkt<NQ, RB>(pB0, pB1, kb1, kx, qr);
    finishSM(pA0, pA1, alA, l_reg, pa0, pa1, pa2, pa3); ATT_SBAR();
    pv_d0(o, vb0, pa0, pa1, pa2, pa3); partialSM(pB0, pB1, m_reg, mnB, alB, C, THRS);
    __syncthreads(); ATT_RESC(alB);
    finishSM(pB0, pB1, alB, l_reg, pa0, pa1, pa2, pa3); ATT_SBAR();
    pv_d0(o, vb0 + SHM_V, pa0, pa1, pa2, pa3);
    __syncthreads();
    }
    l_out = l_reg;
#undef ATT_MAPS
#undef ATT_SLOAD
#undef ATT_SWRITE
#undef ATT_SWAIT
#undef ATT_RESC
}
__device__ __forceinline__ void row_inv(float l_reg, LAS unsigned char* lds, int SHM_K, int tid, float (&rli)[16]) {
    const int wid = tid >> 6, lane = tid & 63, r32 = lane & 31, hi = lane >> 5;
    LAS float* li_l = (LAS float*)(lds + 2 * SHM_V + 2 * SHM_K) + wid * 64;
    if (hi == 0) li_l[r32] = l_reg; asm volatile("s_waitcnt lgkmcnt(0)" ::: "memory");
#pragma unroll
    for (int r = 0; r < 16; ++r) rli[r] = __builtin_amdgcn_rcpf(li_l[crow(r, hi)]);
    asm volatile("s_waitcnt lgkmcnt(0)" ::: "memory");
}
}
__device__ __forceinline__ f32x4 ld_bf16x4(const bf16* p) { const unsigned long long w = *(const GAS unsigned long long*)p; return (f32x4){bflo((unsigned)w), bfhi((unsigned)w), bflo((unsigned)(w >> 32)), bfhi((unsigned)(w >> 32))}; }
__device__ __forceinline__ int key_row(int b, int j) { return j < CTXL ? ML + b * CTXL + j : b * SEQ + (j - CTXL); }
__device__ __forceinline__ float dot64_lds(const bf16* kp, const LAS float* q) {
    float s = 0.f;
#pragma unroll
    for (int c = 0; c < 8; ++c) { const v4u kv = *(const GAS v4u*)(kp + 8 * c); const LAS float* qq = q + 8 * c;
        s += bflo(kv.x) * qq[0] + bfhi(kv.x) * qq[1] + bflo(kv.y) * qq[2] + bfhi(kv.y) * qq[3] + bflo(kv.z) * qq[4] + bfhi(kv.z) * qq[5] + bflo(kv.w) * qq[6] + bfhi(kv.w) * qq[7]; }
    return s;
}
constexpr int ATT_WAVE_BYTES = 18944;
static_assert(8 * ATT_WAVE_BYTES <= SCR_BYTES, "attention scratch");

__device__ __forceinline__ void p_attn0_naive(Frame& F) {
    const bf16* P = (const bf16*)(F.ws + WS_P); float* OA = (float*)(F.ws + WS_OA);
    const float lam = *(const float*)(F.ws + WS_SCAL);
    LAS float* w1 = (LAS float*)(F.lds + F.wave * ATT_WAVE_BYTES); LAS float* w2 = w1 + 2304; LAS float* q = w2 + 2304;
    for (int it = F.gw; it < MT * 4; it += F.NGW) {
        const int m = it >> 2, h = it & 3;
        const int b = m < ML ? (m >> 11) : ((m - ML) >> 8), NK = m < ML ? (CTXL + SEQ) : CTXL;
        const bf16* qp = P + (size_t)m * EV_INP + EV_QA + h * 128;
        q[F.lane] = bf2f(qp[F.lane]); q[64 + F.lane] = bf2f(qp[64 + F.lane]);
        LDS_WAIT(); asm volatile("" ::: "memory");
        float mx1 = -3.0e38f, mx2 = -3.0e38f;
        for (int j = F.lane; j < NK; j += 64) { const bf16* kp = P + (size_t)key_row(b, j) * EV_INP + EV_KA + h * 128;
            const float s1 = dot64_lds(kp, q) * DA_SCALE, s2 = dot64_lds(kp + 64, q + 64) * DA_SCALE; w1[j] = s1; w2[j] = s2; mx1 = fmaxf(mx1, s1); mx2 = fmaxf(mx2, s2); }
        mx1 = wave_max(mx1); mx2 = wave_max(mx2);
        float sum1 = 0.f, sum2 = 0.f;
        for (int j = F.lane; j < NK; j += 64) { const float e1 = __expf(w1[j] - mx1), e2 = __expf(w2[j] - mx2); w1[j] = e1; w2[j] = e2; sum1 += e1; sum2 += e2; }
        const float inv1 = 1.0f / wave_sum(sum1), c2 = lam / wave_sum(sum2);
        for (int j = F.lane; j < NK; j += 64) w1[j] = w1[j] * inv1 - c2 * w2[j];
        LDS_WAIT(); asm volatile("" ::: "memory");
        float a0 = 0.f, a1 = 0.f;
        const bf16* vbase = P + EV_VA + h * 128 + 2 * F.lane;
        for (int j = 0; j < NK; j += 4) {
            unsigned vv[4]; float ww[4];
#pragma unroll
            for (int u = 0; u < 4; ++u) { vv[u] = *(const GAS unsigned*)(vbase + (size_t)key_row(b, j + u) * EV_INP); ww[u] = w1[j + u]; }
#pragma unroll
            for (int u = 0; u < 4; ++u) { a0 += ww[u] * bflo(vv[u]); a1 += ww[u] * bfhi(vv[u]); }
        }
        *(float2*)(OA + (size_t)m * 512 + h * 128 + 2 * F.lane) = make_float2(a0, a1);
        LDS_WAIT(); asm volatile("" ::: "memory");
    }
}

__device__ __forceinline__ void p_attn1_naive(Frame& F) {
    const bf16* P = (const bf16*)(F.ws + WS_P); const bf16* Q = (const bf16*)(F.ws + WS_Q); const bf16* KV = (const bf16*)(F.ws + WS_KV); float* OM = (float*)(F.ws + WS_OM);
    const float* COS = (const float*)(F.ws + WS_COS); const float* SIN = (const float*)(F.ws + WS_SIN);
    LAS float* w1 = (LAS float*)(F.lds + F.wave * ATT_WAVE_BYTES); LAS float* q = w1 + 2304;
    for (int it = F.gw; it < ML * 4; it += F.NGW) {
        const int m = it >> 2, h = it & 3, b = m >> 11, NK = CTXL + SEQ, t = m & (SEQ - 1);
        const bf16* qp = Q + (size_t)m * 768 + h * 192;
        q[F.lane] = bf2f(qp[F.lane]); q[64 + F.lane] = bf2f(qp[64 + F.lane]);
        if (F.lane < 32) { const float t0 = bf2f(qp[128 + 2 * F.lane]), t1 = bf2f(qp[129 + 2 * F.lane]), cs = COS[t * 32 + F.lane], sn = SIN[t * 32 + F.lane];
            q[128 + 2 * F.lane] = t0 * cs - t1 * sn; q[129 + 2 * F.lane] = t0 * sn + t1 * cs; }
        LDS_WAIT(); asm volatile("" ::: "memory");
        float mx = -3.0e38f;
        for (int j = F.lane; j < NK; j += 64) { const int kr = key_row(b, j); const bf16* kn = KV + (size_t)kr * 1024 + h * 256; const bf16* kp = P + (size_t)kr * OD_INP + OD_KR;
            const float s = (dot64_lds(kn, q) + dot64_lds(kn + 64, q + 64) + dot64_lds(kp, q + 128)) * MLA_SCALE; w1[j] = s; mx = fmaxf(mx, s); }
        mx = wave_max(mx);
        float sum = 0.f;
        for (int j = F.lane; j < NK; j += 64) { const float e = __expf(w1[j] - mx); w1[j] = e; sum += e; }
        const float inv = 1.0f / wave_sum(sum);
        LDS_WAIT(); asm volatile("" ::: "memory");
        float a0 = 0.f, a1 = 0.f;
        const bf16* vbase = KV + h * 256 + 128 + 2 * F.lane;
        for (int j = 0; j < NK; j += 4) {
            unsigned vv[4]; float ww[4];
#pragma unroll
            for (int u = 0; u < 4; ++u) { vv[u] = *(const GAS unsigned*)(vbase + (size_t)key_row(b, j + u) * 1024); ww[u] = w1[j + u]; }
#pragma unroll
            for (int u = 0; u < 4; ++u) { a0 += ww[u] * bflo(vv[u]); a1 += ww[u] * bfhi(vv[u]); }
        }
        *(float2*)(OM + (size_t)m * 512 + h * 128 + 2 * F.lane) = make_float2(a0 * inv, a1 * inv);
        LDS_WAIT(); asm volatile("" ::: "memory");
    }
}


__device__ __forceinline__ void p_attn0(Frame& F) {
    const bf16* P = (const bf16*)(F.ws + WS_P); float* OA = (float*)(F.ws + WS_OA);
    const float lam = *(const float*)(F.ws + WS_SCAL);
    const float C = DA_SCALE * 1.4426950408889634f, THRS = att::THR / DA_SCALE;
    const int r32 = F.lane & 31, hi = F.lane >> 5;
    for (int u = blockIdx.x; u < 288; u += F.G) {
        int bh, qb, NT;
        if (u < 256) { const int x = u & 7, y = u >> 3; bh = x * 4 + (y & 3); qb = y >> 2; NT = 36; } else { bh = u - 256; qb = 0; NT = 4; }
        const int b = bh >> 2, h = bh & 3;
        const int m0 = (u < 256 ? b * SEQ + qb * 256 : ML + b * CTXL) + F.wave * 32;
        const bf16* Qw = P + (size_t)(m0 + r32) * EV_INP + EV_QA + h * 128 + hi * 8;
#pragma unroll 1
        for (int pass = 0; pass < 2; ++pass) {
            att::Src S; S.kbase = P + EV_KA + h * 128 + 64 * pass; S.ldk = EV_INP; S.k2base = nullptr; S.ldk2 = 0; S.vbase = P + EV_VA + h * 128; S.ldv = EV_INP; S.rowc = ML + b * CTXL; S.rowl = b * SEQ; S.NT = NT;
            att::f32x16 o[4]; float l; float rli[16];
            att::attn_core<64, false, true>(Qw + 64 * pass, S, F.lds, C, THRS, o, l, F.tid, nullptr, nullptr);
            att::row_inv(l, F.lds, 64 * 128, F.tid, rli);
            const float sc = pass ? -lam : 1.0f;
            int lo_ = F.lane; asm volatile("" : "+v"(lo_));
            float* Ow = OA + (size_t)m0 * 512 + h * 128; const unsigned ob = (unsigned)((lo_ >> 5) * 4 * 512 + (lo_ & 31));
#pragma unroll
            for (int r = 0; r < 16; ++r)
#pragma unroll
                for (int d0 = 0; d0 < 4; ++d0) { float* p = Ow + (ob + (unsigned)(((r & 3) + 8 * (r >> 2)) * 512 + d0 * 32)); const float v = o[d0][r] * rli[r] * sc; *p = pass ? *p + v : v; if (d0 == 3 && (r & 1)) asm volatile("" ::: "memory"); }
        }
    }
}
__device__ __forceinline__ void p_attn1(Frame& F) {
    const bf16* P = (const bf16*)(F.ws + WS_P); const bf16* Q = (const bf16*)(F.ws + WS_Q); const bf16* KV = (const bf16*)(F.ws + WS_KV); float* OM = (float*)(F.ws + WS_OM);
    const float* COS = (const float*)(F.ws + WS_COS); const float* SIN = (const float*)(F.ws + WS_SIN);
    const float C = MLA_SCALE * 1.4426950408889634f, THRS = att::THR / MLA_SCALE;
    const int r32 = F.lane & 31, hi = F.lane >> 5;
    for (int u = blockIdx.x; u < 256; u += F.G) {
        const int x = u & 7, y = u >> 3, bh = x * 4 + (y & 3), qb = y >> 2, b = bh >> 2, h = bh & 3;
        const int m0 = b * SEQ + qb * 256 + F.wave * 32;
        att::Src S; S.kbase = KV + h * 256; S.ldk = 1024; S.k2base = P + OD_KR; S.ldk2 = OD_INP; S.vbase = KV + h * 256 + 128; S.ldv = 1024; S.rowc = ML + b * CTXL; S.rowl = b * SEQ; S.NT = 36;
        const int t = (m0 + r32) & (SEQ - 1);
        att::f32x16 o[4]; float l; float rli[16];
        att::attn_core<192, true, false>(Q + (size_t)(m0 + r32) * 768 + h * 192 + hi * 8, S, F.lds, C, THRS, o, l, F.tid, COS + t * 32, SIN + t * 32);
        att::row_inv(l, F.lds, 64 * 384, F.tid, rli);
        int lo_ = F.lane; asm volatile("" : "+v"(lo_));
        bf16* Ow = (bf16*)(F.ws + WS_H) + (size_t)m0 * DM + h * 128; const unsigned ob = (unsigned)((lo_ >> 5) * 4 * DM + (lo_ & 31));
#pragma unroll
        for (int r = 0; r < 16; ++r)
#pragma unroll
            for (int d0 = 0; d0 < 4; ++d0) Ow[ob + (unsigned)(((r & 3) + 8 * (r >> 2)) * DM + d0 * 32)] = (bf16)(att::cvtpk(o[d0][r] * rli[r], 0.f) & 0xffffu);
    }
}
__device__ __forceinline__ int scan_row(int b, int d, int s) {
    if (s < CTXL) return ML + b * CTXL + (d ? (CTXL - 1 - s) : s);
    const int t = s - CTXL; return b * SEQ + (d ? (SEQ - 1 - t) : t);
}
__device__ __forceinline__ void p_scan0(Frame& F) {
    const bf16* P = (const bf16*)(F.ws + WS_P); const float* GK = (const float*)(F.ws + WS_GK);
    LAS float* qL = (LAS float*)F.lds; LAS float* kL = qL + 2048; LAS float* eL = kL + 2048; LAS float* vL = eL + 2048; LAS float* part = vL + 4096;
    const int v = F.tid & 127, kg = F.tid >> 7;
    for (int ch = blockIdx.x; ch < 64; ch += F.G) {
        const int b = ch >> 3, h = (ch >> 1) & 3, d = ch & 1;
        float* OB = (float*)(F.ws + (d ? WS_OBB : WS_OBF));
        float S[16];
#pragma unroll
        for (int i = 0; i < 16; ++i) S[i] = 0.f;
        for (int c = 0; c < (CTXL + SEQ) / 32; ++c) {
            for (int i = F.tid; i < 32 * 64; i += NTHR) { const int r = i >> 6, k = i & 63; const size_t row = (size_t)scan_row(b, d, c * 32 + r);
                qL[i] = bf2f(P[row * EV_INP + EV_QB + h * 64 + k]) * GLA_QSCALE; kL[i] = bf2f(P[row * EV_INP + EV_KB + h * 64 + k]); eL[i] = __expf(GK[((size_t)d * MT + row) * 256 + h * 64 + k]); }
            for (int i = F.tid; i < 32 * 128; i += NTHR) { const int r = i >> 7, vv = i & 127; const size_t row = (size_t)scan_row(b, d, c * 32 + r); vL[i] = bf2f(P[row * EV_INP + EV_VB + h * 128 + vv]); }
            __syncthreads();
            for (int r = 0; r < 32; ++r) { const float vv = vL[r * 128 + v]; float po = 0.f;
#pragma unroll
                for (int kk = 0; kk < 16; ++kk) { const int k = kg * 16 + kk; S[kk] = S[kk] * eL[r * 64 + k] + kL[r * 64 + k] * vv; po += S[kk] * qL[r * 64 + k]; }
                part[(r * 4 + kg) * 128 + v] = po; }
            __syncthreads();
            for (int i = F.tid; i < 32 * 128; i += NTHR) { const int r = i >> 7, vv = i & 127; const size_t row = (size_t)scan_row(b, d, c * 32 + r);
                OB[row * 512 + h * 128 + vv] = (part[(r * 4 + 0) * 128 + vv] + part[(r * 4 + 1) * 128 + vv]) + (part[(r * 4 + 2) * 128 + vv] + part[(r * 4 + 3) * 128 + vv]); }
            __syncthreads();
        }
    }
}
__device__ __forceinline__ void p_scan1(Frame& F) {
    const bf16* P = (const bf16*)(F.ws + WS_P); const float* LB = (const float*)(F.ws + WS_SCAL) + 256;
    LAS float* qL = (LAS float*)F.lds; LAS float* fL = qL + 4096; LAS float* vL = fL + 4096; LAS float* part = vL + 4096;
    const int v = F.tid & 127, kg = F.tid >> 7;
    for (int ch = blockIdx.x; ch < 64; ch += F.G) {
        const int b = ch >> 3, h = (ch >> 1) & 3, d = ch & 1;
        float* OH = (float*)(F.ws + (d ? WS_OHB : WS_OHF));
        const int fcol = (d ? OD_HFB : OD_HFF) + h * 128;
        float S[32];
#pragma unroll
        for (int i = 0; i < 32; ++i) S[i] = 0.f;
        for (int c = 0; c < (CTXL + SEQ) / 32; ++c) {
            for (int i = F.tid; i < 32 * 128; i += NTHR) { const int r = i >> 7, k = i & 127; const size_t row = (size_t)scan_row(b, d, c * 32 + r); const bf16* pr = P + row * OD_INP;
                const float lb = LB[h * 128 + k];
                qL[i] = bf2f(pr[OD_HQ + h * 128 + k]); fL[i] = lb + (1.0f - lb) * sigmoidf_(bf2f(pr[fcol + k])); vL[i] = bf2f(pr[OD_HI + h * 128 + k]); }
            __syncthreads();
            for (int r = 0; r < 32; ++r) { const float vv = vL[r * 128 + v]; float po = 0.f;
#pragma unroll
                for (int kk = 0; kk < 32; ++kk) { const int k = kg * 32 + kk; const float f = fL[r * 128 + k]; S[kk] = S[kk] * f + (1.0f - f) * vv; po += S[kk] * qL[r * 128 + k]; }
                part[(r * 4 + kg) * 128 + v] = po; }
            __syncthreads();
            if (c >= CTXL / 32) {
                for (int i = F.tid; i < 32 * 128; i += NTHR) { const int r = i >> 7, vv = i & 127; const size_t row = (size_t)scan_row(b, d, c * 32 + r);
                    OH[row * 512 + h * 128 + vv] = (part[(r * 4 + 0) * 128 + vv] + part[(r * 4 + 1) * 128 + vv]) + (part[(r * 4 + 2) * 128 + vv] + part[(r * 4 + 3) * 128 + vv]); }
            }
            __syncthreads();
        }
    }
}

namespace scn {
#define SCN_BAR() do { asm volatile("s_waitcnt lgkmcnt(0)" ::: "memory"); __builtin_amdgcn_s_barrier(); asm volatile("" ::: "memory"); } while (0)
typedef short bf16x8 __attribute__((ext_vector_type(8)));
typedef float f32x16 __attribute__((ext_vector_type(16)));
typedef unsigned u32x4 __attribute__((ext_vector_type(4)));
typedef unsigned u32x2 __attribute__((ext_vector_type(2)));
__device__ __forceinline__ unsigned cvtpk(float lo, float hi) { unsigned r; asm volatile("v_cvt_pk_bf16_f32 %0, %1, %2" : "=v"(r) : "v"(lo), "v"(hi)); return r; }
__device__ __forceinline__ int crow(int r, int hi) { return (r & 3) + 8 * (r >> 2) + 4 * hi; }
template <int DK> struct Lay {
    static constexpr int RS = DK * 2 + 16;
    static constexpr int TS = 80;
    static constexpr int QA = 0, KA = QA + 32 * RS, QB = KA + 32 * RS, KDT = QB + 32 * RS, VT = KDT + DK * TS, DEC = VT + 128 * TS, BUF = DEC + DK * 4;
};
__device__ __forceinline__ bf16x8 pack8(const f32x16& x, int s8) {
    u32x4 w; w.x = cvtpk(x[s8 + 0], x[s8 + 1]); w.y = cvtpk(x[s8 + 2], x[s8 + 3]); w.z = cvtpk(x[s8 + 4], x[s8 + 5]); w.w = cvtpk(x[s8 + 6], x[s8 + 7]); return __builtin_bit_cast(bf16x8, w);
}
__device__ __forceinline__ bf16x8 ld2x8(const LAS unsigned char* p) {
    const u32x2 a = *(const LAS u32x2*)p, b = *(const LAS u32x2*)(p + 16); u32x4 w; w.x = a.x; w.y = a.y; w.z = b.x; w.w = b.y; return __builtin_bit_cast(bf16x8, w);
}
__device__ __forceinline__ float dpp_f(float x, const int ctrl, const int row_mask, const bool bc) {
    return __builtin_bit_cast(float, ctrl == 0x111 ? __builtin_amdgcn_update_dpp(0, __builtin_bit_cast(int, x), 0x111, 0xf, 0xf, true)
                                   : ctrl == 0x112 ? __builtin_amdgcn_update_dpp(0, __builtin_bit_cast(int, x), 0x112, 0xf, 0xf, true)
                                   : ctrl == 0x114 ? __builtin_amdgcn_update_dpp(0, __builtin_bit_cast(int, x), 0x114, 0xf, 0xf, true)
                                   : ctrl == 0x118 ? __builtin_amdgcn_update_dpp(0, __builtin_bit_cast(int, x), 0x118, 0xf, 0xf, true)
                                   : __builtin_amdgcn_update_dpp(0, __builtin_bit_cast(int, x), 0x142, 0xa, 0xf, false));
}
__device__ __forceinline__ float prefix32(float x) {
    x += dpp_f(x, 0x111, 0xf, true); x += dpp_f(x, 0x112, 0xf, true); x += dpp_f(x, 0x114, 0xf, true); x += dpp_f(x, 0x118, 0xf, true); x += dpp_f(x, 0x142, 0xa, false);
    return x;
}
__device__ __forceinline__ float bcast_half(float x, const int l, int hi) {
    const float a = __builtin_bit_cast(float, __builtin_amdgcn_readlane(__builtin_bit_cast(int, x), l)), b = __builtin_bit_cast(float, __builtin_amdgcn_readlane(__builtin_bit_cast(int, x), l + 32));
    return hi ? b : a;
}
constexpr int NSEG = 4, SEGC = (CTXL + SEQ) / 32 / NSEG;
static_assert(SEGC % 3 == 0, "producer loop unrolled by 3");
template <int LAYER, bool OUT>
__device__ __forceinline__ void scan_seg(Frame& F, int u, LAS unsigned char* lds) {
    constexpr int DK = LAYER == 0 ? 64 : 128, NC = DK / 8, NMB = DK / 32, PITCH = LAYER == 0 ? EV_INP : OD_INP;
    typedef Lay<DK> LY;
    const int ch = u / NSEG, seg = u % NSEG, c0 = seg * SEGC;
    const int b = ch >> 3, h = (ch >> 1) & 3, d = ch & 1;
    const bf16* P = (const bf16*)(F.ws + WS_P);
    const int lane = F.lane, r32_o = lane & 31, hi = lane >> 5;
    const bool producer = F.wave >= 4; const int pw = F.wave & 3;
    constexpr int NCHUNK = SEGC;
    float* const EST = (float*)(F.ws + WS_SCAN_E); float* const DST = (float*)(F.ws + WS_SCAN_D);
    __syncthreads();
    if (producer) {
        const int kc0 = NC * (2 * pw + hi), vc0 = 32 * pw + 16 * hi;
        struct Raw { u32x4 rq[NC / 8]; u32x4 rk; u32x4 rv[2]; f32x4 rg[NC / 4]; };
        Raw RA, RB, RC;
        const float* GG = LAYER == 0 ? (const float*)(F.ws + WS_GK) + (size_t)d * MT * 256 + h * 64 + kc0 : (const float*)(F.ws + WS_GH) + (size_t)d * MT * 512 + h * 128 + kc0;
#define SCN_FETCH(X, n) do { const int _s = 32 * (c0 + (n)) + r32; const size_t _row = (size_t)scan_row(b, d, _s); const bf16* pr = P + _row * PITCH; const float* gr = GG + _row * (LAYER == 0 ? 256 : 512); \
        _Pragma("unroll") for (int _q = 0; _q < NC / 4; ++_q) X.rg[_q] = *(const f32x4*)(gr + 4 * _q); \
        if (LAYER == 0) { X.rq[0] = *(const GAS u32x4*)(pr + EV_QB + h * 64 + kc0); X.rk = *(const GAS u32x4*)(pr + EV_KB + h * 64 + kc0); \
            X.rv[0] = *(const GAS u32x4*)(pr + EV_VB + h * 128 + vc0); X.rv[1] = *(const GAS u32x4*)(pr + EV_VB + h * 128 + vc0 + 8); } \
        else { _Pragma("unroll") for (int _q = 0; _q < NC / 8; ++_q) X.rq[_q] = *(const GAS u32x4*)(pr + OD_HQ + h * 128 + kc0 + 8 * _q); \
            X.rv[0] = *(const GAS u32x4*)(pr + OD_HI + h * 128 + vc0); X.rv[1] = *(const GAS u32x4*)(pr + OD_HI + h * 128 + vc0 + 8); } } while (0)
#define SCN_STEP(X, n) do { \
            LAS unsigned char* buf = lds + ((n) & 1) * LY::BUF; \
            int r32 = r32_o; asm volatile("" : "+v"(r32)); \
            float qq[NC], kk[NC], gg[NC]; \
            _Pragma("unroll") for (int j = 0; j < NC; ++j) { const unsigned wq = X.rq[j >> 3][(j >> 1) & 3]; qq[j] = (j & 1) ? bfhi(wq) : bflo(wq); gg[j] = X.rg[j >> 2][j & 3]; } \
            if (LAYER == 0) { _Pragma("unroll") for (int j = 0; j < NC; ++j) { const unsigned wk = X.rk[(j >> 1) & 3]; kk[j] = (j & 1) ? bfhi(wk) : bflo(wk); qq[j] *= GLA_QSCALE; } } \
            else { _Pragma("unroll") for (int j = 0; j < NC; ++j) kk[j] = 1.0f - __expf(gg[j]); } \
            { LAS unsigned short* vt = (LAS unsigned short*)(buf + LY::VT); \
              _Pragma("unroll") for (int j = 0; j < 16; ++j) { const unsigned w = X.rv[j >> 3][(j >> 1) & 3]; vt[(vc0 + j) * (LY::TS / 2) + r32] = (unsigned short)((j & 1) ? (w >> 16) : (w & 0xffffu)); } } \
            if ((n) + 3 < NCHUNK) SCN_FETCH(X, (n) + 3); \
            u32x4 wqa[NC / 8], wka[NC / 8], wqb[NC / 8]; (void)wqa; (void)wka; (void)wqb; \
            LAS unsigned short* kdt = (LAS unsigned short*)(buf + LY::KDT); \
            LAS float* dec = (LAS float*)(buf + LY::DEC); \
            _Pragma("unroll") for (int j2 = 0; j2 < NC; j2 += 2) { \
                float oqa[2], oka[2], oqb[2]; \
                _Pragma("unroll") for (int u = 0; u < 2; ++u) { const int j = j2 + u; \
                    const float bc = prefix32(gg[j]), bref = bcast_half(bc, 15, hi), blast = bcast_half(bc, 31, hi); \
                    float kd, dcv; \
                    if (OUT) { const float E = __expf(bc - bref), Ei = __builtin_amdgcn_rcpf(E), cq = __expf(bref), ck = __expf(blast - bref); \
                        oqa[u] = qq[j] * E; oka[u] = kk[j] * Ei; oqb[u] = oqa[u] * cq; kd = oka[u] * ck; dcv = cq * ck; } \
                    else { oqa[u] = 0.f; oka[u] = 0.f; oqb[u] = 0.f; dsum[j] += blast; kd = kk[j] * __expf(blast - bc); dcv = __expf(blast); } \
                    kdt[(kc0 + j) * (LY::TS / 2) + r32] = (unsigned short)(cvtpk(kd, 0.f) & 0xffffu); \
                    if (r32 == 31) dec[kc0 + j] = dcv; } \
                if (OUT) { wqa[j2 >> 3][(j2 >> 1) & 3] = cvtpk(oqa[0], oqa[1]); wka[j2 >> 3][(j2 >> 1) & 3] = cvtpk(oka[0], oka[1]); wqb[j2 >> 3][(j2 >> 1) & 3] = cvtpk(oqb[0], oqb[1]); } } \
            if (OUT) { _Pragma("unroll") for (int q = 0; q < NC / 8; ++q) { const int off = r32 * LY::RS + (kc0 + 8 * q) * 2; \
                *(LAS u32x4*)(buf + LY::QA + off) = wqa[q]; *(LAS u32x4*)(buf + LY::KA + off) = wka[q]; *(LAS u32x4*)(buf + LY::QB + off) = wqb[q]; } } \
            SCN_BAR(); } while (0)
        float dsum[NC];
#pragma unroll
        for (int j = 0; j < NC; ++j) dsum[j] = 0.f;
        { const int r32 = r32_o; SCN_FETCH(RA, 0); SCN_FETCH(RB, 1); SCN_FETCH(RC, 2); }
        for (int n = 0; n < NCHUNK; n += 3) { SCN_STEP(RA, n); SCN_STEP(RB, n + 1); SCN_STEP(RC, n + 2); }
        SCN_BAR();
        if (!OUT && r32_o == 0) {
#pragma unroll
            for (int j = 0; j < NC; ++j) DST[(size_t)u * DK + kc0 + j] = __expf(dsum[j]);
        }
#undef SCN_FETCH
#undef SCN_STEP
    } else {
        const int w = pw;
        f32x16 S[NMB];
#pragma unroll
        for (int mb = 0; mb < NMB; ++mb) S[mb] = f32x16{};
        if (OUT) {
            for (int js = 0; js < seg; ++js) { const size_t uj = (size_t)ch * NSEG + js;
#pragma unroll
                for (int mb = 0; mb < NMB; ++mb) { const float* e = EST + uj * (DK * 128) + (size_t)((w * NMB + mb) * 16) * 64 + lane; const float* dd = DST + uj * DK + 32 * mb + 4 * hi;
#pragma unroll
                    for (int r = 0; r < 16; ++r) S[mb][r] = S[mb][r] * dd[(r & 3) + 8 * (r >> 2)] + e[r * 64]; } }
        }
        bf16* OB = (bf16*)(F.ws + (LAYER == 0 ? (d ? WS_OBB : WS_OBF) : (d ? WS_OHB : WS_OHF)));
        SCN_BAR();
        for (int n = 0; n < NCHUNK; ++n) {
            const LAS unsigned char* buf = lds + (n & 1) * LY::BUF;
            int r32 = r32_o; asm volatile("" : "+v"(r32));
            const LAS unsigned char* vtr = buf + LY::VT + (32 * w + r32) * LY::TS;
            if (OUT) {
            f32x16 at = f32x16{};
#pragma unroll
            for (int s = 0; s < DK / 16; ++s) { const int off = r32 * LY::RS + (16 * s + 8 * hi) * 2;
                at = __builtin_amdgcn_mfma_f32_32x32x16_bf16(*(const LAS bf16x8*)(buf + LY::KA + off), *(const LAS bf16x8*)(buf + LY::QA + off), at, 0, 0, 0); }
#pragma unroll
            for (int r = 0; r < 16; ++r) if (crow(r, hi) > r32) at[r] = 0.f;
            f32x16 o = f32x16{};
#pragma unroll
            for (int s = 0; s < 2; ++s) o = __builtin_amdgcn_mfma_f32_32x32x16_bf16(pack8(at, 8 * s), ld2x8(vtr + (16 * s + 4 * hi) * 2), o, 0, 0, 0);
#pragma unroll
            for (int mb = 0; mb < NMB; ++mb)
#pragma unroll
                for (int s = 0; s < 2; ++s)
                    o = __builtin_amdgcn_mfma_f32_32x32x16_bf16(ld2x8(buf + LY::QB + r32 * LY::RS + (32 * mb + 16 * s + 4 * hi) * 2), pack8(S[mb], 8 * s), o, 0, 0, 0);
            if (LAYER == 0 || c0 + n >= CTXL / 32) {
                const int row0 = scan_row(b, d, 32 * (c0 + n)), sg = d ? -1 : 1;
                bf16* ob = OB + (size_t)row0 * 512 + h * 128 + 32 * w + r32;
#pragma unroll
                for (int r = 0; r < 16; ++r) ob[(ptrdiff_t)(sg * crow(r, hi)) * 512] = (bf16)(cvtpk(o[r], 0.f) & 0xffffu);
            }
            }
#pragma unroll
            for (int mb = 0; mb < NMB; ++mb) {
                const LAS float* dc = (const LAS float*)(buf + LY::DEC) + 32 * mb + 4 * hi;
#pragma unroll
                for (int g = 0; g < 4; ++g) { const f32x4 dv = *(const LAS f32x4*)(dc + 8 * g);
                    S[mb][4 * g + 0] *= dv.x; S[mb][4 * g + 1] *= dv.y; S[mb][4 * g + 2] *= dv.z; S[mb][4 * g + 3] *= dv.w; }
#pragma unroll
                for (int s = 0; s < 2; ++s)
                    S[mb] = __builtin_amdgcn_mfma_f32_32x32x16_bf16(*(const LAS bf16x8*)(buf + LY::KDT + (32 * mb + r32) * LY::TS + (16 * s + 8 * hi) * 2),
                                                                   *(const LAS bf16x8*)(vtr + (16 * s + 8 * hi) * 2), S[mb], 0, 0, 0);
            }
            SCN_BAR();
        }
        if (!OUT) {
#pragma unroll
            for (int mb = 0; mb < NMB; ++mb) { float* e = EST + (size_t)u * (DK * 128) + (size_t)((w * NMB + mb) * 16) * 64 + lane;
#pragma unroll
                for (int r = 0; r < 16; ++r) e[r * 64] = S[mb][r]; }
        }
    }
}
}

__device__ __forceinline__ int scan_unit(int p) { return ((p & 63) << 2) | (3 - (p >> 6)); }
template <int LAYER> __device__ __forceinline__ void p_scan_pass1(Frame& F) { for (int p = blockIdx.x; p < 64 * scn::NSEG; p += F.G) { const int u = scan_unit(p); if (u % scn::NSEG == scn::NSEG - 1) continue; scn::scan_seg<LAYER, false>(F, u, F.lds); __syncthreads(); } }
template <int LAYER> __device__ __forceinline__ void p_scan_pass2(Frame& F) { for (int p = blockIdx.x; p < 64 * scn::NSEG; p += F.G) { scn::scan_seg<LAYER, true>(F, scan_unit(p), F.lds); __syncthreads(); } }
__device__ __forceinline__ void p_merge0(Frame& F) {
    const bf16* P = (const bf16*)(F.ws + WS_P); const float* OA = (const float*)(F.ws + WS_OA); const bf16* OBF = (const bf16*)(F.ws + WS_OBF); const bf16* OBB = (const bf16*)(F.ws + WS_OBB);
    bf16* A = (bf16*)(F.ws + WS_H);
    const int c = 2 * F.lane;
    const float sg0 = F.in[I_EV_SUBLN][c] * (1.0f - LAM_INIT0), sg1 = F.in[I_EV_SUBLN][c + 1] * (1.0f - LAM_INIT0), gg0 = F.in[I_EV_GLAG][c], gg1 = F.in[I_EV_GLAG][c + 1];
    for (int m = F.gw; m < MT; m += F.NGW) {
        float2 va[4]; unsigned vf[4], vb[4], vg[4];
#pragma unroll
        for (int h = 0; h < 4; ++h) { va[h] = *(const float2*)(OA + (size_t)m * 512 + h * 128 + c); vf[h] = *(const GAS unsigned*)(OBF + (size_t)m * 512 + h * 128 + c); vb[h] = *(const GAS unsigned*)(OBB + (size_t)m * 512 + h * 128 + c);
            vg[h] = *(const GAS unsigned*)(P + (size_t)m * EV_INP + EV_GB + h * 128 + c); }
#pragma unroll
        for (int h = 0; h < 4; ++h) {
            const float r = rsqrtf(wave_sum(va[h].x * va[h].x + va[h].y * va[h].y) * (1.0f / 128.0f) + RMS_EPS);
            *(GAS unsigned*)(A + (size_t)m * DM + h * 128 + c) = pk2(va[h].x * r * sg0, va[h].y * r * sg1);
            const float v0 = bflo(vf[h]) + bflo(vb[h]), v1 = bfhi(vf[h]) + bfhi(vb[h]); const float r2 = rsqrtf(wave_sum(v0 * v0 + v1 * v1) * (1.0f / 128.0f) + RMS_EPS);
            *(GAS unsigned*)(A + (size_t)m * DM + 512 + h * 128 + c) = pk2(v0 * r2 * gg0 * siluf_(bflo(vg[h])), v1 * r2 * gg1 * siluf_(bfhi(vg[h])));
        }
    }
}
__device__ __forceinline__ void p_merge1(Frame& F) {
    const bf16* P = (const bf16*)(F.ws + WS_P); const bf16* OHF = (const bf16*)(F.ws + WS_OHF); const bf16* OHB = (const bf16*)(F.ws + WS_OHB);
    bf16* A = (bf16*)(F.ws + WS_H);
    const int c = 2 * F.lane; const float gg0 = F.in[I_OD_HGG][c], gg1 = F.in[I_OD_HGG][c + 1];
    for (int m = F.gw; m < ML; m += F.NGW) {
        unsigned vf[4], vb[4], vg[4];
#pragma unroll
        for (int h = 0; h < 4; ++h) { vf[h] = *(const GAS unsigned*)(OHF + (size_t)m * 512 + h * 128 + c); vb[h] = *(const GAS unsigned*)(OHB + (size_t)m * 512 + h * 128 + c); vg[h] = *(const GAS unsigned*)(P + (size_t)m * OD_INP + OD_HG + h * 128 + c); }
#pragma unroll
        for (int h = 0; h < 4; ++h) { const float v0 = bflo(vf[h]) + bflo(vb[h]), v1 = bfhi(vf[h]) + bfhi(vb[h]); const float r = rsqrtf(wave_sum(v0 * v0 + v1 * v1) * (1.0f / 128.0f) + RMS_EPS);
            *(GAS unsigned*)(A + (size_t)m * DM + 512 + h * 128 + c) = pk2(v0 * r * gg0 * siluf_(bflo(vg[h])), v1 * r * gg1 * siluf_(bfhi(vg[h]))); }
    }
}

template <bool BASE_SRC, bool DO_H, bool ROUTER, int NSP>
__device__ __forceinline__ void p_ln(Frame& F, int nrows, const float* base, const bf16* y, int l, int gate_chunk, int ln_slot, float* xout, int hl, int hsc, int hsh, const float* ypart = nullptr) {
    const float* MOD = (const float*)(F.ws + WS_MOD); bf16* H = (bf16*)(F.ws + WS_H);
    const float* G = F.in[I_LNG] + (size_t)(l * 2 + ln_slot) * DM; const float* Bb = F.in[I_LNB] + (size_t)(l * 2 + ln_slot) * DM;
    for (int m = F.gw; m < nrows; m += F.NGW) {
        const float* br = BASE_SRC ? src_row(F, m) : base + (size_t)m * DM; const bf16* yr = y + (size_t)m * DM;
        const float* mr = MOD + (size_t)(l * 9 + mod_row(m)) * 6144 + gate_chunk * 1024;
        f32x4 t[4]; float s = 0.f;
#pragma unroll
        for (int j = 0; j < 4; ++j) { const int c = 4 * F.lane + 256 * j; f32x4 yv;
            if (NSP > 0 && m >= ML) { f32x4 pv[NSP > 0 ? NSP : 1];
#pragma unroll
                for (int sp = 0; sp < NSP; ++sp) pv[sp] = *(const f32x4*)(ypart + ((size_t)sp * MC + (m - ML)) * DM + c);
                yv = pv[0];
#pragma unroll
                for (int sp = 1; sp < NSP; ++sp) yv = yv + pv[sp]; }
            else yv = ld_bf16x4(yr + c);
            t[j] = *(const f32x4*)(br + c) * DN_ALPHA + *(const f32x4*)(mr + c) * yv; s += (t[j].x + t[j].y) + (t[j].z + t[j].w); }
        const float mean = wave_sum(s) * (1.0f / DM); float s2 = 0.f;
#pragma unroll
        for (int j = 0; j < 4; ++j) { t[j] = t[j] - mean; s2 += (t[j].x * t[j].x + t[j].y * t[j].y) + (t[j].z * t[j].z + t[j].w * t[j].w); }
        const float rstd = rsqrtf(wave_sum(s2) * (1.0f / DM) + LN_EPS);
        float lg[8];
#pragma unroll
        for (int e = 0; e < 8; ++e) lg[e] = 0.f;
#pragma unroll
        for (int j = 0; j < 4; ++j) { const int c = 4 * F.lane + 256 * j; const f32x4 xo = t[j] * rstd * *(const f32x4*)(G + c) + *(const f32x4*)(Bb + c);
            if (xout) *(f32x4*)(xout + (size_t)m * DM + c) = xo;
            if (DO_H) { const float* hr = MOD + (size_t)(hl * 9 + mod_row(m)) * 6144; const f32x4 hv = xo * (1.0f + *(const f32x4*)(hr + hsc * 1024 + c)) + *(const f32x4*)(hr + hsh * 1024 + c);
                store_bf16x4(H + (size_t)m * DM + c, hv);
                if (ROUTER) { const float* wr = F.in[I_OD_ROUTER] + (size_t)c * 8;
#pragma unroll
                    for (int q = 0; q < 4; ++q) { const f32x4 wa = *(const f32x4*)(wr + q * 8), wb = *(const f32x4*)(wr + q * 8 + 4); const float hq = hv[q];
                        lg[0] += hq * wa.x; lg[1] += hq * wa.y; lg[2] += hq * wa.z; lg[3] += hq * wa.w; lg[4] += hq * wb.x; lg[5] += hq * wb.y; lg[6] += hq * wb.z; lg[7] += hq * wb.w; } } }
        }
        if (ROUTER) {
#pragma unroll
            for (int e = 0; e < 8; ++e) lg[e] = wave_sum(lg[e]);
            int i0 = 0; float v0 = lg[0];
#pragma unroll
            for (int e = 1; e < 8; ++e) if (lg[e] > v0) { v0 = lg[e]; i0 = e; }
            int i1 = -1; float v1 = -3.0e38f;
#pragma unroll
            for (int e = 0; e < 8; ++e) if (e != i0 && lg[e] > v1) { v1 = lg[e]; i1 = e; }
            const float g0 = 1.0f / (1.0f + __expf(v1 - v0)), g1 = 1.0f - g0;
            if (F.lane == 0) { v4u o; o.x = (unsigned)i0; o.y = (unsigned)i1; o.z = __float_as_uint(g0); o.w = __float_as_uint(g1); *(GAS v4u*)(F.ws + WS_ROUTE + (size_t)m * 16) = o; }
        }
    }
}

__device__ __forceinline__ void p_post1(Frame& F) {
    bf16* P = (bf16*)(F.ws + WS_P); bf16* NQ = (bf16*)(F.ws + WS_NQ); bf16* NKV = (bf16*)(F.ws + WS_NKV);
    const float* COS = (const float*)(F.ws + WS_COS); const float* SIN = (const float*)(F.ws + WS_SIN);
    for (int m = F.gw; m < MT; m += F.NGW) {
        bf16* pr = P + (size_t)m * OD_INP;
        if (m < ML) {
            const int c = 4 * F.lane; const unsigned long long w = *(const GAS unsigned long long*)(pr + OD_CQ + c);
            const float v0 = bflo((unsigned)w), v1 = bfhi((unsigned)w), v2 = bflo((unsigned)(w >> 32)), v3 = bfhi((unsigned)(w >> 32));
            const float r = rsqrtf(wave_sum((v0 * v0 + v1 * v1) + (v2 * v2 + v3 * v3)) * (1.0f / 256.0f) + RMS_EPS);
            const f32x4 g = *(const f32x4*)(F.in[I_OD_QNG] + c);
            store_bf16x4(NQ + (size_t)m * 256 + c, (f32x4){v0 * r * g.x, v1 * r * g.y, v2 * r * g.z, v3 * r * g.w});
        }
        { const int c = 2 * F.lane; const unsigned w = *(const GAS unsigned*)(pr + OD_CKV + c); const float v0 = bflo(w), v1 = bfhi(w);
          const float r = rsqrtf(wave_sum(v0 * v0 + v1 * v1) * (1.0f / 128.0f) + RMS_EPS);
          *(GAS unsigned*)(NKV + (size_t)m * 256 + c) = pk2(v0 * r * F.in[I_OD_KVNG][c], v1 * r * F.in[I_OD_KVNG][c + 1]);
          *(GAS unsigned*)(NKV + (size_t)m * 256 + 128 + c) = 0u; }
        {
          const float* LB = (const float*)(F.ws + WS_SCAL) + 256; float* GH = (float*)(F.ws + WS_GH);
#pragma unroll
          for (int d = 0; d < 2; ++d) { const int c = 8 * F.lane; const v4u w = *(const GAS v4u*)(pr + (d ? OD_HFB : OD_HFF) + c);
              const f32x4 l0 = *(const f32x4*)(LB + c), l1 = *(const f32x4*)(LB + c + 4); f32x4 o0, o1;
              o0.x = __logf(l0.x + (1.0f - l0.x) * sigmoidf_(bflo(w.x))); o0.y = __logf(l0.y + (1.0f - l0.y) * sigmoidf_(bfhi(w.x))); o0.z = __logf(l0.z + (1.0f - l0.z) * sigmoidf_(bflo(w.y))); o0.w = __logf(l0.w + (1.0f - l0.w) * sigmoidf_(bfhi(w.y)));
              o1.x = __logf(l1.x + (1.0f - l1.x) * sigmoidf_(bflo(w.z))); o1.y = __logf(l1.y + (1.0f - l1.y) * sigmoidf_(bfhi(w.z))); o1.z = __logf(l1.z + (1.0f - l1.z) * sigmoidf_(bflo(w.w))); o1.w = __logf(l1.w + (1.0f - l1.w) * sigmoidf_(bfhi(w.w)));
              float* go = GH + ((size_t)d * MT + m) * 512 + c; *(f32x4*)go = o0; *(f32x4*)(go + 4) = o1; } }
        if (m < ML && F.lane < 32) { const int t = m & (SEQ - 1); const float cs = COS[t * 32 + F.lane], sn = SIN[t * 32 + F.lane];
            const unsigned w = *(const GAS unsigned*)(pr + OD_KR + 2 * F.lane); const float t0 = bflo(w), t1 = bfhi(w);
            *(GAS unsigned*)(pr + OD_KR + 2 * F.lane) = pk2(t0 * cs - t1 * sn, t0 * sn + t1 * cs); }
    }
}

__device__ __forceinline__ void p_act(Frame& F, int nrows) {
    const bf16* U = (const bf16*)(F.ws + WS_U); bf16* ACT = (bf16*)(F.ws + WS_ACT);
    const size_t n8 = (size_t)nrows * (DFF / 8);
    for (size_t i = (size_t)blockIdx.x * NTHR + F.tid; i < n8; i += (size_t)F.G * NTHR) {
        const size_t m = i / (DFF / 8); const int j = (int)(i % (DFF / 8)) * 8;
        const v4u g = *(const GAS v4u*)(U + m * (2 * DFF) + j), u = *(const GAS v4u*)(U + m * (2 * DFF) + DFF + j);
        v4u o; o.x = pk2(siluf_(bflo(g.x)) * bflo(u.x), siluf_(bfhi(g.x)) * bfhi(u.x)); o.y = pk2(siluf_(bflo(g.y)) * bflo(u.y), siluf_(bfhi(g.y)) * bfhi(u.y));
        o.z = pk2(siluf_(bflo(g.z)) * bflo(u.z), siluf_(bfhi(g.z)) * bfhi(u.z)); o.w = pk2(siluf_(bflo(g.w)) * bflo(u.w), siluf_(bfhi(g.w)) * bfhi(u.w));
        *(GAS v4u*)(ACT + m * DFF + j) = o;
    }
}

struct MoeOff { int t1, t2, t3, t4, t5, t6, t7, t8; };
__device__ __forceinline__ MoeOff moe_offsets(const Frame& F) {
    const unsigned* cnt = (const unsigned*)(F.ctl + CW_CNT);
    int n[8];
#pragma unroll
    for (int e = 0; e < 8; ++e) n[e] = (int)((__builtin_amdgcn_readfirstlane((int)cnt[16 * e]) + 255) >> 8);
    MoeOff o; o.t1 = n[0]; o.t2 = o.t1 + n[1]; o.t3 = o.t2 + n[2]; o.t4 = o.t3 + n[3]; o.t5 = o.t4 + n[4]; o.t6 = o.t5 + n[5]; o.t7 = o.t6 + n[6]; o.t8 = o.t7 + n[7];
    return o;
}
__device__ __forceinline__ int moe_tile0(const MoeOff& o, int e) { return e == 0 ? 0 : e == 1 ? o.t1 : e == 2 ? o.t2 : e == 3 ? o.t3 : e == 4 ? o.t4 : e == 5 ? o.t5 : e == 6 ? o.t6 : o.t7; }

__device__ __forceinline__ void p_ln1_router(Frame& F) {
    const float* MOD = (const float*)(F.ws + WS_MOD); bf16* H = (bf16*)(F.ws + WS_H);
    const float* X2 = (const float*)(F.ws + WS_X2); const bf16* Y = (const bf16*)(F.ws + WS_YF); float* X1 = (float*)(F.ws + WS_X1);
    const float* G = F.in[I_LNG] + (size_t)(1 * 2 + 0) * DM; const float* Bb = F.in[I_LNB] + (size_t)(1 * 2 + 0) * DM;
    LAS int* sel = (LAS int*)F.lds; LAS int* base = sel + 128;
    unsigned* POS = (unsigned*)(F.ws + WS_POS);
    for (int mb = blockIdx.x * 64; mb < ML; mb += F.G * 64) {
        for (int rl = F.wave; rl < 64; rl += NWAVES) {
            const int m = mb + rl;
            const float* br = X2 + (size_t)m * DM; const bf16* yr = Y + (size_t)m * DM; const float* mr = MOD + (size_t)(1 * 9 + mod_row(m)) * 6144;
            f32x4 t[4]; float s = 0.f;
#pragma unroll
            for (int j = 0; j < 4; ++j) { const int c = 4 * F.lane + 256 * j; t[j] = *(const f32x4*)(br + c) * DN_ALPHA + *(const f32x4*)(mr + 2 * 1024 + c) * ld_bf16x4(yr + c); s += (t[j].x + t[j].y) + (t[j].z + t[j].w); }
            const float mean = wave_sum(s) * (1.0f / DM); float s2 = 0.f;
#pragma unroll
            for (int j = 0; j < 4; ++j) { t[j] = t[j] - mean; s2 += (t[j].x * t[j].x + t[j].y * t[j].y) + (t[j].z * t[j].z + t[j].w * t[j].w); }
            const float rstd = rsqrtf(wave_sum(s2) * (1.0f / DM) + LN_EPS);
            float lg[8];
#pragma unroll
            for (int e = 0; e < 8; ++e) lg[e] = 0.f;
#pragma unroll
            for (int j = 0; j < 4; ++j) { const int c = 4 * F.lane + 256 * j; const f32x4 xo = t[j] * rstd * *(const f32x4*)(G + c) + *(const f32x4*)(Bb + c);
                *(f32x4*)(X1 + (size_t)m * DM + c) = xo;
                const f32x4 hv = xo * (1.0f + *(const f32x4*)(mr + 4 * 1024 + c)) + *(const f32x4*)(mr + 3 * 1024 + c);
                store_bf16x4(H + (size_t)m * DM + c, hv);
                const float* wr = F.in[I_OD_ROUTER] + (size_t)c * 8;
#pragma unroll
                for (int q = 0; q < 4; ++q) { const f32x4 wa = *(const f32x4*)(wr + q * 8), wb = *(const f32x4*)(wr + q * 8 + 4); const float hq = hv[q];
                    lg[0] += hq * wa.x; lg[1] += hq * wa.y; lg[2] += hq * wa.z; lg[3] += hq * wa.w; lg[4] += hq * wb.x; lg[5] += hq * wb.y; lg[6] += hq * wb.z; lg[7] += hq * wb.w; } }
#pragma unroll
            for (int e = 0; e < 8; ++e) lg[e] = wave_sum(lg[e]);
            int i0 = 0; float v0 = lg[0];
#pragma unroll
            for (int e = 1; e < 8; ++e) if (lg[e] > v0) { v0 = lg[e]; i0 = e; }
            int i1 = -1; float v1 = -3.0e38f;
#pragma unroll
            for (int e = 0; e < 8; ++e) if (e != i0 && lg[e] > v1) { v1 = lg[e]; i1 = e; }
            const float g0 = 1.0f / (1.0f + __expf(v1 - v0)), g1 = 1.0f - g0;
            if (F.lane == 0) { v4u o; o.x = (unsigned)i0; o.y = (unsigned)i1; o.z = __float_as_uint(g0); o.w = __float_as_uint(g1); *(GAS v4u*)(F.ws + WS_ROUTE + (size_t)m * 16) = o;
                sel[rl * 2] = i0; sel[rl * 2 + 1] = i1; }
        }
        __syncthreads();
        if (F.tid < 8) { int c = 0; for (int i = 0; i < 128; ++i) c += (sel[i] == F.tid) ? 1 : 0;
            base[F.tid] = (int)__hip_atomic_fetch_add((unsigned*)(F.ctl + CW_CNT) + 16 * F.tid, (unsigned)c, __ATOMIC_RELAXED, __HIP_MEMORY_SCOPE_AGENT); }
        __syncthreads();
        if (F.tid < 128) { const int e = sel[F.tid]; int rank = 0; for (int i = 0; i < F.tid; ++i) rank += (sel[i] == e) ? 1 : 0; POS[(size_t)mb * 2 + F.tid] = (unsigned)(base[e] + rank); }
        __syncthreads();
    }
}
__device__ __forceinline__ void p_moe_dispatch(Frame& F) {
    const MoeOff o = moe_offsets(F);
    const bf16* H = (const bf16*)(F.ws + WS_H); bf16* HG = (bf16*)(F.ws + WS_HG); const unsigned* POS = (const unsigned*)(F.ws + WS_POS);
    for (int mb = F.gw; mb < ML; mb += 4 * F.NGW) {
        v4u rr[4]; unsigned p0[4], p1[4]; v4u a[4], c[4];
#pragma unroll
        for (int q = 0; q < 4; ++q) { const int m = mb + q * F.NGW; if (m < ML) { rr[q] = *(const GAS v4u*)(F.ws + WS_ROUTE + (size_t)m * 16); p0[q] = POS[(size_t)m * 2]; p1[q] = POS[(size_t)m * 2 + 1];
            a[q] = *(const GAS v4u*)(H + (size_t)m * DM + 8 * F.lane); c[q] = *(const GAS v4u*)(H + (size_t)m * DM + 512 + 8 * F.lane); } }
#pragma unroll
        for (int q = 0; q < 4; ++q) { const int m = mb + q * F.NGW; if (m < ML) {
            const int s0 = moe_tile0(o, (int)rr[q].x) * 256 + (int)p0[q], s1 = moe_tile0(o, (int)rr[q].y) * 256 + (int)p1[q];
            *(GAS v4u*)(HG + (size_t)s0 * DM + 8 * F.lane) = a[q]; *(GAS v4u*)(HG + (size_t)s0 * DM + 512 + 8 * F.lane) = c[q];
            *(GAS v4u*)(HG + (size_t)s1 * DM + 8 * F.lane) = a[q]; *(GAS v4u*)(HG + (size_t)s1 * DM + 512 + 8 * F.lane) = c[q]; } }
    }
}
template <class Epi> __device__ __forceinline__ void run_gemm_moe(Frame& F, const bf16* A, const bf16* Bt, int N, int K, size_t estride_bytes, int nsplit, const Epi& E) {
    const MoeOff o = moe_offsets(F);
    pg8::Gemm g{A, Bt, nsplit * o.t8 * 256, N, K, nsplit > 1 ? K / nsplit / 64 : 0}; pg8::GroupedOrder S; S.init(nsplit * o.t8 * 256, N, F.G, (int)blockIdx.x);
    S.t1 = o.t1; S.t2 = o.t2; S.t3 = o.t3; S.t4 = o.t4; S.t5 = o.t5; S.t6 = o.t6; S.t7 = o.t7; S.estride = estride_bytes;
    S.mt = nsplit > 1 ? o.t8 : 0; S.kbytes = (size_t)(K / nsplit) * 2;
    pg8::gemm_phase<Epi, pg8::GroupedOrder, true, true>(F.lds, g, S, E);
}
__device__ __forceinline__ void p_ln_final(Frame& F) {
    const MoeOff o = moe_offsets(F);
    const float* MOD = (const float*)(F.ws + WS_MOD); const float* X1 = (const float*)(F.ws + WS_X1); const bf16* F2 = (const bf16*)(F.ws + WS_F2); const unsigned* POS = (const unsigned*)(F.ws + WS_POS);
    const float* G = F.in[I_LNG] + (size_t)(1 * 2 + 1) * DM; const float* Bb = F.in[I_LNB] + (size_t)(1 * 2 + 1) * DM;
    const size_t half = (size_t)o.t8 * 256 * DM;
    for (int mb = F.gw; mb < ML; mb += 4 * F.NGW) {
      v4u rr[4]; unsigned p0[4], p1[4];
#pragma unroll
      for (int q = 0; q < 4; ++q) { const int m = mb + q * F.NGW; if (m < ML) { rr[q] = *(const GAS v4u*)(F.ws + WS_ROUTE + (size_t)m * 16); p0[q] = POS[(size_t)m * 2]; p1[q] = POS[(size_t)m * 2 + 1]; } }
#pragma unroll
      for (int q = 0; q < 4; ++q) { const int m = mb + q * F.NGW; if (m < ML) {
        const v4u r = rr[q];
        const int s0 = moe_tile0(o, (int)r.x) * 256 + (int)p0[q], s1 = moe_tile0(o, (int)r.y) * 256 + (int)p1[q];
        const float g0 = __uint_as_float(r.z), g1 = __uint_as_float(r.w);
        const float* br = X1 + (size_t)m * DM; const bf16* f0 = F2 + (size_t)s0 * DM; const bf16* f1 = F2 + (size_t)s1 * DM; const float* mr = MOD + (size_t)(1 * 9 + mod_row(m)) * 6144 + 5 * 1024;
        f32x4 t[4]; float s = 0.f;
#pragma unroll
        for (int j = 0; j < 4; ++j) { const int c = 4 * F.lane + 256 * j;
            const f32x4 fv = (ld_bf16x4(f0 + c) + ld_bf16x4(f0 + half + c)) * g0 + (ld_bf16x4(f1 + c) + ld_bf16x4(f1 + half + c)) * g1;
            t[j] = *(const f32x4*)(br + c) * DN_ALPHA + *(const f32x4*)(mr + c) * fv; s += (t[j].x + t[j].y) + (t[j].z + t[j].w); }
        const float mean = wave_sum(s) * (1.0f / DM); float s2 = 0.f;
#pragma unroll
        for (int j = 0; j < 4; ++j) { t[j] = t[j] - mean; s2 += (t[j].x * t[j].x + t[j].y * t[j].y) + (t[j].z * t[j].z + t[j].w * t[j].w); }
        const float rstd = rsqrtf(wave_sum(s2) * (1.0f / DM) + LN_EPS);
#pragma unroll
        for (int j = 0; j < 4; ++j) { const int c = 4 * F.lane + 256 * j; *(f32x4*)(F.out + (size_t)m * DM + c) = t[j] * rstd * *(const f32x4*)(G + c) + *(const f32x4*)(Bb + c); }
      } }
    }
}

template <class Epi> __device__ __forceinline__ void run_gemm(Frame& F, const bf16* A, const bf16* Bt, int M, int N, int K, const Epi& E) {
    pg8::Gemm g{A, Bt, M, N, K, 0}; pg8::StaticOrder S; S.init(M, N, F.G, (int)blockIdx.x);
    pg8::gemm_phase<Epi, pg8::StaticOrder, true, true>(F.lds, g, S, E);
}
template <class Epi> __device__ __forceinline__ void run_gemm_split(Frame& F, const bf16* A, const bf16* Bt, int mt, int N, int Kpitch, int nsplit, int ksplit, const Epi& E) {
    pg8::Gemm g{A, Bt, nsplit * mt * 256, N, Kpitch, ksplit / 64}; pg8::SplitOrder S; S.init(nsplit * mt * 256, N, F.G, (int)blockIdx.x); S.mt = mt; S.kbytes = (size_t)ksplit * 2;
    pg8::gemm_phase<Epi, pg8::SplitOrder, true, true>(F.lds, g, S, E);
}

constexpr int NPHASE = 24;
struct Args { const float* in[28]; float* out; unsigned char* ws; int ph_lo, ph_hi, li, pad; };
__global__ void __launch_bounds__(NTHR, 2) fwd(Args args) {
    extern __shared__ __attribute__((aligned(16))) unsigned char lds[];
    Frame F;
    F.lds = (LAS unsigned char*)lds; F.MISC = (volatile LAS unsigned*)(F.lds + MISC_OFF);
    F.tid = threadIdx.x; F.lane = F.tid & 63; F.wave = __builtin_amdgcn_readfirstlane(F.tid >> 6);
    F.G = gridDim.x; F.gw = blockIdx.x * NWAVES + F.wave; F.NGW = F.G * NWAVES;
    F.ws = args.ws; F.ctl = (gu32*)(args.ws + WS_CTL); F.out = args.out;
#pragma unroll
    for (int i = 0; i < 28; ++i) F.in[i] = args.in[i];
    for (int u = F.tid; u < (LDS_BYTES - MISC_OFF) / 4; u += NTHR) ((LAS unsigned*)(F.lds + MISC_OFF))[u] = 0u;
    __syncthreads();
    XcdBarrier bar = xcd_barrier_post((unsigned*)(F.ctl + CW_BAR) + args.li * XCD_BAR_WORDS, F.MISC + 8);
    const int lo = args.ph_lo, hi = args.ph_hi;
#define IN(k) (lo <= (k) && (k) < hi && (frame_refresh(F), true))
#define SEAM(k) do { if (IN(k) && IN((k) + 1)) xcd_barrier(bar); } while (0)
#ifndef DUPK
#define DUPK (-1)
#endif
#define PHB(k, ...) if (IN(k)) { __VA_ARGS__; if ((k) == DUPK) { xcd_barrier(bar); __VA_ARGS__; } } SEAM(k);
    bf16* const Hb = (bf16*)(F.ws + WS_H); bf16* const Pb = (bf16*)(F.ws + WS_P); bf16* const ACTb = (bf16*)(F.ws + WS_ACT);
    float* const YF = (float*)(F.ws + WS_YF); bf16* const YB = (bf16*)(F.ws + WS_YF); float* const YP = (float*)(F.ws + WS_YPART); float* const X1 = (float*)(F.ws + WS_X1); float* const X2 = (float*)(F.ws + WS_X2);

    PHB(0, { p0_prologue(F); })
    PHB(1, { p_modulate0(F); })
    PHB(2, { pg8::EpiRope E{Pb, EV_INP, (const float*)(F.ws + WS_COS), (const float*)(F.ws + WS_SIN), 4, ML}; run_gemm(F, Hb, (const bf16*)(F.ws + WS_W_IN0), MT, EV_INP, DM, E); })
    PHB(3, { p_post0(F); })
    PHB(4, { p_scan_pass1<0>(F); p_attn0(F); })
    PHB(5, { p_scan_pass2<0>(F); })
    PHB(6, { p_merge0(F); })
    PHB(7, { { pg8::EpiBf16<0> E{YB, DM, nullptr, 0, 0, 1.f}; run_gemm(F, Hb, (const bf16*)(F.ws + WS_W_OUT0), ML, DM, DM, E); }
             { pg8::EpiF32 E{YP, DM, nullptr}; run_gemm_split(F, Hb + (size_t)ML * DM, (const bf16*)(F.ws + WS_W_OUT0), MC / 256, DM, DM, 4, 256, E); } })
    PHB(8, { p_ln<true, true, false, 4>(F, MT, nullptr, YB, 0, 2, 0, X1, 0, 4, 3, YP); })
    PHB(9, { pg8::EpiSwiGLU E{ACTb, DFF}; run_gemm(F, Hb, (const bf16*)(F.ws + WS_W_FF1), MT, 2 * DFF, DM, E); })
    PHB(10, { { pg8::EpiBf16<0> E{YB, DM, nullptr, 0, 0, 1.f}; run_gemm(F, ACTb, (const bf16*)(F.ws + WS_W_FF2), ML, DM, DFF, E); }
              { pg8::EpiF32 E{YP, DM, nullptr}; run_gemm_split(F, ACTb + (size_t)ML * DFF, (const bf16*)(F.ws + WS_W_FF2), MC / 256, DM, DFF, 7, 512, E); } })
    PHB(11, { p_ln<false, true, false, 7>(F, MT, X1, YB, 0, 5, 1, X2, 1, 1, 0, YP); })
    PHB(12, { pg8::EpiBf16<0> E{Pb, OD_INP, nullptr, 0, 0, 1.f}; run_gemm(F, Hb, (const bf16*)(F.ws + WS_W_IN1), MT, OD_INP, DM, E); })
    PHB(13, { p_post1(F); })
    PHB(14, { p_scan_pass1<1>(F); { pg8::EpiBf16<0> E{(bf16*)(F.ws + WS_Q), 768, nullptr, 0, 0, 1.f}; run_gemm(F, (const bf16*)(F.ws + WS_NQ), (const bf16*)(F.ws + WS_W_UQ), ML, 768, 256, E); }
              { pg8::EpiBf16<0> E{(bf16*)(F.ws + WS_KV), 1024, nullptr, 0, 0, 1.f}; run_gemm(F, (const bf16*)(F.ws + WS_NKV), (const bf16*)(F.ws + WS_W_UKV), MT, 1024, 256, E); } })
    PHB(15, { p_attn1(F); })
    PHB(16, { p_scan_pass2<1>(F); })
    PHB(17, { p_merge1(F); })
    PHB(18, { pg8::EpiBf16<0> E{YB, DM, nullptr, 0, 0, 1.f}; run_gemm(F, Hb, (const bf16*)(F.ws + WS_W_OUT1), ML, DM, DM, E); })
    PHB(19, { p_ln1_router(F); })
    PHB(20, { p_moe_dispatch(F); })
    PHB(21, { pg8::EpiSwiGLU E{(bf16*)(F.ws + WS_ACT2), DFF}; run_gemm_moe(F, (const bf16*)(F.ws + WS_HG), (const bf16*)(F.ws + WS_EXP_W1), 2 * DFF, DM, (size_t)2 * DFF * DM * 2, 1, E); })
    PHB(22, { pg8::EpiBf16<0> E{(bf16*)(F.ws + WS_F2), DM, nullptr, 0, 0, 1.f}; run_gemm_moe(F, (const bf16*)(F.ws + WS_ACT2), (const bf16*)(F.ws + WS_EXP_W2), DM, DFF, (size_t)DM * DFF * 2, 2, E); })
    PHB(23, { p_ln_final(F); })
#undef IN
#undef SEAM
#undef PHB
}

#ifndef MK_ONE_LAUNCH
#define MK_ONE_LAUNCH 1
#endif
extern "C" void kernel_launch(void* const* d_in, const int* in_sizes, int n_in, void* d_out, int out_size, void* d_ws, size_t ws_size, hipStream_t stream) {
    static int grid = 0;
    if (grid == 0) {
        if (n_in != 28 || in_sizes[0] != ML * DM || out_size != ML * DM || ws_size < WS_END) { fprintf(stderr, "kernel_launch: unexpected shapes (n_in %d, in0 %d, out %d, ws %zu)\n", n_in, n_in > 0 ? in_sizes[0] : -1, out_size, ws_size); grid = -1; return; }
        int dev = 0, cus = 0;
        if (hipGetDevice(&dev) != hipSuccess || hipDeviceGetAttribute(&cus, hipDeviceAttributeMultiprocessorCount, dev) != hipSuccess) { grid = -1; return; }
        if (hipFuncSetAttribute((const void*)fwd, hipFuncAttributeMaxDynamicSharedMemorySize, LDS_BYTES) != hipSuccess) { fprintf(stderr, "kernel_launch: hipFuncSetAttribute failed\n"); grid = -1; return; }
        int per_cu = 0;
        if (hipOccupancyMaxActiveBlocksPerMultiprocessor(&per_cu, (const void*)fwd, NTHR, LDS_BYTES) != hipSuccess || per_cu < 1) fprintf(stderr, "kernel_launch: occupancy query reports %d\n", per_cu);
        (void)hipGetLastError();
        grid = cus;
    }
    if (grid < 0) return;
    if (hipMemsetAsync((char*)d_ws + WS_CTL, 0, CTL_ZERO_BYTES, stream) != hipSuccess) return;
    Args a{};
    for (int i = 0; i < 28; ++i) a.in[i] = (const float*)d_in[i];
    a.out = (float*)d_out; a.ws = (unsigned char*)d_ws; a.pad = 0;
#if MK_ONE_LAUNCH
    a.ph_lo = 0; a.ph_hi = NPHASE; a.li = 0;
    hipLaunchKernelGGL(fwd, dim3(grid), dim3(NTHR), LDS_BYTES, stream, a);
#else
    for (int p = 0; p < NPHASE; ++p) { a.ph_lo = p; a.ph_hi = p + 1; a.li = p; hipLaunchKernelGGL(fwd, dim3(grid), dim3(NTHR), LDS_BYTES, stream, a); }
#endif
    const hipError_t le = hipPeekAtLastError();
    if (le != hipSuccess) fprintf(stderr, "kernel_launch: launch failed: %s\n", hipGetErrorName(le));
}
```
